# Optimizing an MI355X kernel written in HIP

```python
import jax, jax.numpy as jnp
from jax import lax
import numpy as np

D_MODEL = 2048
BATCH = 2
SEQ = 4096
DEPTH = 1

N_META = 16
N_ATT_HEADS = 8
N_KV_HEADS = 2
ATT_GROUP = N_ATT_HEADS // N_KV_HEADS
ATT_HEAD_DIM = 128
N_IDX_HEADS = 16
IDX_HEAD_DIM = 64
TOPK_MAX = 256
Q_BLOCK = 128
HG_HEADS = 8
HG_KEY_DIM = 128
HG_VAL_DIM = 128
HG_CHUNK = 64
D_FF = 5632
LN_EPS = 1e-5
RMS_EPS = 1e-6

ATT_Q_W = N_ATT_HEADS * ATT_HEAD_DIM
ATT_KV_W = N_KV_HEADS * ATT_HEAD_DIM
IDX_Q_W = N_IDX_HEADS * IDX_HEAD_DIM
HG_K_W = HG_HEADS * HG_KEY_DIM
HG_V_W = HG_HEADS * HG_VAL_DIM
IN_SPLITS = (ATT_Q_W, ATT_KV_W, ATT_KV_W, IDX_Q_W, IDX_HEAD_DIM, N_IDX_HEADS, HG_K_W, HG_K_W, HG_V_W, HG_V_W, D_MODEL, D_MODEL)
D_IN_PROJ = sum(IN_SPLITS)

kernel_name = 'hybrid_dsa_hgrn2_macaron_block'


def layer_norm(x, g, b):
    xf = x.astype(jnp.float32)
    mu = jnp.mean(xf, -1, keepdims=True)
    var = jnp.mean(jnp.square(xf - mu), -1, keepdims=True)
    return ((xf - mu) * lax.rsqrt(var + LN_EPS) * g + b).astype(x.dtype)


def swiglu(x, w_gate, w_up, w_down):
    return (jax.nn.silu(x @ w_gate) * (x @ w_up)) @ w_down


def alibi_slopes(n):
    return jnp.exp2(-8.0 * (jnp.arange(n, dtype=jnp.float32) + 1.0) / n)


def dsa_attention(q, k, v, iq, ik, iw):
    B, T = q.shape[0], q.shape[1]
    L = T - N_META
    k_sel = min(TOPK_MAX, L // 4)
    slopes = alibi_slopes(N_ATT_HEADS).reshape(N_KV_HEADS, ATT_GROUP)
    ik_real = ik[:, N_META:].astype(jnp.float32)
    key_pos = N_META + jnp.arange(L)
    meta_pos = jnp.arange(N_META)

    def block(t0, qlen):
        t_pos = t0 + jnp.arange(qlen)
        qb = lax.dynamic_slice_in_dim(q, t0, qlen, axis=1)
        iqb = lax.dynamic_slice_in_dim(iq, t0, qlen, axis=1).astype(jnp.float32)
        iwb = lax.dynamic_slice_in_dim(iw, t0, qlen, axis=1).astype(jnp.float32)
        s = jnp.einsum('bqhd,bsd->bqhs', iqb, ik_real) * (IDX_HEAD_DIM ** -0.5)
        score = jnp.einsum('bqhs,bqh->bqs', jax.nn.relu(s), iwb)
        score = jnp.where(key_pos[None, None, :] <= t_pos[None, :, None], score, -jnp.inf)
        vals, sel = lax.top_k(score, k_sel)
        pos = jnp.concatenate([jnp.broadcast_to(meta_pos, (B, qlen, N_META)), sel + N_META], -1)
        valid = jnp.concatenate([jnp.broadcast_to(meta_pos[None, None, :] <= t_pos[None, :, None], (B, qlen, N_META)), jnp.isfinite(vals)], -1)
        kg = jax.vmap(lambda kb, pb: kb[pb])(k, pos)
        vg = jax.vmap(lambda vb, pb: vb[pb])(v, pos)
        logits = jnp.einsum('bqkgd,bqnkd->bqkgn', qb, kg).astype(jnp.float32) * (ATT_HEAD_DIM ** -0.5)
        dist = jnp.abs(t_pos[None, :, None] - pos).astype(jnp.float32)
        logits = logits - slopes[None, None, :, :, None] * dist[:, :, None, None, :]
        logits = jnp.where(valid[:, :, None, None, :], logits, -jnp.inf)
        p = jax.nn.softmax(logits, axis=-1).astype(v.dtype)
        return jnp.einsum('bqkgn,bqnkd->bqkgd', p, vg)

    meta_out = block(0, N_META)
    n_blocks = L // Q_BLOCK
    real = lax.map(lambda i: block(N_META + i * Q_BLOCK, Q_BLOCK), jnp.arange(n_blocks))
    real = jnp.moveaxis(real, 0, 1).reshape(B, L, N_KV_HEADS, ATT_GROUP, ATT_HEAD_DIM)
    return jnp.concatenate([meta_out, real], axis=1).reshape(B, T, ATT_Q_W)


def _hgrn2_chunk(state, chunk):
    q, k, v, logf = chunk
    b = jnp.cumsum(logf, axis=2)
    causal = jnp.tril(jnp.ones((HG_CHUNK, HG_CHUNK), dtype=bool))
    diff = b[:, :, :, None, :] - b[:, :, None, :, :]
    decay = jnp.exp(jnp.where(causal[None, None, :, :, None], diff, -jnp.inf))
    scores = jnp.einsum('bhtd,bhsd,bhtsd->bhts', q, k, decay)
    o = jnp.einsum('bhts,bhsv->bhtv', scores, v) + jnp.einsum('bhtd,bhdv->bhtv', q * jnp.exp(b), state)
    b_last = b[:, :, -1:, :]
    state = jnp.exp(b_last[:, :, 0, :])[..., None] * state + jnp.einsum('bhsd,bhsv->bhdv', k * jnp.exp(b_last - b), v)
    return state, o


def hgrn2(q, f, i, gate, lb, norm_g):
    B, T = q.shape[0], q.shape[1]
    f32 = jnp.float32
    fg = lb + (1.0 - lb) * jax.nn.sigmoid(f.astype(f32))
    qh = jax.nn.silu(q.astype(f32)).reshape(B, T, HG_HEADS, HG_KEY_DIM)
    kh = (1.0 - fg).reshape(B, T, HG_HEADS, HG_KEY_DIM)
    logf = jnp.log(fg).reshape(B, T, HG_HEADS, HG_KEY_DIM)
    vh = i.astype(f32).reshape(B, T, HG_HEADS, HG_VAL_DIM)
    pad = HG_CHUNK - N_META

    def to_chunks(a):
        a = jnp.pad(a, ((0, 0), (pad, 0), (0, 0), (0, 0)))
        n = a.shape[1] // HG_CHUNK
        return a.reshape(B, n, HG_CHUNK, HG_HEADS, a.shape[-1]).transpose(1, 0, 3, 2, 4)

    state0 = jnp.zeros((B, HG_HEADS, HG_KEY_DIM, HG_VAL_DIM), f32)
    _, o = lax.scan(_hgrn2_chunk, state0, (to_chunks(qh), to_chunks(kh), to_chunks(vh), to_chunks(logf)))
    o = o.transpose(1, 0, 3, 2, 4).reshape(B, -1, HG_HEADS, HG_VAL_DIM)[:, pad:]
    o = o * lax.rsqrt(jnp.mean(jnp.square(o), -1, keepdims=True) + RMS_EPS) * norm_g
    o = o * jax.nn.silu(gate.astype(f32)).reshape(B, T, HG_HEADS, HG_VAL_DIM)
    return o.reshape(B, T, HG_V_W).astype(gate.dtype)


def hybrid_mixer(h, w_in, idx_k_norm_g, idx_k_norm_b, lb, hg_norm_g, w_branch_att, w_branch_hg, w_out):
    B, T, _ = h.shape
    offsets = np.cumsum(IN_SPLITS)[:-1].tolist()
    aq, ak, av, iq, ik, iw, hq, hf, hi, hgate, g_att, g_hg = jnp.split(h @ w_in, offsets, axis=-1)
    aq = aq.reshape(B, T, N_KV_HEADS, ATT_GROUP, ATT_HEAD_DIM)
    ak = ak.reshape(B, T, N_KV_HEADS, ATT_HEAD_DIM)
    av = av.reshape(B, T, N_KV_HEADS, ATT_HEAD_DIM)
    iq = iq.reshape(B, T, N_IDX_HEADS, IDX_HEAD_DIM)
    ik = layer_norm(ik, idx_k_norm_g, idx_k_norm_b)
    iw = iw * (N_IDX_HEADS ** -0.5)
    y_att = dsa_attention(aq, ak, av, iq, ik, iw)
    y_hg = hgrn2(hq, hf, hi, hgate, lb, hg_norm_g)
    merged = jax.nn.sigmoid(g_att) * (y_att @ w_branch_att) + jax.nn.sigmoid(g_hg) * (y_hg @ w_branch_hg)
    return merged @ w_out


def setup_inputs(seed: int = 0) -> dict:
    key = jax.random.key(seed)
    ks = jax.random.split(key, 24)
    f32 = jnp.float32
    beta = (8.0 * DEPTH) ** -0.25

    def dense(k, shape, fan_in, scale=1.0):
        return jax.random.normal(k, shape, f32) * (scale * fan_in ** -0.5)

    def gain(k, shape):
        return 1.0 + 0.02 * jax.random.normal(k, shape, f32)

    def bias(k, shape):
        return 0.02 * jax.random.normal(k, shape, f32)

    return {
        'x': jax.random.normal(ks[0], (BATCH, SEQ, D_MODEL), f32),
        'meta': jax.random.normal(ks[1], (N_META, D_MODEL), f32),
        'ffn1_w_gate': dense(ks[2], (DEPTH, D_MODEL, D_FF), D_MODEL),
        'ffn1_w_up': dense(ks[3], (DEPTH, D_MODEL, D_FF), D_MODEL),
        'ffn1_w_down': dense(ks[4], (DEPTH, D_FF, D_MODEL), D_FF, beta),
        'ln1_g': gain(ks[5], (DEPTH, D_MODEL)),
        'ln1_b': bias(ks[6], (DEPTH, D_MODEL)),
        'w_in': dense(ks[7], (DEPTH, D_MODEL, D_IN_PROJ), D_MODEL),
        'idx_k_norm_g': gain(ks[8], (DEPTH, IDX_HEAD_DIM)),
        'idx_k_norm_b': bias(ks[9], (DEPTH, IDX_HEAD_DIM)),
        'hg_lb_logits': 0.1 * jax.random.normal(ks[10], (DEPTH + 1, HG_K_W), f32),
        'hg_norm_g': gain(ks[11], (DEPTH, HG_HEADS, HG_VAL_DIM)),
        'w_branch_att': dense(ks[12], (DEPTH, ATT_Q_W, D_MODEL), ATT_Q_W),
        'w_branch_hg': dense(ks[13], (DEPTH, HG_V_W, D_MODEL), HG_V_W),
        'w_out': dense(ks[14], (DEPTH, D_MODEL, D_MODEL), D_MODEL, beta),
        'ln2_g': gain(ks[15], (DEPTH, D_MODEL)),
        'ln2_b': bias(ks[16], (DEPTH, D_MODEL)),
        'ffn2_w_gate': dense(ks[17], (DEPTH, D_MODEL, D_FF), D_MODEL),
        'ffn2_w_up': dense(ks[18], (DEPTH, D_MODEL, D_FF), D_MODEL),
        'ffn2_w_down': dense(ks[19], (DEPTH, D_FF, D_MODEL), D_FF, beta),
        'ln3_g': gain(ks[20], (DEPTH, D_MODEL)),
        'ln3_b': bias(ks[21], (DEPTH, D_MODEL)),
    }


def reference(x, meta, ffn1_w_gate, ffn1_w_up, ffn1_w_down, ln1_g, ln1_b, w_in, idx_k_norm_g, idx_k_norm_b, hg_lb_logits, hg_norm_g, w_branch_att, w_branch_hg, w_out, ln2_g, ln2_b, ffn2_w_gate, ffn2_w_up, ffn2_w_down, ln3_g, ln3_b):
    B = x.shape[0]
    alpha = (2.0 * DEPTH) ** 0.25
    lb_all = jnp.cumsum(jax.nn.softmax(hg_lb_logits.astype(jnp.float32), axis=0), axis=0)
    h = jnp.concatenate([jnp.broadcast_to(meta[None].astype(x.dtype), (B, N_META, D_MODEL)), x], axis=1)
    for l in range(DEPTH):
        h = layer_norm(alpha * h + 0.5 * swiglu(h, ffn1_w_gate[l], ffn1_w_up[l], ffn1_w_down[l]), ln1_g[l], ln1_b[l])
        mix = hybrid_mixer(h, w_in[l], idx_k_norm_g[l], idx_k_norm_b[l], lb_all[l], hg_norm_g[l], w_branch_att[l], w_branch_hg[l], w_out[l])
        h = layer_norm(alpha * h + mix, ln2_g[l], ln2_b[l])
        h = layer_norm(alpha * h + 0.5 * swiglu(h, ffn2_w_gate[l], ffn2_w_up[l], ffn2_w_down[l]), ln3_g[l], ln3_b[l])
    return h[:, N_META:]
```

```cpp
#include <hip/hip_runtime.h>
#include <cstdio>
#include <cstdint>
namespace pg8 {
#define PG8_LAS __attribute__((address_space(3)))
typedef unsigned short bf16_t;
typedef short bf16x8 __attribute__((ext_vector_type(8)));
typedef float f32x4 __attribute__((ext_vector_type(4)));
typedef unsigned u32x4 __attribute__((ext_vector_type(4)));
constexpr int BM = 256, BK = 64, HALF = 128, HTB = HALF * BK * 2  , STAGE_BYTES = 8 * HTB, NXCD = 8, WGM = 8;

__host__ __device__ __forceinline__ int lds_byte(int r, int c) { const int st = (r >> 4) * 2 + (c >> 5), rr = r & 15, cc = c & 31, ob = rr * 64 + cc * 2; return st * 1024 + (ob ^ (((ob >> 9) & 1) << 5)); }
__host__ __device__ __forceinline__ void stage_rc(int b, int& R, int& C) { const int st = b / 1024, sb = b % 1024, swz = sb ^ (((sb >> 9) & 1) << 5); R = (st >> 1) * 16 + swz / 64; C = (st & 1) * 32 + (swz % 64) / 2; }
__host__ __device__ __forceinline__ int perm32(int rho) { const int n = rho >> 4, i = rho & 15; return 8 * (i >> 2) + 4 * n + (i & 3); }

struct Unit { int pm, pn; };
struct Gemm { const bf16_t* A; const bf16_t* Bt; int M, N, K; };

struct StaticOrder {
    int nM, nN, nwg, G, c;
    __host__ __device__ void init(int M, int N, int G_, int c_) { nM = M / BM; nN = N / BM; nwg = nM * nN; G = G_; c = c_; }
    __host__ __device__ bool next(int i, Unit& u) const {
        const long L = (long)i * G + c; if (L >= nwg) return false;
        int wgid = (int)L; { const int q = nwg / NXCD, r = nwg % NXCD, xcd = wgid % NXCD, off = wgid / NXCD; wgid = (xcd < r ? xcd * (q + 1) : r * (q + 1) + (xcd - r) * q) + off; }
        const int nig = WGM * nN, gid = wgid / nig, fm = gid * WGM, gsz = (nM - fm) < WGM ? (nM - fm) : WGM;
        u.pm = fm + ((wgid % nig) % gsz); u.pn = (wgid % nig) / gsz; return true;
    }
    __device__ __forceinline__ void a_ready(const Unit&) const {}
    __device__ __forceinline__ void done(const Unit&) const {}
};

__device__ __forceinline__ unsigned cvt_pk_bf16(float lo, float hi) { unsigned r; asm volatile("v_cvt_pk_bf16_f32 %0, %1, %2" : "=v"(r) : "v"(lo), "v"(hi)); return r; }
typedef float f32x2 __attribute__((ext_vector_type(2)));
typedef unsigned u32x2 __attribute__((ext_vector_type(2)));
__device__ __forceinline__ float bflo(unsigned w) { return __uint_as_float(w << 16); }
__device__ __forceinline__ float bfhi(unsigned w) { return __uint_as_float(w & 0xffff0000u); }
__device__ __forceinline__ float sigm(float x) { return __builtin_amdgcn_rcpf(1.f + __expf(-x)); }
__device__ __forceinline__ float silu(float x) { return x * sigm(x); }
__device__ __forceinline__ void row_stats(const float* slab, int row, float& mu, float& rstd) {
    const f32x4* p = (const f32x4*)(slab + (size_t)row * 16);
    const f32x4 a = p[0], b = p[1], c = p[2], d = p[3];
    const float s = ((a[0] + a[2]) + (b[0] + b[2])) + ((c[0] + c[2]) + (d[0] + d[2]));
    const float q = ((a[1] + a[3]) + (b[1] + b[3])) + ((c[1] + c[3]) + (d[1] + d[3]));
    mu = s * (1.0f / 2048.0f);
    const float var = fmaxf(q * (1.0f / 2048.0f) - mu * mu, 0.f);
    rstd = __builtin_amdgcn_rsqf(var + 1e-5f);
}
template <bool LNF> struct EpiSwiGLU {
    static constexpr bool PERM = true, AFTER_DRAIN = false;
    bf16_t* O; int ldc; const float* slab; const float* cs; const float* bw;
    __device__ __forceinline__ void operator()(const f32x4 (&acc)[2][2][4][2], const Unit& u, int wr, int wc, int fr, int fq) const {
        const int row0 = u.pm * BM + wr * 64 + fr;
        const int ocol = u.pn * 128 + wc * 32 + 8 * fq;
        const int brow = u.pn * BM + wc * 32 + 8 * fq;
        f32x4 csg[2], csu[2], bwg[2], bwu[2];
#pragma unroll
        for (int n = 0; n < 2; ++n) {
            if (LNF) { csg[n] = *(const f32x4*)(cs + brow + 4 * n); csu[n] = *(const f32x4*)(cs + brow + 128 + 4 * n); bwg[n] = *(const f32x4*)(bw + brow + 4 * n); bwu[n] = *(const f32x4*)(bw + brow + 128 + 4 * n); }
            else { csg[n] = csu[n] = bwg[n] = bwu[n] = (f32x4){0.f, 0.f, 0.f, 0.f}; }
        }
#pragma unroll
        for (int ai = 0; ai < 2; ++ai)
#pragma unroll
            for (int m = 0; m < 4; ++m) {
                const int row = row0 + ai * HALF + m * 16;
                float mu = 0.f, rs = 1.f; if (LNF) row_stats(slab, row, mu, rs);
                u32x4 w;
#pragma unroll
                for (int n = 0; n < 2; ++n) {
                    f32x4 g = acc[ai][0][m][n], up = acc[ai][1][m][n];
                    if (LNF) { g = (g - mu * csg[n]) * rs + bwg[n]; up = (up - mu * csu[n]) * rs + bwu[n]; }
                    const float o0 = silu(g[0]) * up[0], o1 = silu(g[1]) * up[1], o2 = silu(g[2]) * up[2], o3 = silu(g[3]) * up[3];
                    w[2 * n] = cvt_pk_bf16(o0, o1); w[2 * n + 1] = cvt_pk_bf16(o2, o3);
                }
                *(u32x4*)(O + (size_t)row * ldc + ocol) = w;
            }
    }
};
struct EpiProj {
    static constexpr bool PERM = true, AFTER_DRAIN = false;
    bf16_t* O; int ldc; const float* slab; const float* cs; const float* bw; const PG8_LAS float* mstat;
    __device__ __forceinline__ void operator()(const f32x4 (&acc)[2][2][4][2], const Unit& u, int wr, int wc, int fr, int fq) const {
        const int col0 = u.pn * BM + wc * 32 + 8 * fq;
        f32x4 cv[2][2], bv[2][2];
#pragma unroll
        for (int bj = 0; bj < 2; ++bj)
#pragma unroll
            for (int n = 0; n < 2; ++n) { cv[bj][n] = *(const f32x4*)(cs + col0 + bj * HALF + 4 * n); bv[bj][n] = *(const f32x4*)(bw + col0 + bj * HALF + 4 * n); }
#pragma unroll
        for (int ai = 0; ai < 2; ++ai)
#pragma unroll
            for (int m = 0; m < 4; ++m) {
                const int lr = ai * HALF + wr * 64 + m * 16 + fr, row = u.pm * BM + lr;
                float mu, rs;
                if (u.pm == 32) { if (lr < 16) { mu = mstat[2 * lr]; rs = mstat[2 * lr + 1]; } else { mu = 0.f; rs = 0.f; } }
                else row_stats(slab, row, mu, rs);
#pragma unroll
                for (int bj = 0; bj < 2; ++bj) {
                    const f32x4 v0 = (acc[ai][bj][m][0] - mu * cv[bj][0]) * rs + bv[bj][0], v1 = (acc[ai][bj][m][1] - mu * cv[bj][1]) * rs + bv[bj][1];
                    u32x4 w; w.x = cvt_pk_bf16(v0[0], v0[1]); w.y = cvt_pk_bf16(v0[2], v0[3]); w.z = cvt_pk_bf16(v1[0], v1[1]); w.w = cvt_pk_bf16(v1[2], v1[3]);
                    *(u32x4*)(O + (size_t)row * ldc + col0 + bj * HALF) = w;
                }
            }
    }
};
template <int MODE> struct EpiResid {
    static constexpr bool PERM = false, AFTER_DRAIN = true;
    const float* xres; const bf16_t* zprev; const float* pslab; const float* lg; const float* lb; bf16_t* zb; float* zf; float* oslab; float sc;
    __device__ __forceinline__ void fused(f32x4 (&acc)[2][2][4][2], const Unit& u, int wr, int wc, int fr, int fq, PG8_LAS unsigned char* lds, int wid, int lane) const {
        const float alpha = 1.18920711500272f;
        const int col0 = u.pn * BM + wc * 32 + 4 * fq;
        PG8_LAS float* P = (PG8_LAS float*)lds;
#pragma unroll
        for (int ai = 0; ai < 2; ++ai)
#pragma unroll
            for (int m = 0; m < 4; ++m) {
                const int lr = ai * HALF + wr * 64 + m * 16 + fr, row = u.pm * BM + lr;
                float mu = 0.f, rs = 1.f; if (MODE != 0) row_stats(pslab, row, mu, rs);
                float s1 = 0.f, s2 = 0.f;
#pragma unroll
                for (int bj = 0; bj < 2; ++bj)
#pragma unroll
                    for (int n = 0; n < 2; ++n) {
                        const int c = col0 + bj * HALF + n * 16; const size_t off = (size_t)row * 2048 + c;
                        f32x4 res;
                        if (MODE == 0) res = *(const f32x4*)(xres + off);
                        else { const u32x2 zz = *(const u32x2*)(zprev + off); const f32x4 zv = (f32x4){bflo(zz.x), bfhi(zz.x), bflo(zz.y), bfhi(zz.y)};
                               res = (zv - mu) * rs * *(const f32x4*)(lg + c) + *(const f32x4*)(lb + c); }
                        const f32x4 z = alpha * res + sc * acc[ai][bj][m][n];
                        s1 += (z[0] + z[1]) + (z[2] + z[3]); s2 += (z[0] * z[0] + z[1] * z[1]) + (z[2] * z[2] + z[3] * z[3]);
                        if (MODE == 2) *(f32x4*)(zf + off) = z;
                        else { u32x2 w; w.x = cvt_pk_bf16(z[0], z[1]); w.y = cvt_pk_bf16(z[2], z[3]); *(u32x2*)(zb + off) = w; }
                    }
                s1 += __shfl_xor(s1, 16); s1 += __shfl_xor(s1, 32); s2 += __shfl_xor(s2, 16); s2 += __shfl_xor(s2, 32);
                if (fq == 0) { P[(lr * 4 + wc) * 2] = s1; P[(lr * 4 + wc) * 2 + 1] = s2; }
            }
        __syncthreads();
        const int tid = wid * 64 + lane;
        if (tid < 256) {
            const PG8_LAS float* p = P + tid * 8;
            const float a = (p[0] + p[2]) + (p[4] + p[6]), b = (p[1] + p[3]) + (p[5] + p[7]);
            float* o = oslab + ((size_t)(u.pm * BM + tid) * 8 + u.pn) * 2; o[0] = a; o[1] = b;
        }
    }
};
template <int SECOND> struct EpiBranch {
    static constexpr bool PERM = true, AFTER_DRAIN = false;
    const bf16_t* proj; int ldp, gcol; bf16_t* t1; bf16_t* out;
    __device__ __forceinline__ void operator()(const f32x4 (&acc)[2][2][4][2], const Unit& u, int wr, int wc, int fr, int fq) const {
        const int col0 = u.pn * BM + wc * 32 + 8 * fq;
#pragma unroll
        for (int ai = 0; ai < 2; ++ai)
#pragma unroll
            for (int m = 0; m < 4; ++m) {
                const int row = u.pm * BM + ai * HALF + wr * 64 + m * 16 + fr;
#pragma unroll
                for (int bj = 0; bj < 2; ++bj) {
                    const int c = col0 + bj * HALF;
                    const u32x4 gz = *(const u32x4*)(proj + (size_t)row * ldp + gcol + c);
                    u32x4 tz = (u32x4){0u, 0u, 0u, 0u}; if (SECOND) tz = *(const u32x4*)(t1 + (size_t)row * 2048 + c);
                    const f32x4 a0 = acc[ai][bj][m][0], a1 = acc[ai][bj][m][1];
                    const float v0 = bflo(tz.x) + sigm(bflo(gz.x)) * a0[0], v1 = bfhi(tz.x) + sigm(bfhi(gz.x)) * a0[1], v2 = bflo(tz.y) + sigm(bflo(gz.y)) * a0[2], v3 = bfhi(tz.y) + sigm(bfhi(gz.y)) * a0[3];
                    const float v4 = bflo(tz.z) + sigm(bflo(gz.z)) * a1[0], v5 = bfhi(tz.z) + sigm(bfhi(gz.z)) * a1[1], v6 = bflo(tz.w) + sigm(bflo(gz.w)) * a1[2], v7 = bfhi(tz.w) + sigm(bfhi(gz.w)) * a1[3];
                    u32x4 w; w.x = cvt_pk_bf16(v0, v1); w.y = cvt_pk_bf16(v2, v3); w.z = cvt_pk_bf16(v4, v5); w.w = cvt_pk_bf16(v6, v7);
                    *(u32x4*)((SECOND ? out : t1) + (size_t)row * 2048 + c) = w;
                }
            }
    }
};

template <class Epi, class Sched, bool ALIGN_EPI = false, bool SP2 = false>
__device__ __forceinline__ void gemm_phase(PG8_LAS unsigned char* lds, const Gemm g, const Sched& S, const Epi& E) {
    const int tid = threadIdx.x, wid = __builtin_amdgcn_readfirstlane(tid >> 6), lane = tid & 63, wr = wid >> 2, wc = wid & 3, fr = lane & 15, fq = lane >> 4;
    const int K = g.K, nt = K / BK;
    unsigned voffA[2], voffB[2];
#pragma unroll
    for (int i = 0; i < 2; ++i) { int R, C; stage_rc(tid * 16 + i * 8192, R, C); const int Rb = Epi::PERM ? ((R & ~31) + perm32(R & 31)) : R;
        voffA[i] = (unsigned)(R * K + C) * 2u; voffB[i] = (unsigned)(Rb * K + C) * 2u; }
    const size_t kstep = (size_t)(BK * 2);
    const size_t hstep = (size_t)HALF * K * 2;
    const size_t tstep = 2 * hstep;
    const unsigned ldsw = (unsigned)wid * 1024u;
    const int aoff = lds_byte(wr * 64 + fr, fq * 8), boff = lds_byte(wc * 32 + fr, fq * 8);
#define PG8_SA(b, h) (((b) * 2 + (h)) * HTB)
#define PG8_SB(b, h) ((4 + (b) * 2 + (h)) * HTB)
#define PG8_STAGE(bufoff, gbase, voff) do { _Pragma("unroll") for (int _i = 0; _i < 2; ++_i) \
        __builtin_amdgcn_global_load_lds((const unsigned*)((const char*)(gbase) + (voff)[_i]), (PG8_LAS unsigned*)(lds + (bufoff) + ldsw + _i * 8192), 16, 0, 0); } while (0)
#define PG8_LDA(dst, b, h) do { _Pragma("unroll") for (int m = 0; m < 4; ++m) _Pragma("unroll") for (int k = 0; k < 2; ++k) dst[m][k] = *(const PG8_LAS bf16x8*)(lds + PG8_SA(b, h) + aoff + m * 2048 + k * 1024); } while (0)
#define PG8_LDB(dst, b, h) do { _Pragma("unroll") for (int n = 0; n < 2; ++n) _Pragma("unroll") for (int k = 0; k < 2; ++k) dst[n][k] = *(const PG8_LAS bf16x8*)(lds + PG8_SB(b, h) + boff + n * 2048 + k * 1024); } while (0)
#define PG8_MMA(ai, bj, At, Bt) do { __builtin_amdgcn_s_setprio(1); _Pragma("unroll") for (int m = 0; m < 4; ++m) _Pragma("unroll") for (int n = 0; n < 2; ++n) _Pragma("unroll") for (int k = 0; k < 2; ++k) \
        acc[ai][bj][m][n] = __builtin_amdgcn_mfma_f32_16x16x32_bf16(Bt[n][k], At[m][k], acc[ai][bj][m][n], 0, 0, 0); __builtin_amdgcn_s_setprio(0); } while (0)
#define PG8_WAIT_V(n) asm volatile("s_waitcnt vmcnt(" #n ")" ::: "memory")
#define PG8_WAIT_L(n) asm volatile("s_waitcnt lgkmcnt(" #n ")" ::: "memory")
#define PG8_BAR __builtin_amdgcn_s_barrier()
#define PG8_SCHED __builtin_amdgcn_sched_barrier(0)
    Unit cur, nxt; int ui = 0;
    if (!S.next(0, cur)) return;
    f32x4 acc[2][2][4][2];
#pragma unroll
    for (int a = 0; a < 2; ++a)
#pragma unroll
        for (int b = 0; b < 2; ++b)
#pragma unroll
            for (int m = 0; m < 4; ++m)
#pragma unroll
                for (int n = 0; n < 2; ++n) acc[a][b][m][n] = (f32x4){0.f, 0.f, 0.f, 0.f};
    bf16x8 At[4][2], B0[2][2], B1[2][2];
    const char* cA = (const char*)g.A + (size_t)cur.pm * tstep; const char* cB = (const char*)g.Bt + (size_t)cur.pn * tstep;
    S.a_ready(cur);
    if constexpr (SP2) {
        PG8_STAGE(PG8_SB(0, 0), cB, voffB); PG8_STAGE(PG8_SB(0, 1), cB + hstep, voffB); PG8_STAGE(PG8_SA(0, 0), cA, voffA); PG8_STAGE(PG8_SA(0, 1), cA + hstep, voffA);
        if (wr == 1) PG8_BAR;
        PG8_WAIT_V(2); PG8_BAR;
        PG8_STAGE(PG8_SB(1, 0), cB + kstep, voffB); PG8_STAGE(PG8_SA(1, 0), cA + kstep, voffA); PG8_STAGE(PG8_SB(1, 1), cB + hstep + kstep, voffB);
        PG8_WAIT_V(6); PG8_BAR;
    } else {
        PG8_STAGE(PG8_SB(0, 0), cB, voffB); PG8_STAGE(PG8_SA(0, 0), cA, voffA); PG8_STAGE(PG8_SB(0, 1), cB + hstep, voffB); PG8_STAGE(PG8_SA(0, 1), cA + hstep, voffA);
        if (wr == 1) PG8_BAR;
        PG8_WAIT_V(4); PG8_BAR;
        PG8_STAGE(PG8_SB(1, 0), cB + kstep, voffB); PG8_STAGE(PG8_SA(1, 0), cA + kstep, voffA); PG8_STAGE(PG8_SB(1, 1), cB + hstep + kstep, voffB);
        PG8_WAIT_V(6); PG8_BAR;
    }
    for (;;) {
        const bool has_next = S.next(ui + 1, nxt);
        const char* nA = has_next ? (const char*)g.A + (size_t)nxt.pm * tstep : cA; const char* nB = has_next ? (const char*)g.Bt + (size_t)nxt.pn * tstep : cB;
        for (int t = 0; t < nt; t += 2) {
            const bool last = (t == nt - 2);
            const char* a1 = cA + (size_t)(t + 1) * kstep;
            const char* a2 = last ? nA : cA + (size_t)(t + 2) * kstep; const char* b2 = last ? nB : cB + (size_t)(t + 2) * kstep;
            const char* a3 = a2 + kstep; const char* b3 = b2 + kstep;
            if (last && has_next) S.a_ready(nxt);
            if constexpr (SP2) {
            PG8_LDB(B0, 0, 0); PG8_LDB(B1, 0, 1); PG8_SCHED; PG8_LDA(At, 0, 0); PG8_STAGE(PG8_SA(1, 1), a1 + hstep, voffA);
            PG8_WAIT_V(8); PG8_WAIT_L(0); PG8_BAR; PG8_MMA(0, 0, At, B0); PG8_MMA(0, 1, At, B1); PG8_BAR; PG8_SCHED;
            PG8_LDA(At, 0, 1); PG8_STAGE(PG8_SB(0, 0), b2, voffB); PG8_STAGE(PG8_SB(0, 1), b2 + hstep, voffB); PG8_STAGE(PG8_SA(0, 0), a2, voffA);
            PG8_WAIT_V(8); PG8_WAIT_L(0); PG8_BAR; PG8_MMA(1, 0, At, B0); PG8_MMA(1, 1, At, B1); PG8_BAR; PG8_SCHED;
            PG8_LDB(B0, 1, 0); PG8_LDB(B1, 1, 1); PG8_SCHED; PG8_LDA(At, 1, 0); PG8_STAGE(PG8_SA(0, 1), a2 + hstep, voffA);
            PG8_WAIT_V(8); PG8_WAIT_L(0); PG8_BAR; PG8_MMA(0, 0, At, B0); PG8_MMA(0, 1, At, B1); PG8_BAR; PG8_SCHED;
            PG8_LDA(At, 1, 1); PG8_STAGE(PG8_SB(1, 0), b3, voffB); PG8_STAGE(PG8_SB(1, 1), b3 + hstep, voffB); PG8_STAGE(PG8_SA(1, 0), a3, voffA);
            PG8_WAIT_V(8); PG8_WAIT_L(0); PG8_BAR; PG8_MMA(1, 0, At, B0); PG8_MMA(1, 1, At, B1); PG8_BAR; PG8_SCHED;
            } else {
            PG8_LDB(B0, 0, 0); PG8_SCHED; PG8_LDA(At, 0, 0); PG8_STAGE(PG8_SA(1, 1), a1 + hstep, voffA);
            PG8_WAIT_L(8); PG8_BAR; PG8_WAIT_L(0); PG8_MMA(0, 0, At, B0); PG8_BAR; PG8_SCHED;
            PG8_LDB(B1, 0, 1); PG8_STAGE(PG8_SB(0, 0), b2, voffB);
            PG8_BAR; PG8_WAIT_L(0); PG8_MMA(0, 1, At, B1); PG8_BAR;
            PG8_LDA(At, 0, 1); PG8_STAGE(PG8_SA(0, 0), a2, voffA);
            PG8_BAR; PG8_WAIT_L(0); PG8_MMA(1, 0, At, B0); PG8_BAR; PG8_SCHED;
            PG8_STAGE(PG8_SB(0, 1), b2 + hstep, voffB);
            PG8_WAIT_V(6); PG8_BAR; PG8_MMA(1, 1, At, B1); PG8_BAR;
            PG8_LDB(B0, 1, 0); PG8_SCHED; PG8_LDA(At, 1, 0); PG8_STAGE(PG8_SA(0, 1), a2 + hstep, voffA);
            PG8_WAIT_L(8); PG8_BAR; PG8_WAIT_L(0); PG8_MMA(0, 0, At, B0); PG8_BAR; PG8_SCHED;
            PG8_LDB(B1, 1, 1); PG8_STAGE(PG8_SB(1, 0), b3, voffB);
            PG8_BAR; PG8_WAIT_L(0); PG8_MMA(0, 1, At, B1); PG8_BAR;
            PG8_LDA(At, 1, 1); PG8_STAGE(PG8_SA(1, 0), a3, voffA);
            PG8_BAR; PG8_WAIT_L(0); PG8_MMA(1, 0, At, B0); PG8_BAR; PG8_SCHED;
            PG8_STAGE(PG8_SB(1, 1), b3 + hstep, voffB);
            PG8_WAIT_V(6); PG8_BAR; PG8_MMA(1, 1, At, B1); PG8_BAR;
            }
        }
        if constexpr (ALIGN_EPI) { if (wr == 0) PG8_BAR; }
        if constexpr (!Epi::AFTER_DRAIN) { E(acc, cur, wr, wc, fr, fq); S.done(cur); }
        if (!has_next) break;
#pragma unroll
        for (int a = 0; a < 2; ++a)
#pragma unroll
            for (int b = 0; b < 2; ++b)
#pragma unroll
                for (int m = 0; m < 4; ++m)
#pragma unroll
                    for (int n = 0; n < 2; ++n) acc[a][b][m][n] = (f32x4){0.f, 0.f, 0.f, 0.f};
        cur = nxt; cA = nA; cB = nB; ++ui;
        if constexpr (ALIGN_EPI) { if (wr == 1) PG8_BAR; }
    }
    PG8_WAIT_V(0);
    if constexpr (!ALIGN_EPI) { if (wr == 0) PG8_BAR; }
    PG8_BAR;
    if constexpr (Epi::AFTER_DRAIN) { E.fused(acc, cur, wr, wc, fr, fq, lds, wid, lane); S.done(cur); }
#undef PG8_SA
#undef PG8_SB
#undef PG8_STAGE
#undef PG8_LDA
#undef PG8_LDB
#undef PG8_MMA
#undef PG8_WAIT_V
#undef PG8_WAIT_L
#undef PG8_BAR
#undef PG8_SCHED
}
}
using namespace pg8;
#define LAS __attribute__((address_space(3)))
typedef short s16x4 __attribute__((ext_vector_type(4)));
typedef float f32x16 __attribute__((ext_vector_type(16)));
typedef float f32x2 __attribute__((ext_vector_type(2)));
#define MFMA32(a, b, c) __builtin_amdgcn_mfma_f32_32x32x16_bf16((a), (b), (c), 0, 0, 0)
#define MFMA16(a, b, c) __builtin_amdgcn_mfma_f32_16x16x32_bf16((a), (b), (c), 0, 0, 0)
#define LDS_WAIT() asm volatile("s_waitcnt lgkmcnt(0)" ::: "memory")

constexpr int NBATCH = 2, SEQ = 4096, DM = 2048, NMETA = 16, MR = NBATCH * SEQ  , MPAD = 8448  , METAROW = 8192;
constexpr int DFF = 5632, NGU = 2 * DFF, PW = 11008  , NPROJ = 10832;
constexpr int PC_AQ = 0, PC_AK = 1024, PC_AV = 1280, PC_IQ = 1536, PC_HQ = 2560, PC_HF = 3584, PC_HI = 4608, PC_HG = 5632, PC_GA = 6656, PC_GH = 8704, PC_IK = 10752, PC_IW = 10816;
constexpr int NCS = PW + NGU;
constexpr size_t MiB = 1u << 20;
constexpr size_t WS_CTL = 0, CTL_BYTES = 1 * MiB;
constexpr size_t WS_PCS = 1 * MiB, WS_PBW = 4 * MiB, WS_CSV = 7 * MiB, WS_BWV = 7 * MiB + 131072, WS_Z1M = 7 * MiB + 262144, WS_ST1 = 8 * MiB, WS_ST2 = 9 * MiB, WS_ST3 = 10 * MiB;
constexpr size_t WS_WGU1 = 11 * MiB, WS_WD1 = 55 * MiB, WS_H0B = 77 * MiB, WS_G = 110 * MiB, WS_PROJ = 11 * MiB, WS_G2 = 11 * MiB;
constexpr size_t WS_WIN = 201 * MiB, WS_IKN = 201 * MiB, WS_SEL = 202 * MiB, WS_GCH = 206 * MiB, WS_YATT = 207 * MiB, WS_YHG = 223 * MiB;
constexpr size_t WS_WBA = 244 * MiB, WS_WBH = 248 * MiB, WS_WOUT = 252 * MiB, WS_WGU2 = 260 * MiB, WS_WD2 = 304 * MiB, WS_Z1B = 326 * MiB;
constexpr size_t WS_QT = 359 * MiB, WS_OI = 375 * MiB, WS_LST = 407 * MiB, WS_T1 = 359 * MiB, WS_MRG = 391 * MiB, WS_Z2B = 359 * MiB, WS_END = 440 * MiB;
static_assert(WS_G + (size_t)MPAD * DFF * 2 <= WS_WIN && WS_PROJ + (size_t)MPAD * PW * 2 <= WS_WIN && WS_LST + (size_t)16 * 65 * 32768 <= WS_END && WS_ST1 + (size_t)MPAD * 64 <= WS_ST2, "ws map");
constexpr int CW_BAR = 4096;
constexpr int RING_BYTES = 131072, MISC_OFF = RING_BYTES, MSTAT_OFF = RING_BYTES + 256, LDS_BYTES = 147456;

typedef unsigned v4u __attribute__((ext_vector_type(4)));
__device__ __forceinline__ unsigned f2bf(float f) { unsigned u = __builtin_bit_cast(unsigned, f); return (u + 0x7fffu + ((u >> 16) & 1u)) >> 16; }
__device__ __forceinline__ unsigned pk2(float lo, float hi) { return f2bf(lo) | (f2bf(hi) << 16); }
__device__ __forceinline__ float bf2f(unsigned short h) { return __uint_as_float(((unsigned)h) << 16); }
__device__ __forceinline__ float bfround(float x) { return __uint_as_float(f2bf(x) << 16); }
__device__ __forceinline__ float wave_sum(float v) {
#pragma unroll
    for (int o = 1; o < 64; o <<= 1) v += __shfl_xor(v, o);
    return v;
}
__device__ __forceinline__ int crow(int reg, int h) { return (reg & 3) + 8 * (reg >> 2) + 4 * h; }

#define XB_TMO      128
#define XB_XCNT(j)  (256  + 64 * (j))
#define XB_XSUB(j)  (1280 + 64 * (j))
#define XB_XGEN(j)  (2304 + 64 * (j))
#define XB_TOP      3328
#define XB_TOPGEN   3392
#define XCD_BAR_WORDS 3456
#define XB_SPIN_CAP (1u << 18)

__device__ __forceinline__ unsigned xb_ld(unsigned* p)              { return __hip_atomic_load(p, __ATOMIC_RELAXED, __HIP_MEMORY_SCOPE_AGENT); }
__device__ __forceinline__ unsigned xb_add(unsigned* p, unsigned v) { return __hip_atomic_fetch_add(p, v, __ATOMIC_RELAXED, __HIP_MEMORY_SCOPE_AGENT); }
__device__ __forceinline__ unsigned xb_xcc_id() { return (unsigned)__builtin_amdgcn_s_getreg((3 << 11) | 20) & 0xFu; }
#define XB_SPIN(cond, bar) do { unsigned _sp = 0; while (cond) { __builtin_amdgcn_s_sleep(1); \
    if ((++_sp & 255u) == 0u) { if (xb_ld(&(bar)[XB_TMO])) break; if (_sp > XB_SPIN_CAP) { atomicAdd(&(bar)[XB_TMO], 1u); break; } } } } while (0)

struct XcdBarrier {
    unsigned* bar; unsigned x;
    volatile LAS unsigned* st;
};

__device__ __forceinline__ XcdBarrier xcd_barrier_post(unsigned* bar, volatile LAS unsigned* st) {
    XcdBarrier b; b.bar = bar; b.x = xb_xcc_id(); b.st = st;
    if (threadIdx.x == 0) (void)xb_add(&bar[XB_XCNT(b.x)], 1u);
    return b;
}
__device__ __forceinline__ void xcd_barrier_complete(unsigned* bar, unsigned x, unsigned& nloc, unsigned& nx) {
    const unsigned G = gridDim.x * gridDim.y * gridDim.z;
    unsigned sum, cnt, mine, sp = 0u;
    for (;;) {
        sum = 0u; cnt = 0u; mine = 0u;
#pragma unroll
        for (unsigned j = 0; j < 16; ++j) { const unsigned c = xb_ld(&bar[XB_XCNT(j)]); sum += c; cnt += (c > 0u) ? 1u : 0u; mine = (j == x) ? c : mine; }
        if (sum == G) break;
        __builtin_amdgcn_s_sleep(1);
        if ((++sp & 255u) == 0u) { if (xb_ld(&bar[XB_TMO])) break; if (sp > XB_SPIN_CAP) { atomicAdd(&bar[XB_TMO], 1u); break; } }
    }
    nloc = mine > 0u ? mine : 1u; nx = cnt > 0u ? cnt : 1u;
}

__device__ __forceinline__ void xcd_barrier(const XcdBarrier& b) {
    asm volatile("s_waitcnt vmcnt(0)" ::: "memory");
    __syncthreads();
    if (threadIdx.x == 0) {
        unsigned* bar = b.bar;
        __builtin_amdgcn_s_waitcnt(0);
        unsigned nloc = b.st[0], nx = b.st[1];
        if (nloc == 0u) { xcd_barrier_complete(bar, b.x, nloc, nx); b.st[0] = nloc; b.st[1] = nx; }
        const unsigned old = xb_add(&bar[XB_XSUB(b.x)], 1u);
        const unsigned gen = old / nloc;
        if (old + 1u == (gen + 1u) * nloc) {
            __builtin_amdgcn_fence(__ATOMIC_RELEASE, "agent");
            asm volatile("s_waitcnt vmcnt(0)" ::: "memory");
            const unsigned og = xb_add(&bar[XB_TOP], 1u);
            const unsigned tg = og / nx;
            if (og + 1u == (tg + 1u) * nx) xb_add(&bar[XB_TOPGEN], 1u);
            else XB_SPIN(xb_ld(&bar[XB_TOPGEN]) == tg, bar);
            __builtin_amdgcn_fence(__ATOMIC_ACQUIRE, "agent");
            xb_add(&bar[XB_XGEN(b.x)], 1u);
            asm volatile("s_waitcnt vmcnt(0)" ::: "memory");
        } else {
            XB_SPIN(xb_ld(&bar[XB_XGEN(b.x)]) == gen, bar);
            __builtin_amdgcn_fence(__ATOMIC_ACQUIRE, "agent");
            asm volatile("s_waitcnt vmcnt(0)" ::: "memory");
        }
    }
    __syncthreads();
}
struct Frame {
    LAS unsigned char* lds;
    int tid, lane, wave, G, gw, NGW;
    const float* in[22]; float* out; unsigned char* ws;
};
#define WSP(T, off) ((T*)(F.ws + (off)))

__device__ __forceinline__ int dst_row(int map, int n) {
    if (map == 1) return ((n >> 7) << 8) + (n & 127);
    if (map == 2) return ((n >> 7) << 8) + 128 + (n & 127);
    if (map == 3) return n < 2560 ? n : (n < 2640 ? n + 8192 : n - 80);
    return n;
}
__device__ __forceinline__ void tr_item(const float* W, int K, int N, bf16_t* WT, int map, const float* g, const float* bb, int pcol0, float* pcs, float* pbw,
                                        LAS float* scr, int item, int lane) {
    const int nblk = (N + 31) >> 5, kb = item / nblk, nb = item - kb * nblk, k0 = 64 * kb, n0 = 32 * nb;
    const int nn = n0 + (lane & 31); const bool okn = nn < N;
#pragma unroll 8
    for (int i = 0; i < 32; ++i) { const int kk = 2 * i + (lane >> 5); scr[kk * 33 + (lane & 31)] = okn ? W[(size_t)(k0 + kk) * N + nn] : 0.f; }
    LDS_WAIT(); asm volatile("" ::: "memory");
    if (g) {
        float cs = 0.f, bw = 0.f;
#pragma unroll 8
        for (int kk = 0; kk < 64; ++kk) { const float w = scr[kk * 33 + (lane & 31)]; cs += bfround(g[k0 + kk] * w); bw += bb[k0 + kk] * w; }
        if (lane < 32 && okn) { const int d = pcol0 + dst_row(map, nn); pcs[(size_t)kb * NCS + d] = cs; pbw[(size_t)kb * NCS + d] = bw; }
    }
    const int c = lane & 7;
    float gs[8];
#pragma unroll
    for (int i = 0; i < 8; ++i) gs[i] = g ? g[k0 + 8 * c + i] : 1.f;
#pragma unroll
    for (int j = 0; j < 4; ++j) { const int n = (lane >> 3) + 8 * j; const LAS float* s = scr + (8 * c) * 33 + n;
        if (n0 + n < N) { v4u o; o.x = pk2(s[0 * 33] * gs[0], s[1 * 33] * gs[1]); o.y = pk2(s[2 * 33] * gs[2], s[3 * 33] * gs[3]); o.z = pk2(s[4 * 33] * gs[4], s[5 * 33] * gs[5]); o.w = pk2(s[6 * 33] * gs[6], s[7 * 33] * gs[7]);
            *(v4u*)(WT + (size_t)dst_row(map, n0 + n) * K + k0 + 8 * c) = o; } }
    LDS_WAIT(); asm volatile("" ::: "memory");
}
__device__ __forceinline__ void p0_prologue(Frame& F) {
    LAS float* scr = (LAS float*)(F.lds + F.wave * 16384);
    float* pcs = WSP(float, WS_PCS); float* pbw = WSP(float, WS_PBW);
    constexpr int I_GU = 32 * 176, I_DN = 88 * 64, I_IN = 32 * 339, I_BR = 16 * 64, I_OUT = 32 * 64;
    constexpr int NITEMS = 6 * I_GU + I_IN + 2 * I_BR + I_OUT;
    static_assert(I_DN == I_GU, "items");
    for (int it = F.gw; it < NITEMS; it += F.NGW) {
        int r = it;
        if (r < I_GU) { tr_item(F.in[2], DM, DFF, WSP(bf16_t, WS_WGU1), 1, nullptr, nullptr, 0, pcs, pbw, scr, r, F.lane); continue; } r -= I_GU;
        if (r < I_GU) { tr_item(F.in[3], DM, DFF, WSP(bf16_t, WS_WGU1), 2, nullptr, nullptr, 0, pcs, pbw, scr, r, F.lane); continue; } r -= I_GU;
        if (r < I_DN) { tr_item(F.in[4], DFF, DM, WSP(bf16_t, WS_WD1), 0, nullptr, nullptr, 0, pcs, pbw, scr, r, F.lane); continue; } r -= I_DN;
        if (r < I_IN) { tr_item(F.in[7], DM, NPROJ, WSP(bf16_t, WS_WIN), 3, F.in[5], F.in[6], 0, pcs, pbw, scr, r, F.lane); continue; } r -= I_IN;
        if (r < I_BR) { tr_item(F.in[12], 1024, DM, WSP(bf16_t, WS_WBA), 0, nullptr, nullptr, 0, pcs, pbw, scr, r, F.lane); continue; } r -= I_BR;
        if (r < I_BR) { tr_item(F.in[13], 1024, DM, WSP(bf16_t, WS_WBH), 0, nullptr, nullptr, 0, pcs, pbw, scr, r, F.lane); continue; } r -= I_BR;
        if (r < I_OUT) { tr_item(F.in[14], DM, DM, WSP(bf16_t, WS_WOUT), 0, nullptr, nullptr, 0, pcs, pbw, scr, r, F.lane); continue; } r -= I_OUT;
        if (r < I_GU) { tr_item(F.in[17], DM, DFF, WSP(bf16_t, WS_WGU2), 1, F.in[15], F.in[16], PW, pcs, pbw, scr, r, F.lane); continue; } r -= I_GU;
        if (r < I_GU) { tr_item(F.in[18], DM, DFF, WSP(bf16_t, WS_WGU2), 2, F.in[15], F.in[16], PW, pcs, pbw, scr, r, F.lane); continue; } r -= I_GU;
        tr_item(F.in[19], DFF, DM, WSP(bf16_t, WS_WD2), 0, nullptr, nullptr, 0, pcs, pbw, scr, r, F.lane);
    }
    bf16_t* h0b = WSP(bf16_t, WS_H0B); bf16_t* z1b = WSP(bf16_t, WS_Z1B); bf16_t* wint = WSP(bf16_t, WS_WIN);
    for (int m = F.gw; m < MPAD + (PW - NPROJ); m += F.NGW) {
        if (m >= MPAD) { u32x2* o = (u32x2*)(wint + (size_t)(NPROJ + m - MPAD) * DM) + F.lane;
#pragma unroll
            for (int j = 0; j < 8; ++j) o[64 * j] = (u32x2){0u, 0u};
            continue; }
        const float* src = m < MR ? F.in[0] + (size_t)m * DM : (m < MR + NMETA ? F.in[1] + (size_t)(m - MR) * DM : nullptr);
        u32x2* o = (u32x2*)(h0b + (size_t)m * DM) + F.lane;
#pragma unroll
        for (int j = 0; j < 8; ++j) { u32x2 w = (u32x2){0u, 0u}; if (src) { const f32x4 v = ((const f32x4*)src)[F.lane + 64 * j]; w.x = pk2(v[0], v[1]); w.y = pk2(v[2], v[3]); } o[64 * j] = w; }
        if (m >= MR + NMETA) { u32x2* oz = (u32x2*)(z1b + (size_t)m * DM) + F.lane;
#pragma unroll
            for (int j = 0; j < 8; ++j) oz[64 * j] = (u32x2){0u, 0u}; }
    }
}
__device__ __forceinline__ void p1_colsums(Frame& F) {
    const float* pcs = WSP(float, WS_PCS); const float* pbw = WSP(float, WS_PBW); float* csv = WSP(float, WS_CSV); float* bwv = WSP(float, WS_BWV);
    for (int i = blockIdx.x * 512 + F.tid; i < NCS; i += F.G * 512) {
        float cs = 0.f, bw = 0.f;
        if (!(i >= NPROJ && i < PW)) {
#pragma unroll 8
            for (int kb = 0; kb < 32; ++kb) { cs += pcs[(size_t)kb * NCS + i]; bw += pbw[(size_t)kb * NCS + i]; } }
        csv[i] = cs; bwv[i] = bw;
    }
}
__device__ __forceinline__ void p2_meta_down(Frame& F) {
    const bf16_t* G = WSP(bf16_t, WS_G); const bf16_t* wd = WSP(bf16_t, WS_WD1); float* z1m = WSP(float, WS_Z1M); bf16_t* z1b = WSP(bf16_t, WS_Z1B);
    const int lane = F.lane;
    for (int c = F.gw; c < DM; c += F.NGW) {
        const bf16_t* wrow = wd + (size_t)c * DFF;
        float acc[16];
#pragma unroll
        for (int r = 0; r < 16; ++r) acc[r] = 0.f;
        for (int i = 0; i < 11; ++i) {
            const int k = 8 * lane + 512 * i;
            const v4u wv = *(const v4u*)(wrow + k);
            const float w0 = bflo(wv.x), w1 = bfhi(wv.x), w2 = bflo(wv.y), w3 = bfhi(wv.y), w4 = bflo(wv.z), w5 = bfhi(wv.z), w6 = bflo(wv.w), w7 = bfhi(wv.w);
#pragma unroll
            for (int r = 0; r < 16; ++r) { const v4u gv = *(const v4u*)(G + (size_t)(METAROW + r) * DFF + k);
                acc[r] += (bflo(gv.x) * w0 + bfhi(gv.x) * w1) + (bflo(gv.y) * w2 + bfhi(gv.y) * w3) + (bflo(gv.z) * w4 + bfhi(gv.z) * w5) + (bflo(gv.w) * w6 + bfhi(gv.w) * w7); }
        }
        float v8[8], v4[4], v2[2], v1;
#pragma unroll
        for (int i = 0; i < 8; ++i) { const bool hi = (lane & 32) != 0; const float send = hi ? acc[i] : acc[8 + i], keep = hi ? acc[8 + i] : acc[i]; v8[i] = keep + __shfl_xor(send, 32); }
#pragma unroll
        for (int i = 0; i < 4; ++i) { const bool hi = (lane & 16) != 0; const float send = hi ? v8[i] : v8[4 + i], keep = hi ? v8[4 + i] : v8[i]; v4[i] = keep + __shfl_xor(send, 16); }
#pragma unroll
        for (int i = 0; i < 2; ++i) { const bool hi = (lane & 8) != 0; const float send = hi ? v4[i] : v4[2 + i], keep = hi ? v4[2 + i] : v4[i]; v2[i] = keep + __shfl_xor(send, 8); }
        { const bool hi = (lane & 4) != 0; const float send = hi ? v2[0] : v2[1], keep = hi ? v2[1] : v2[0]; v1 = keep + __shfl_xor(send, 4); }
        v1 += __shfl_xor(v1, 1); v1 += __shfl_xor(v1, 2);
        const int r = ((lane >> 5) & 1) * 8 + ((lane >> 4) & 1) * 4 + ((lane >> 3) & 1) * 2 + ((lane >> 2) & 1);
        if ((lane & 3) == 0) { const float z = 1.18920711500272f * F.in[1][(size_t)r * DM + c] + 0.5f * v1; z1m[(size_t)r * DM + c] = z; z1b[(size_t)(METAROW + r) * DM + c] = (bf16_t)f2bf(z); }
    }
}
__device__ __forceinline__ void p3_meta_stats(Frame& F) {
    const float* z1m = WSP(float, WS_Z1M); LAS float* ms = (LAS float*)(F.lds + MSTAT_OFF);
#pragma unroll
    for (int q = 0; q < 2; ++q) { const int r = 2 * F.wave + q; float s = 0.f, s2 = 0.f;
#pragma unroll
        for (int j = 0; j < 8; ++j) { const f32x4 v = ((const f32x4*)(z1m + (size_t)r * DM))[F.lane + 64 * j]; s += (v[0] + v[1]) + (v[2] + v[3]); s2 += (v[0] * v[0] + v[1] * v[1]) + (v[2] * v[2] + v[3] * v[3]); }
        s = wave_sum(s); s2 = wave_sum(s2);
        const float mu = s * (1.f / DM), var = fmaxf(s2 * (1.f / DM) - mu * mu, 0.f);
        if (F.lane == 0) { ms[2 * r] = mu; ms[2 * r + 1] = __builtin_amdgcn_rsqf(var + 1e-5f); } }
    __syncthreads();
}
__device__ __forceinline__ void p4_ikn(Frame& F) {
    const bf16_t* proj = WSP(bf16_t, WS_PROJ); bf16_t* ikn = WSP(bf16_t, WS_IKN);
    const float g = F.in[8][F.lane], b = F.in[9][F.lane];
    for (int row = F.gw; row < MR; row += F.NGW) {
        const float v = bf2f(proj[(size_t)row * PW + PC_IK + F.lane]);
        const float mu = wave_sum(v) * (1.f / 64.f); const float d = v - mu; const float var = wave_sum(d * d) * (1.f / 64.f);
        ikn[(size_t)row * 64 + F.lane] = (bf16_t)f2bf(d * __builtin_amdgcn_rsqf(var + 1e-5f) * g + b);
    }
}
constexpr int QP = 136, TP = 72;
__device__ __forceinline__ void h1_item(Frame& F, int bh, int c) {
    const int b = bh >> 3, h = bh & 7, tid = F.tid, lane = F.lane, w = F.wave;
    const bf16_t* proj = WSP(bf16_t, WS_PROJ);
    LAS bf16_t* Qs = (LAS bf16_t*)F.lds; LAS bf16_t* Ks = Qs + 64 * QP; LAS bf16_t* KhT = Ks + 64 * QP; LAS bf16_t* VT = KhT + 128 * TP; LAS float* tot = (LAS float*)(VT + 128 * TP);
    const int ch = tid & 127, part = tid >> 7;
    const float l0 = F.in[10][h * 128 + ch], l1 = F.in[10][1024 + h * 128 + ch];
    const float lb = 1.f / (1.f + __expf(l1 - l0));
    float fgv[16], cum[16]; float run = 0.f;
#pragma unroll
    for (int i = 0; i < 16; ++i) { const int tt = 16 * part + i; const bool valid = (c > 0) || (tt < NMETA);
        const size_t row = c == 0 ? (size_t)(METAROW + (tt & 15)) : (size_t)(b * SEQ + (c - 1) * 64 + tt);
        const float f = bf2f(proj[row * PW + PC_HF + h * 128 + ch]);
        const float fg = valid ? lb + (1.f - lb) * sigm(f) : 1.f; run += __logf(fg); fgv[i] = fg; cum[i] = run; }
    tot[part * 128 + ch] = run;
    __syncthreads();
    float off = 0.f, blast = 0.f;
#pragma unroll
    for (int p = 0; p < 4; ++p) { const float t = tot[p * 128 + ch]; if (p < part) off += t; blast += t; }
    if (part == 0) WSP(float, WS_GCH)[(size_t)(bh * 65 + c) * 128 + ch] = __expf(blast);
    bf16_t* qtg = WSP(bf16_t, WS_QT);
#pragma unroll
    for (int i = 0; i < 16; ++i) { const int tt = 16 * part + i; const bool valid = (c > 0) || (tt < NMETA);
        const size_t row = c == 0 ? (size_t)(METAROW + (tt & 15)) : (size_t)(b * SEQ + (c - 1) * 64 + tt);
        const float bq = off + cum[i], fg = fgv[i];
        const float q = valid ? bf2f(proj[row * PW + PC_HQ + h * 128 + ch]) : 0.f, v = valid ? bf2f(proj[row * PW + PC_HI + h * 128 + ch]) : 0.f;
        const float qt = silu(q) * __expf(bq), kk = 1.f - fg, kt = kk * __expf(-bq), kh = kk * __expf(blast - bq);
        const bf16_t qb = (bf16_t)f2bf(qt);
        Qs[tt * QP + ch] = qb; Ks[tt * QP + ch] = (bf16_t)f2bf(kt); KhT[ch * TP + tt] = (bf16_t)f2bf(kh); VT[ch * TP + tt] = (bf16_t)f2bf(v);
        if (c > 0) qtg[((size_t)(bh * 64 + (c - 1)) * 64 + tt) * 128 + ch] = qb; }
    __syncthreads();
    const int tb = w >> 2, dvb = w & 3, r = lane & 31, hh = lane >> 5;
    if (c > 0) {
        f32x16 o;
#pragma unroll
        for (int i = 0; i < 16; ++i) o[i] = 0.f;
        for (int sb = 0; sb <= tb; ++sb) {
            f32x16 x;
#pragma unroll
            for (int i = 0; i < 16; ++i) x[i] = 0.f;
#pragma unroll
            for (int ks = 0; ks < 8; ++ks) { const bf16x8 a = *(const LAS bf16x8*)(Ks + (32 * sb + r) * QP + 16 * ks + 8 * hh); const bf16x8 bq = *(const LAS bf16x8*)(Qs + (32 * tb + r) * QP + 16 * ks + 8 * hh); x = MFMA32(a, bq, x); }
            if (sb == tb) {
#pragma unroll
                for (int i = 0; i < 16; ++i) if (crow(i, hh) > r) x[i] = 0.f; }
#pragma unroll
            for (int s2 = 0; s2 < 2; ++s2) {
                bf16x8 xb;
#pragma unroll
                for (int j = 0; j < 8; ++j) xb[j] = (short)f2bf(x[8 * s2 + j]);
                const LAS bf16_t* vp = VT + (32 * dvb + r) * TP + 32 * sb + 16 * s2 + 4 * hh;
                const s16x4 lo = *(const LAS s16x4*)vp, hi = *(const LAS s16x4*)(vp + 8);
                const bf16x8 a2 = __builtin_shufflevector(lo, hi, 0, 1, 2, 3, 4, 5, 6, 7);
                o = MFMA32(a2, xb, o);
            }
        }
        float* oi = WSP(float, WS_OI) + ((size_t)(bh * 64 + (c - 1)) * 8 + w) * 1024 + lane;
#pragma unroll
        for (int i = 0; i < 16; ++i) oi[i * 64] = o[i];
    }
    if (c < 64) {
        bf16_t* lst = WSP(bf16_t, WS_LST) + (size_t)(bh * 65 + c) * 16384;
#pragma unroll
        for (int q2 = 0; q2 < 2; ++q2) { const int db = (w >> 2) * 2 + q2;
            f32x16 l;
#pragma unroll
            for (int i = 0; i < 16; ++i) l[i] = 0.f;
#pragma unroll
            for (int ks = 0; ks < 4; ++ks) { const bf16x8 a = *(const LAS bf16x8*)(VT + (32 * dvb + r) * TP + 16 * ks + 8 * hh); const bf16x8 bb = *(const LAS bf16x8*)(KhT + (32 * db + r) * TP + 16 * ks + 8 * hh); l = MFMA32(a, bb, l); }
#pragma unroll
            for (int i = 0; i < 16; ++i) lst[(size_t)(32 * dvb + crow(i, hh)) * 128 + 32 * db + r] = (bf16_t)f2bf(l[i]); }
    }
    __syncthreads();
}
__device__ __forceinline__ void h2_item(Frame& F, int it) {
    const int bh = it >> 4, part = it & 15, dv = 8 * part + (F.tid >> 6), d0 = 2 * (F.tid & 63);
    bf16_t* p = WSP(bf16_t, WS_LST) + ((size_t)bh * 65 * 128 + dv) * 128 + d0; const float* g = WSP(float, WS_GCH) + (size_t)bh * 65 * 128 + d0;
    float s0 = 0.f, s1 = 0.f;
#pragma unroll 8
    for (int c = 0; c < 64; ++c) { const unsigned l = *(const unsigned*)(p + (size_t)c * 16384); const f32x2 gg = *(const f32x2*)(g + c * 128);
        s0 = gg.x * s0 + bflo(l); s1 = gg.y * s1 + bfhi(l); *(unsigned*)(p + (size_t)c * 16384) = pk2(s0, s1); }
}
__device__ __forceinline__ void h3_item(Frame& F, int bh, int c) {
    const int b = bh >> 3, h = bh & 7, lane = F.lane, w = F.wave, tid = F.tid;
    const bf16_t* st = WSP(bf16_t, WS_LST) + (size_t)(bh * 65 + (c - 1)) * 16384; const bf16_t* qg = WSP(bf16_t, WS_QT) + (size_t)(bh * 64 + (c - 1)) * 8192;
    const float* oi = WSP(float, WS_OI) + ((size_t)(bh * 64 + (c - 1)) * 8 + w) * 1024 + lane;
    LAS float* Ot = (LAS float*)F.lds; LAS float* ssq = Ot + 64 * 129;
    const int tb = w >> 2, dvb = w & 3, r = lane & 31, hh = lane >> 5;
    f32x16 o;
#pragma unroll
    for (int i = 0; i < 16; ++i) o[i] = oi[i * 64];
#pragma unroll
    for (int ks = 0; ks < 8; ++ks) { const bf16x8 a = *(const bf16x8*)(st + (size_t)(32 * dvb + r) * 128 + 16 * ks + 8 * hh); const bf16x8 bq = *(const bf16x8*)(qg + (size_t)(32 * tb + r) * 128 + 16 * ks + 8 * hh); o = MFMA32(a, bq, o); }
    float ss = 0.f;
#pragma unroll
    for (int i = 0; i < 16; ++i) { ss += o[i] * o[i]; Ot[(32 * tb + r) * 129 + 32 * dvb + crow(i, hh)] = o[i]; }
    ssq[(dvb * 2 + hh) * 64 + 32 * tb + r] = ss;
    __syncthreads();
    const int t = tid >> 3, d0 = (tid & 7) * 16;
    float sq = 0.f;
#pragma unroll
    for (int k = 0; k < 8; ++k) sq += ssq[k * 64 + t];
    const float rstd = __builtin_amdgcn_rsqf(sq * (1.f / 128.f) + 1e-6f);
    const size_t row = (size_t)(b * SEQ + (c - 1) * 64 + t);
    const bf16_t* gp = WSP(bf16_t, WS_PROJ) + row * PW + PC_HG + h * 128 + d0; const float* ng = F.in[11] + h * 128 + d0;
    bf16_t* yp = WSP(bf16_t, WS_YHG) + row * 1024 + h * 128 + d0;
#pragma unroll
    for (int q = 0; q < 2; ++q) { const v4u gz = *(const v4u*)(gp + 8 * q); const f32x4 n0 = *(const f32x4*)(ng + 8 * q), n1 = *(const f32x4*)(ng + 8 * q + 4);
        const LAS float* op = Ot + t * 129 + d0 + 8 * q;
        v4u wv; wv.x = pk2(op[0] * rstd * n0[0] * silu(bflo(gz.x)), op[1] * rstd * n0[1] * silu(bfhi(gz.x))); wv.y = pk2(op[2] * rstd * n0[2] * silu(bflo(gz.y)), op[3] * rstd * n0[3] * silu(bfhi(gz.y)));
        wv.z = pk2(op[4] * rstd * n1[0] * silu(bflo(gz.z)), op[5] * rstd * n1[1] * silu(bfhi(gz.z))); wv.w = pk2(op[6] * rstd * n1[2] * silu(bflo(gz.w)), op[7] * rstd * n1[3] * silu(bfhi(gz.w)));
        *(v4u*)(yp + 8 * q) = wv; }
    __syncthreads();
}
__device__ __forceinline__ void idx_item(Frame& F, int b, int qblk) {
    const int lane = F.lane, w = F.wave;
    const bf16_t* proj = WSP(bf16_t, WS_PROJ); const bf16_t* ikn = WSP(bf16_t, WS_IKN);
    LAS unsigned* sc = (LAS unsigned*)F.lds;
    const int r0 = 8 * qblk, ntile = (r0 + 8 + 31) >> 5;
    const int p = w & 3, kh = w >> 2, r = lane & 31, hh = lane >> 5;
    {
        const size_t rowq = (size_t)(b * SEQ + r0 + 2 * p + (r >> 4));
        bf16x8 a[4];
#pragma unroll
        for (int ks = 0; ks < 4; ++ks) a[ks] = *(const bf16x8*)(proj + rowq * PW + PC_IQ + (r & 15) * 64 + 16 * ks + 8 * hh);
        float wv[16];
#pragma unroll
        for (int i = 0; i < 16; ++i) { const int rw = crow(i, hh); wv[i] = bf2f(proj[(size_t)(b * SEQ + r0 + 2 * p + (rw >> 4)) * PW + PC_IW + (rw & 15)]) * (1.f / 32.f); }
        const int myr = r0 + 2 * p + hh;
        LAS unsigned* scq = sc + (2 * p + hh) * 4096;
        for (int kt = kh; kt < ntile; kt += 2) {
            const int key = 32 * kt + r; const bf16_t* kp = ikn + (size_t)(b * SEQ + key) * 64 + 8 * hh;
            f32x16 x;
#pragma unroll
            for (int i = 0; i < 16; ++i) x[i] = 0.f;
#pragma unroll
            for (int ks = 0; ks < 4; ++ks) { const bf16x8 bb = *(const bf16x8*)(kp + 16 * ks); x = MFMA32(a[ks], bb, x); }
            float p0 = 0.f, p1 = 0.f;
#pragma unroll
            for (int i = 0; i < 8; ++i) { p0 += wv[i] * fmaxf(x[i], 0.f); p1 += wv[8 + i] * fmaxf(x[8 + i], 0.f); }
            const float send = hh ? p0 : p1; const float recv = __shfl_xor(send, 32); const float tot = (hh ? p1 : p0) + recv;
            unsigned u = __float_as_uint(tot); u = (u & 0x80000000u) ? ~u : (u | 0x80000000u); if (key > myr) u = 0u;
            scq[key] = u;
        }
    }
    __syncthreads();
    {
        const int rq = r0 + w, nvalid = rq + 1, nk = ntile * 32;
        unsigned k[64];
#pragma unroll
        for (int i = 0; i < 64; ++i) { const int idx = lane + 64 * i; k[i] = idx < nk ? sc[w * 4096 + idx] : 0u; }
        unsigned thr = 0u;
        if (nvalid > 256) {
            for (int bit = 31; bit >= 0; --bit) { const unsigned cand = thr | (1u << bit); int cnt = 0;
#pragma unroll
                for (int i = 0; i < 64; ++i) cnt += __popcll(__ballot(k[i] >= cand));
                if (cnt >= 256) thr = cand; }
        }
        int ngt = 0;
#pragma unroll
        for (int i = 0; i < 64; ++i) ngt += __popcll(__ballot(k[i] > thr));
        const int quota = thr != 0u ? 256 - ngt : 0;
        int run = 0, eqrun = 0; unsigned short* out = WSP(unsigned short, WS_SEL) + (size_t)(b * SEQ + rq) * 256;
#pragma unroll
        for (int i = 0; i < 64; ++i) { const bool gt = k[i] > thr, eq = (k[i] == thr) && (thr != 0u);
            const unsigned long long meq = __ballot(eq); const int eqb = eqrun + (int)__builtin_amdgcn_mbcnt_hi((unsigned)(meq >> 32), __builtin_amdgcn_mbcnt_lo((unsigned)meq, 0u));
            const bool take = gt || (eq && eqb < quota);
            const unsigned long long m = __ballot(take); const int pos = run + (int)__builtin_amdgcn_mbcnt_hi((unsigned)(m >> 32), __builtin_amdgcn_mbcnt_lo((unsigned)m, 0u));
            if (take && pos < 256) out[pos] = (unsigned short)(lane + 64 * i);
            run += __popcll(m); eqrun += __popcll(meq); }
    }
    __syncthreads();
}
__device__ __forceinline__ void att_item(Frame& F, int it) {
    const int lane = F.lane, w = F.wave;
    const bf16_t* proj = WSP(bf16_t, WS_PROJ); const unsigned short* sel = WSP(unsigned short, WS_SEL);
    const int b = it >> 10, blk = it & 1023, q = w >> 1, kv = w & 1, rq = 4 * blk + q, tpos = rq + NMETA; const size_t rowq = (size_t)(b * SEQ + rq);
    const int nsel = rq + 1 < 256 ? rq + 1 : 256, ntot = NMETA + nsel;
    LAS int* rowl = (LAS int*)(F.lds + w * 8192); LAS float* dl = (LAS float*)(rowl + 288); LAS float* Pl = dl + 288;
#pragma unroll
    for (int i = 0; i < 5; ++i) { const int n = lane + 64 * i;
        if (n < 272) { int row; float d;
            if (n < NMETA) { row = METAROW + n; d = (float)(tpos - n); }
            else { const int j = n - NMETA; const bool ok = j < nsel; const int s = ok ? (int)sel[rowq * 256 + j] : 0; row = b * SEQ + s; d = ok ? (float)(rq - s) : INFINITY; }
            rowl[n] = row; dl[n] = d; } }
    __syncthreads();
    const int hh = lane & 15, g = lane >> 4;
    bf16x8 qf[4];
#pragma unroll
    for (int ks = 0; ks < 4; ++ks) { bf16x8 z = {0, 0, 0, 0, 0, 0, 0, 0}; if (hh < 4) z = *(const bf16x8*)(proj + rowq * PW + PC_AQ + (kv * 4 + hh) * 128 + 32 * ks + 8 * g); qf[ks] = z; }
    f32x4 acc[17];
#pragma unroll
    for (int T = 0; T < 17; ++T) { const int row = rowl[16 * T + hh]; const bf16_t* kp = proj + (size_t)row * PW + PC_AK + kv * 128 + 8 * g;
        f32x4 x = (f32x4){0.f, 0.f, 0.f, 0.f};
#pragma unroll
        for (int ks = 0; ks < 4; ++ks) { const bf16x8 a = *(const bf16x8*)(kp + 32 * ks); x = MFMA16(a, qf[ks], x); }
        acc[T] = x; }
    const float slope = exp2f(-(float)(kv * 4 + (hh & 3) + 1));
    float mx = -INFINITY;
#pragma unroll
    for (int T = 0; T < 17; ++T) { const f32x4 d4 = *(const LAS f32x4*)(dl + 16 * T + 4 * g);
#pragma unroll
        for (int j = 0; j < 4; ++j) { const float l = acc[T][j] * 0.08838834764831845f - slope * d4[j]; acc[T][j] = l; mx = fmaxf(mx, l); } }
    mx = fmaxf(mx, __shfl_xor(mx, 16)); mx = fmaxf(mx, __shfl_xor(mx, 32));
    float sum = 0.f;
#pragma unroll
    for (int T = 0; T < 17; ++T)
#pragma unroll
        for (int j = 0; j < 4; ++j) { const float e = __expf(acc[T][j] - mx); acc[T][j] = e; sum += e; }
    sum += __shfl_xor(sum, 16); sum += __shfl_xor(sum, 32);
    const float inv = 1.f / sum;
    if (hh < 4) {
#pragma unroll
        for (int T = 0; T < 17; ++T)
#pragma unroll
            for (int j = 0; j < 4; ++j) Pl[(16 * T + 4 * g + j) * 4 + hh] = acc[T][j] * inv; }
    __syncthreads();
    f32x2 o0 = (f32x2){0.f, 0.f}, o1 = o0, o2 = o0, o3 = o0;
    const bf16_t* vbase = proj + PC_AV + kv * 128 + 2 * lane;
#pragma unroll 8
    for (int n = 0; n < ntot; ++n) { const int row = rowl[n]; const unsigned vv = *(const unsigned*)(vbase + (size_t)row * PW); const f32x4 p4 = *(const LAS f32x4*)(Pl + 4 * n);
        const f32x2 v2 = (f32x2){bflo(vv), bfhi(vv)}; o0 += p4[0] * v2; o1 += p4[1] * v2; o2 += p4[2] * v2; o3 += p4[3] * v2; }
    unsigned* yp = (unsigned*)(WSP(bf16_t, WS_YATT) + rowq * 1024 + kv * 512 + 2 * lane);
    yp[0] = pk2(o0.x, o0.y); yp[64] = pk2(o1.x, o1.y); yp[128] = pk2(o2.x, o2.y); yp[192] = pk2(o3.x, o3.y);
    __syncthreads();
}
__device__ __forceinline__ void p11_final_ln(Frame& F) {
    const float* st = WSP(float, WS_ST3); const float* g = F.in[20]; const float* b = F.in[21];
    for (int row = F.gw; row < MR; row += F.NGW) { float mu, rs; row_stats(st, row, mu, rs);
        f32x4* o = (f32x4*)(F.out + (size_t)row * DM);
#pragma unroll
        for (int j = 0; j < 8; ++j) { const int i = F.lane + 64 * j; const f32x4 z = o[i]; o[i] = (z - mu) * rs * ((const f32x4*)g)[i] + ((const f32x4*)b)[i]; } }
}
struct Args { const float* in[22]; float* out; unsigned char* ws; int ph_lo, ph_hi, li, pad; };
constexpr int NPH = 12;
__global__ void __launch_bounds__(512, 2) mk_fwd(Args args) {
    extern __shared__ __attribute__((aligned(16))) unsigned char lds_raw[];
    Frame F;
    F.lds = (LAS unsigned char*)lds_raw;
    F.tid = threadIdx.x; F.lane = F.tid & 63; F.wave = __builtin_amdgcn_readfirstlane(F.tid >> 6);
    F.G = gridDim.x; F.gw = blockIdx.x * 8 + F.wave; F.NGW = F.G * 8;
#pragma unroll
    for (int i = 0; i < 22; ++i) F.in[i] = args.in[i];
    F.out = args.out; F.ws = args.ws;
    volatile LAS unsigned* MISC = (volatile LAS unsigned*)(F.lds + MISC_OFF);
    if (F.tid < 64) MISC[F.tid] = 0u;
    __syncthreads();
    XcdBarrier bar = xcd_barrier_post((unsigned*)(F.ws + WS_CTL) + CW_BAR + args.li * XCD_BAR_WORDS, MISC + 8);
    const int lo = args.ph_lo, hi = args.ph_hi;
#define IN(k) (lo <= (k) && (k) < hi)
#define SEAM(k) do { if (IN(k) && IN((k) + 1)) xcd_barrier(bar); } while (0)
    const int bid = blockIdx.x;

    if (IN(0)) { p0_prologue(F); } SEAM(0);
    if (IN(1)) {
        p1_colsums(F);
        Gemm g{WSP(bf16_t, WS_H0B), WSP(bf16_t, WS_WGU1), MPAD, NGU, DM}; StaticOrder S; S.init(MPAD, NGU, F.G, bid);
        EpiSwiGLU<false> E{WSP(bf16_t, WS_G), DFF, nullptr, nullptr, nullptr};
        gemm_phase<EpiSwiGLU<false>, StaticOrder, true, true>(F.lds, g, S, E);
    } SEAM(1);
    if (IN(2)) {
        p2_meta_down(F);
        Gemm g{WSP(bf16_t, WS_G), WSP(bf16_t, WS_WD1), MR, DM, DFF}; StaticOrder S; S.init(MR, DM, F.G, bid);
        EpiResid<0> E{F.in[0], nullptr, nullptr, nullptr, nullptr, WSP(bf16_t, WS_Z1B), nullptr, WSP(float, WS_ST1), 0.5f};
        gemm_phase<EpiResid<0>, StaticOrder, false, true>(F.lds, g, S, E);
    } SEAM(2);
    if (IN(3)) {
        p3_meta_stats(F);
        Gemm g{WSP(bf16_t, WS_Z1B), WSP(bf16_t, WS_WIN), MPAD, PW, DM}; StaticOrder S; S.init(MPAD, PW, F.G, bid);
        EpiProj E{WSP(bf16_t, WS_PROJ), PW, WSP(float, WS_ST1), WSP(float, WS_CSV), WSP(float, WS_BWV), (const LAS float*)(F.lds + MSTAT_OFF)};
        gemm_phase<EpiProj, StaticOrder, true, true>(F.lds, g, S, E);
    } SEAM(3);
    if (IN(4)) {
        p4_ikn(F);
        for (int it = bid; it < 16 * 65; it += F.G) h1_item(F, it / 65, it % 65);
    } SEAM(4);
    if (IN(5)) {
        for (int it = bid; it < 256; it += F.G) h2_item(F, it);
        for (int it = bid; it < 1024; it += F.G) { const int j = it >> 8, x = it & 255; idx_item(F, j >> 1, (j & 1) ? 511 - x : x); }
    } SEAM(5);
    if (IN(6)) {
        for (int it = bid; it < 16 * 64; it += F.G) h3_item(F, it >> 6, (it & 63) + 1);
        for (int it = bid; it < 2048; it += F.G) att_item(F, it);
    } SEAM(6);
    if (IN(7)) {
        { Gemm g{WSP(bf16_t, WS_YATT), WSP(bf16_t, WS_WBA), MR, DM, 1024}; StaticOrder S; S.init(MR, DM, F.G, bid);
          EpiBranch<0> E{WSP(bf16_t, WS_PROJ), PW, PC_GA, WSP(bf16_t, WS_T1), nullptr};
          gemm_phase<EpiBranch<0>, StaticOrder, false, true>(F.lds, g, S, E); }
        __syncthreads();
        { Gemm g{WSP(bf16_t, WS_YHG), WSP(bf16_t, WS_WBH), MR, DM, 1024}; StaticOrder S; S.init(MR, DM, F.G, bid);
          EpiBranch<1> E{WSP(bf16_t, WS_PROJ), PW, PC_GH, WSP(bf16_t, WS_T1), WSP(bf16_t, WS_MRG)};
          gemm_phase<EpiBranch<1>, StaticOrder, false, true>(F.lds, g, S, E); }
    } SEAM(7);
    if (IN(8)) {
        Gemm g{WSP(bf16_t, WS_MRG), WSP(bf16_t, WS_WOUT), MR, DM, DM}; StaticOrder S; S.init(MR, DM, F.G, bid);
        EpiResid<1> E{nullptr, WSP(bf16_t, WS_Z1B), WSP(float, WS_ST1), F.in[5], F.in[6], WSP(bf16_t, WS_Z2B), nullptr, WSP(float, WS_ST2), 1.0f};
        gemm_phase<EpiResid<1>, StaticOrder, false, true>(F.lds, g, S, E);
    } SEAM(8);
    if (IN(9)) {
        Gemm g{WSP(bf16_t, WS_Z2B), WSP(bf16_t, WS_WGU2), MR, NGU, DM}; StaticOrder S; S.init(MR, NGU, F.G, bid);
        EpiSwiGLU<true> E{WSP(bf16_t, WS_G2), DFF, WSP(float, WS_ST2), WSP(float, WS_CSV) + PW, WSP(float, WS_BWV) + PW};
        gemm_phase<EpiSwiGLU<true>, StaticOrder, true, true>(F.lds, g, S, E);
    } SEAM(9);
    if (IN(10)) {
        Gemm g{WSP(bf16_t, WS_G2), WSP(bf16_t, WS_WD2), MR, DM, DFF}; StaticOrder S; S.init(MR, DM, F.G, bid);
        EpiResid<2> E{nullptr, WSP(bf16_t, WS_Z2B), WSP(float, WS_ST2), F.in[15], F.in[16], nullptr, F.out, WSP(float, WS_ST3), 0.5f};
        gemm_phase<EpiResid<2>, StaticOrder, false, true>(F.lds, g, S, E);
    } SEAM(10);
    if (IN(11)) { p11_final_ln(F); }
#undef IN
#undef SEAM
}

#ifndef MK_CUTS
#define MK_CUTS {0, NPH}
#endif
extern "C" void kernel_launch(void* const* d_in, const int* in_sizes, int n_in, void* d_out, int out_size, void* d_ws, size_t ws_size, hipStream_t stream) {
    static int grid = 0;
    if (grid == 0) {
        if (n_in != 22 || out_size != MR * DM || ws_size < WS_END) { fprintf(stderr, "kernel_launch: unexpected shapes (n_in %d, out %d, ws %zu < %zu)\n", n_in, out_size, ws_size, (size_t)WS_END); grid = -1; return; }
        int dev = 0, cus = 0, per_cu = 0;
        if (hipGetDevice(&dev) != hipSuccess || hipDeviceGetAttribute(&cus, hipDeviceAttributeMultiprocessorCount, dev) != hipSuccess) { grid = -1; return; }
        if (hipFuncSetAttribute((const void*)mk_fwd, hipFuncAttributeMaxDynamicSharedMemorySize, LDS_BYTES) != hipSuccess) { fprintf(stderr, "kernel_launch: hipFuncSetAttribute failed\n"); grid = -1; return; }
        if (hipOccupancyMaxActiveBlocksPerMultiprocessor(&per_cu, (const void*)mk_fwd, 512, LDS_BYTES) != hipSuccess || per_cu < 1) { fprintf(stderr, "kernel_launch: occupancy query says %d blocks per CU\n", per_cu); grid = -1; (void)hipGetLastError(); return; }
        grid = cus;
        if (grid != 256) fprintf(stderr, "kernel_launch: %d CUs; the one-unit-per-workgroup GEMM phases assume 256\n", grid);
    }
    if (grid < 0) return;
    (void)hipMemsetAsync((char*)d_ws + WS_CTL, 0, CTL_BYTES, stream);
    Args a{};
    for (int i = 0; i < 22; ++i) a.in[i] = (const float*)d_in[i];
    a.out = (float*)d_out; a.ws = (unsigned char*)d_ws;
    const int cuts[] = MK_CUTS; const int nl = (int)(sizeof(cuts) / sizeof(int)) - 1;
    for (int li = 0; li < nl; ++li) {
        a.ph_lo = cuts[li]; a.ph_hi = cuts[li + 1]; a.li = li; a.pad = 0;
        void* kargs[] = {&a};
        const hipError_t e = hipLaunchCooperativeKernel((const void*)mk_fwd, dim3(grid), dim3(512), kargs, LDS_BYTES, stream);
        if (e != hipSuccess) { fprintf(stderr, "kernel_launch: cooperative launch %d failed: %s\n", li, hipGetErrorString(e)); break; }
    }
}
```

```cpp
#include <hip/hip_runtime.h>
#include <cstdio>
#include <cstdint>
namespace pg8 {
#define PG8_LAS __attribute__((address_space(3)))
typedef unsigned short bf16_t;
typedef short bf16x8 __attribute__((ext_vector_type(8)));
typedef float f32x4 __attribute__((ext_vector_type(4)));
typedef unsigned u32x4 __attribute__((ext_vector_type(4)));
constexpr int BM = 256, BK = 64, HALF = 128, HTB = HALF * BK * 2  , STAGE_BYTES = 8 * HTB, NXCD = 8, WGM = 8;

__host__ __device__ __forceinline__ int lds_byte(int r, int c) { const int st = (r >> 4) * 2 + (c >> 5), rr = r & 15, cc = c & 31, ob = rr * 64 + cc * 2; return st * 1024 + (ob ^ (((ob >> 9) & 1) << 5)); }
__host__ __device__ __forceinline__ void stage_rc(int b, int& R, int& C) { const int st = b / 1024, sb = b % 1024, swz = sb ^ (((sb >> 9) & 1) << 5); R = (st >> 1) * 16 + swz / 64; C = (st & 1) * 32 + (swz % 64) / 2; }
__host__ __device__ __forceinline__ int perm32(int rho) { const int n = rho >> 4, i = rho & 15; return 8 * (i >> 2) + 4 * n + (i & 3); }

struct Unit { int pm, pn; };
struct Gemm { const bf16_t* A; const bf16_t* Bt; int M, N, K; };

struct StaticOrder {
    int nM, nN, nwg, G, c;
    __host__ __device__ void init(int M, int N, int G_, int c_) { nM = M / BM; nN = N / BM; nwg = nM * nN; G = G_; c = c_; }
    __host__ __device__ bool next(int i, Unit& u) const {
        const long L = (long)i * G + c; if (L >= nwg) return false;
        int wgid = (int)L; { const int q = nwg / NXCD, r = nwg % NXCD, xcd = wgid % NXCD, off = wgid / NXCD; wgid = (xcd < r ? xcd * (q + 1) : r * (q + 1) + (xcd - r) * q) + off; }
        const int nig = WGM * nN, gid = wgid / nig, fm = gid * WGM, gsz = (nM - fm) < WGM ? (nM - fm) : WGM;
        u.pm = fm + ((wgid % nig) % gsz); u.pn = (wgid % nig) / gsz; return true;
    }
    __device__ __forceinline__ void a_ready(const Unit&) const {}
    __device__ __forceinline__ void done(const Unit&) const {}
};

__device__ __forceinline__ unsigned cvt_pk_bf16(float lo, float hi) { unsigned r; asm volatile("v_cvt_pk_bf16_f32 %0, %1, %2" : "=v"(r) : "v"(lo), "v"(hi)); return r; }
typedef float f32x2 __attribute__((ext_vector_type(2)));
typedef unsigned u32x2 __attribute__((ext_vector_type(2)));
__device__ __forceinline__ float bflo(unsigned w) { return __uint_as_float(w << 16); }
__device__ __forceinline__ float bfhi(unsigned w) { return __uint_as_float(w & 0xffff0000u); }
__device__ __forceinline__ float sigm(float x) { return __builtin_amdgcn_rcpf(1.f + __expf(-x)); }
__device__ __forceinline__ float silu(float x) { return x * sigm(x); }
__device__ __forceinline__ void row_stats(const float* slab, int row, float& mu, float& rstd) {
    const f32x4* p = (const f32x4*)(slab + (size_t)row * 16);
    const f32x4 a = p[0], b = p[1], c = p[2], d = p[3];
    const float s = ((a[0] + a[2]) + (b[0] + b[2])) + ((c[0] + c[2]) + (d[0] + d[2]));
    const float q = ((a[1] + a[3]) + (b[1] + b[3])) + ((c[1] + c[3]) + (d[1] + d[3]));
    mu = s * (1.0f / 2048.0f);
    const float var = fmaxf(q * (1.0f / 2048.0f) - mu * mu, 0.f);
    rstd = __builtin_amdgcn_rsqf(var + 1e-5f);
}
template <bool LNF> struct EpiSwiGLU {
    static constexpr bool PERM = true, AFTER_DRAIN = false;
    bf16_t* O; int ldc; const float* slab; const float* cs; const float* bw;
    __device__ __forceinline__ void operator()(const f32x4 (&acc)[2][2][4][2], const Unit& u, int wr, int wc, int fr, int fq) const {
        const int row0 = u.pm * BM + wr * 64 + fr;
        const int ocol = u.pn * 128 + wc * 32 + 8 * fq;
        const int brow = u.pn * BM + wc * 32 + 8 * fq;
        f32x4 csg[2], csu[2], bwg[2], bwu[2];
#pragma unroll
        for (int n = 0; n < 2; ++n) {
            if (LNF) { csg[n] = *(const f32x4*)(cs + brow + 4 * n); csu[n] = *(const f32x4*)(cs + brow + 128 + 4 * n); bwg[n] = *(const f32x4*)(bw + brow + 4 * n); bwu[n] = *(const f32x4*)(bw + brow + 128 + 4 * n); }
            else { csg[n] = csu[n] = bwg[n] = bwu[n] = (f32x4){0.f, 0.f, 0.f, 0.f}; }
        }
#pragma unroll
        for (int ai = 0; ai < 2; ++ai)
#pragma unroll
            for (int m = 0; m < 4; ++m) {
                const int row = row0 + ai * HALF + m * 16;
                float mu = 0.f, rs = 1.f; if (LNF) row_stats(slab, row, mu, rs);
                u32x4 w;
#pragma unroll
                for (int n = 0; n < 2; ++n) {
                    f32x4 g = acc[ai][0][m][n], up = acc[ai][1][m][n];
                    if (LNF) { g = (g - mu * csg[n]) * rs + bwg[n]; up = (up - mu * csu[n]) * rs + bwu[n]; }
                    const float o0 = silu(g[0]) * up[0], o1 = silu(g[1]) * up[1], o2 = silu(g[2]) * up[2], o3 = silu(g[3]) * up[3];
                    w[2 * n] = cvt_pk_bf16(o0, o1); w[2 * n + 1] = cvt_pk_bf16(o2, o3);
                }
                *(u32x4*)(O + (size_t)row * ldc + ocol) = w;
            }
    }
};
struct EpiProj {
    static constexpr bool PERM = true, AFTER_DRAIN = false;
    bf16_t* O; int ldc; const float* slab; const float* cs; const float* bw; const PG8_LAS float* mstat;
    __device__ __forceinline__ void operator()(const f32x4 (&acc)[2][2][4][2], const Unit& u, int wr, int wc, int fr, int fq) const {
        const int col0 = u.pn * BM + wc * 32 + 8 * fq;
        f32x4 cv[2][2], bv[2][2];
#pragma unroll
        for (int bj = 0; bj < 2; ++bj)
#pragma unroll
            for (int n = 0; n < 2; ++n) { cv[bj][n] = *(const f32x4*)(cs + col0 + bj * HALF + 4 * n); bv[bj][n] = *(const f32x4*)(bw + col0 + bj * HALF + 4 * n); }
#pragma unroll
        for (int ai = 0; ai < 2; ++ai)
#pragma unroll
            for (int m = 0; m < 4; ++m) {
                const int lr = ai * HALF + wr * 64 + m * 16 + fr, row = u.pm * BM + lr;
                float mu, rs;
                if (u.pm == 32) { if (lr < 16) { mu = mstat[2 * lr]; rs = mstat[2 * lr + 1]; } else { mu = 0.f; rs = 0.f; } }
                else row_stats(slab, row, mu, rs);
#pragma unroll
                for (int bj = 0; bj < 2; ++bj) {
                    const f32x4 v0 = (acc[ai][bj][m][0] - mu * cv[bj][0]) * rs + bv[bj][0], v1 = (acc[ai][bj][m][1] - mu * cv[bj][1]) * rs + bv[bj][1];
                    u32x4 w; w.x = cvt_pk_bf16(v0[0], v0[1]); w.y = cvt_pk_bf16(v0[2], v0[3]); w.z = cvt_pk_bf16(v1[0], v1[1]); w.w = cvt_pk_bf16(v1[2], v1[3]);
                    *(u32x4*)(O + (size_t)row * ldc + col0 + bj * HALF) = w;
                }
            }
    }
};
template <int MODE> struct EpiResid {
    static constexpr bool PERM = false, AFTER_DRAIN = true;
    const float* xres; const bf16_t* zprev; const float* pslab; const float* lg; const float* lb; bf16_t* zb; float* zf; float* oslab; float sc;
    __device__ __forceinline__ void fused(f32x4 (&acc)[2][2][4][2], const Unit& u, int wr, int wc, int fr, int fq, PG8_LAS unsigned char* lds, int wid, int lane) const {
        const float alpha = 1.18920711500272f;
        const int col0 = u.pn * BM + wc * 32 + 4 * fq;
        PG8_LAS float* P = (PG8_LAS float*)lds;
#pragma unroll
        for (int ai = 0; ai < 2; ++ai)
#pragma unroll
            for (int m = 0; m < 4; ++m) {
                const int lr = ai * HALF + wr * 64 + m * 16 + fr, row = u.pm * BM + lr;
                float mu = 0.f, rs = 1.f; if (MODE != 0) row_stats(pslab, row, mu, rs);
                float s1 = 0.f, s2 = 0.f;
#pragma unroll
                for (int bj = 0; bj < 2; ++bj)
#pragma unroll
                    for (int n = 0; n < 2; ++n) {
                        const int c = col0 + bj * HALF + n * 16; const size_t off = (size_t)row * 2048 + c;
                        f32x4 res;
                        if (MODE == 0) res = *(const f32x4*)(xres + off);
                        else { const u32x2 zz = *(const u32x2*)(zprev + off); const f32x4 zv = (f32x4){bflo(zz.x), bfhi(zz.x), bflo(zz.y), bfhi(zz.y)};
                               res = (zv - mu) * rs * *(const f32x4*)(lg + c) + *(const f32x4*)(lb + c); }
                        const f32x4 z = alpha * res + sc * acc[ai][bj][m][n];
                        s1 += (z[0] + z[1]) + (z[2] + z[3]); s2 += (z[0] * z[0] + z[1] * z[1]) + (z[2] * z[2] + z[3] * z[3]);
                        if (MODE == 2) *(f32x4*)(zf + off) = z;
                        else { u32x2 w; w.x = cvt_pk_bf16(z[0], z[1]); w.y = cvt_pk_bf16(z[2], z[3]); *(u32x2*)(zb + off) = w; }
                    }
                s1 += __shfl_xor(s1, 16); s1 += __shfl_xor(s1, 32); s2 += __shfl_xor(s2, 16); s2 += __shfl_xor(s2, 32);
                if (fq == 0) { P[(lr * 4 + wc) * 2] = s1; P[(lr * 4 + wc) * 2 + 1] = s2; }
            }
        __syncthreads();
        const int tid = wid * 64 + lane;
        if (tid < 256) {
            const PG8_LAS float* p = P + tid * 8;
            const float a = (p[0] + p[2]) + (p[4] + p[6]), b = (p[1] + p[3]) + (p[5] + p[7]);
            float* o = oslab + ((size_t)(u.pm * BM + tid) * 8 + u.pn) * 2; o[0] = a; o[1] = b;
        }
    }
};
template <int SECOND> struct EpiBranch {
    static constexpr bool PERM = true, AFTER_DRAIN = false;
    const bf16_t* proj; int ldp, gcol; bf16_t* t1; bf16_t* out;
    __device__ __forceinline__ void operator()(const f32x4 (&acc)[2][2][4][2], const Unit& u, int wr, int wc, int fr, int fq) const {
        const int col0 = u.pn * BM + wc * 32 + 8 * fq;
#pragma unroll
        for (int ai = 0; ai < 2; ++ai)
#pragma unroll
            for (int m = 0; m < 4; ++m) {
                const int row = u.pm * BM + ai * HALF + wr * 64 + m * 16 + fr;
#pragma unroll
                for (int bj = 0; bj < 2; ++bj) {
                    const int c = col0 + bj * HALF;
                    const u32x4 gz = *(const u32x4*)(proj + (size_t)row * ldp + gcol + c);
                    u32x4 tz = (u32x4){0u, 0u, 0u, 0u}; if (SECOND) tz = *(const u32x4*)(t1 + (size_t)row * 2048 + c);
                    const f32x4 a0 = acc[ai][bj][m][0], a1 = acc[ai][bj][m][1];
                    const float v0 = bflo(tz.x) + sigm(bflo(gz.x)) * a0[0], v1 = bfhi(tz.x) + sigm(bfhi(gz.x)) * a0[1], v2 = bflo(tz.y) + sigm(bflo(gz.y)) * a0[2], v3 = bfhi(tz.y) + sigm(bfhi(gz.y)) * a0[3];
                    const float v4 = bflo(tz.z) + sigm(bflo(gz.z)) * a1[0], v5 = bfhi(tz.z) + sigm(bfhi(gz.z)) * a1[1], v6 = bflo(tz.w) + sigm(bflo(gz.w)) * a1[2], v7 = bfhi(tz.w) + sigm(bfhi(gz.w)) * a1[3];
                    u32x4 w; w.x = cvt_pk_bf16(v0, v1); w.y = cvt_pk_bf16(v2, v3); w.z = cvt_pk_bf16(v4, v5); w.w = cvt_pk_bf16(v6, v7);
                    *(u32x4*)((SECOND ? out : t1) + (size_t)row * 2048 + c) = w;
                }
            }
    }
};

template <class Epi, class Sched, bool ALIGN_EPI = false, bool SP2 = false>
__device__ __forceinline__ void gemm_phase(PG8_LAS unsigned char* lds, const Gemm g, const Sched& S, const Epi& E) {
    const int tid = threadIdx.x, wid = __builtin_amdgcn_readfirstlane(tid >> 6), lane = tid & 63, wr = wid >> 2, wc = wid & 3, fr = lane & 15, fq = lane >> 4;
    const int K = g.K, nt = K / BK;
    unsigned voffA[2], voffB[2];
#pragma unroll
    for (int i = 0; i < 2; ++i) { int R, C; stage_rc(tid * 16 + i * 8192, R, C); const int Rb = Epi::PERM ? ((R & ~31) + perm32(R & 31)) : R;
        voffA[i] = (unsigned)(R * K + C) * 2u; voffB[i] = (unsigned)(Rb * K + C) * 2u; }
    const size_t kstep = (size_t)(BK * 2);
    const size_t hstep = (size_t)HALF * K * 2;
    const size_t tstep = 2 * hstep;
    const unsigned ldsw = (unsigned)wid * 1024u;
    const int aoff = lds_byte(wr * 64 + fr, fq * 8), boff = lds_byte(wc * 32 + fr, fq * 8);
#define PG8_SA(b, h) (((b) * 2 + (h)) * HTB)
#define PG8_SB(b, h) ((4 + (b) * 2 + (h)) * HTB)
#define PG8_STAGE(bufoff, gbase, voff) do { _Pragma("unroll") for (int _i = 0; _i < 2; ++_i) \
        __builtin_amdgcn_global_load_lds((const unsigned*)((const char*)(gbase) + (voff)[_i]), (PG8_LAS unsigned*)(lds + (bufoff) + ldsw + _i * 8192), 16, 0, 0); } while (0)
#define PG8_LDA(dst, b, h) do { _Pragma("unroll") for (int m = 0; m < 4; ++m) _Pragma("unroll") for (int k = 0; k < 2; ++k) dst[m][k] = *(const PG8_LAS bf16x8*)(lds + PG8_SA(b, h) + aoff + m * 2048 + k * 1024); } while (0)
#define PG8_LDB(dst, b, h) do { _Pragma("unroll") for (int n = 0; n < 2; ++n) _Pragma("unroll") for (int k = 0; k < 2; ++k) dst[n][k] = *(const PG8_LAS bf16x8*)(lds + PG8_SB(b, h) + boff + n * 2048 + k * 1024); } while (0)
#define PG8_MMA(ai, bj, At, Bt) do { __builtin_amdgcn_s_setprio(1); _Pragma("unroll") for (int m = 0; m < 4; ++m) _Pragma("unroll") for (int n = 0; n < 2; ++n) _Pragma("unroll") for (int k = 0; k < 2; ++k) \
        acc[ai][bj][m][n] = __builtin_amdgcn_mfma_f32_16x16x32_bf16(Bt[n][k], At[m][k], acc[ai][bj][m][n], 0, 0, 0); __builtin_amdgcn_s_setprio(0); } while (0)
#define PG8_WAIT_V(n) asm volatile("s_waitcnt vmcnt(" #n ")" ::: "memory")
#define PG8_WAIT_L(n) asm volatile("s_waitcnt lgkmcnt(" #n ")" ::: "memory")
#define PG8_BAR __builtin_amdgcn_s_barrier()
#define PG8_SCHED __builtin_amdgcn_sched_barrier(0)
    Unit cur, nxt; int ui = 0;
    if (!S.next(0, cur)) return;
    f32x4 acc[2][2][4][2];
#pragma unroll
    for (int a = 0; a < 2; ++a)
#pragma unroll
        for (int b = 0; b < 2; ++b)
#pragma unroll
            for (int m = 0; m < 4; ++m)
#pragma unroll
                for (int n = 0; n < 2; ++n) acc[a][b][m][n] = (f32x4){0.f, 0.f, 0.f, 0.f};
    bf16x8 At[4][2], B0[2][2], B1[2][2];
    const char* cA = (const char*)g.A + (size_t)cur.pm * tstep; const char* cB = (const char*)g.Bt + (size_t)cur.pn * tstep;
    S.a_ready(cur);
    if constexpr (SP2) {
        PG8_STAGE(PG8_SB(0, 0), cB, voffB); PG8_STAGE(PG8_SB(0, 1), cB + hstep, voffB); PG8_STAGE(PG8_SA(0, 0), cA, voffA); PG8_STAGE(PG8_SA(0, 1), cA + hstep, voffA);
        if (wr == 1) PG8_BAR;
        PG8_WAIT_V(2); PG8_BAR;
        PG8_STAGE(PG8_SB(1, 0), cB + kstep, voffB); PG8_STAGE(PG8_SA(1, 0), cA + kstep, voffA); PG8_STAGE(PG8_SB(1, 1), cB + hstep + kstep, voffB);
        PG8_WAIT_V(6); PG8_BAR;
    } else {
        PG8_STAGE(PG8_SB(0, 0), cB, voffB); PG8_STAGE(PG8_SA(0, 0), cA, voffA); PG8_STAGE(PG8_SB(0, 1), cB + hstep, voffB); PG8_STAGE(PG8_SA(0, 1), cA + hstep, voffA);
        if (wr == 1) PG8_BAR;
        PG8_WAIT_V(4); PG8_BAR;
        PG8_STAGE(PG8_SB(1, 0), cB + kstep, voffB); PG8_STAGE(PG8_SA(1, 0), cA + kstep, voffA); PG8_STAGE(PG8_SB(1, 1), cB + hstep + kstep, voffB);
        PG8_WAIT_V(6); PG8_BAR;
    }
    for (;;) {
        const bool has_next = S.next(ui + 1, nxt);
        const char* nA = has_next ? (const char*)g.A + (size_t)nxt.pm * tstep : cA; const char* nB = has_next ? (const char*)g.Bt + (size_t)nxt.pn * tstep : cB;
        for (int t = 0; t < nt; t += 2) {
            const bool last = (t == nt - 2);
            const char* a1 = cA + (size_t)(t + 1) * kstep;
            const char* a2 = last ? nA : cA + (size_t)(t + 2) * kstep; const char* b2 = last ? nB : cB + (size_t)(t + 2) * kstep;
            const char* a3 = a2 + kstep; const char* b3 = b2 + kstep;
            if (last && has_next) S.a_ready(nxt);
            if constexpr (SP2) {
            PG8_LDB(B0, 0, 0); PG8_LDB(B1, 0, 1); PG8_SCHED; PG8_LDA(At, 0, 0); PG8_STAGE(PG8_SA(1, 1), a1 + hstep, voffA);
            PG8_WAIT_V(8); PG8_WAIT_L(0); PG8_BAR; PG8_MMA(0, 0, At, B0); PG8_MMA(0, 1, At, B1); PG8_BAR; PG8_SCHED;
            PG8_LDA(At, 0, 1); PG8_STAGE(PG8_SB(0, 0), b2, voffB); PG8_STAGE(PG8_SB(0, 1), b2 + hstep, voffB); PG8_STAGE(PG8_SA(0, 0), a2, voffA);
            PG8_WAIT_V(8); PG8_WAIT_L(0); PG8_BAR; PG8_MMA(1, 0, At, B0); PG8_MMA(1, 1, At, B1); PG8_BAR; PG8_SCHED;
            PG8_LDB(B0, 1, 0); PG8_LDB(B1, 1, 1); PG8_SCHED; PG8_LDA(At, 1, 0); PG8_STAGE(PG8_SA(0, 1), a2 + hstep, voffA);
            PG8_WAIT_V(8); PG8_WAIT_L(0); PG8_BAR; PG8_MMA(0, 0, At, B0); PG8_MMA(0, 1, At, B1); PG8_BAR; PG8_SCHED;
            PG8_LDA(At, 1, 1); PG8_STAGE(PG8_SB(1, 0), b3, voffB); PG8_STAGE(PG8_SB(1, 1), b3 + hstep, voffB); PG8_STAGE(PG8_SA(1, 0), a3, voffA);
            PG8_WAIT_V(8); PG8_WAIT_L(0); PG8_BAR; PG8_MMA(1, 0, At, B0); PG8_MMA(1, 1, At, B1); PG8_BAR; PG8_SCHED;
            } else {
            PG8_LDB(B0, 0, 0); PG8_SCHED; PG8_LDA(At, 0, 0); PG8_STAGE(PG8_SA(1, 1), a1 + hstep, voffA);
            PG8_WAIT_L(8); PG8_BAR; PG8_WAIT_L(0); PG8_MMA(0, 0, At, B0); PG8_BAR; PG8_SCHED;
            PG8_LDB(B1, 0, 1); PG8_STAGE(PG8_SB(0, 0), b2, voffB);
            PG8_BAR; PG8_WAIT_L(0); PG8_MMA(0, 1, At, B1); PG8_BAR;
            PG8_LDA(At, 0, 1); PG8_STAGE(PG8_SA(0, 0), a2, voffA);
            PG8_BAR; PG8_WAIT_L(0); PG8_MMA(1, 0, At, B0); PG8_BAR; PG8_SCHED;
            PG8_STAGE(PG8_SB(0, 1), b2 + hstep, voffB);
            PG8_WAIT_V(6); PG8_BAR; PG8_MMA(1, 1, At, B1); PG8_BAR;
            PG8_LDB(B0, 1, 0); PG8_SCHED; PG8_LDA(At, 1, 0); PG8_STAGE(PG8_SA(0, 1), a2 + hstep, voffA);
            PG8_WAIT_L(8); PG8_BAR; PG8_WAIT_L(0); PG8_MMA(0, 0, At, B0); PG8_BAR; PG8_SCHED;
            PG8_LDB(B1, 1, 1); PG8_STAGE(PG8_SB(1, 0), b3, voffB);
            PG8_BAR; PG8_WAIT_L(0); PG8_MMA(0, 1, At, B1); PG8_BAR;
            PG8_LDA(At, 1, 1); PG8_STAGE(PG8_SA(1, 0), a3, voffA);
            PG8_BAR; PG8_WAIT_L(0); PG8_MMA(1, 0, At, B0); PG8_BAR; PG8_SCHED;
            PG8_STAGE(PG8_SB(1, 1), b3 + hstep, voffB);
            PG8_WAIT_V(6); PG8_BAR; PG8_MMA(1, 1, At, B1); PG8_BAR;
            }
        }
        if constexpr (ALIGN_EPI) { if (wr == 0) PG8_BAR; }
        if constexpr (!Epi::AFTER_DRAIN) { E(acc, cur, wr, wc, fr, fq); S.done(cur); }
        if (!has_next) break;
#pragma unroll
        for (int a = 0; a < 2; ++a)
#pragma unroll
            for (int b = 0; b < 2; ++b)
#pragma unroll
                for (int m = 0; m < 4; ++m)
#pragma unroll
                    for (int n = 0; n < 2; ++n) acc[a][b][m][n] = (f32x4){0.f, 0.f, 0.f, 0.f};
        cur = nxt; cA = nA; cB = nB; ++ui;
        if constexpr (ALIGN_EPI) { if (wr == 1) PG8_BAR; }
    }
    PG8_WAIT_V(0);
    if constexpr (!ALIGN_EPI) { if (wr == 0) PG8_BAR; }
    PG8_BAR;
    if constexpr (Epi::AFTER_DRAIN) { E.fused(acc, cur, wr, wc, fr, fq, lds, wid, lane); S.done(cur); }
#undef PG8_SA
#undef PG8_SB
#undef PG8_STAGE
#undef PG8_LDA
#undef PG8_LDB
#undef PG8_MMA
#undef PG8_WAIT_V
#undef PG8_WAIT_L
#undef PG8_BAR
#undef PG8_SCHED
}
}
using namespace pg8;
#define LAS __attribute__((address_space(3)))
typedef short s16x4 __attribute__((ext_vector_type(4)));
typedef float f32x16 __attribute__((ext_vector_type(16)));
typedef float f32x2 __attribute__((ext_vector_type(2)));
#define MFMA32(a, b, c) __builtin_amdgcn_mfma_f32_32x32x16_bf16((a), (b), (c), 0, 0, 0)
#define MFMA16(a, b, c) __builtin_amdgcn_mfma_f32_16x16x32_bf16((a), (b), (c), 0, 0, 0)
#define LDS_WAIT() asm volatile("s_waitcnt lgkmcnt(0)" ::: "memory")

constexpr int NBATCH = 2, SEQ = 4096, DM = 2048, NMETA = 16, MR = NBATCH * SEQ  , MPAD = 8448  , METAROW = 8192;
constexpr int DFF = 5632, NGU = 2 * DFF, PW = 11008  , NPROJ = 10832;
constexpr int PC_AQ = 0, PC_AK = 1024, PC_AV = 1280, PC_IQ = 1536, PC_HQ = 2560, PC_HF = 3584, PC_HI = 4608, PC_HG = 5632, PC_GA = 6656, PC_GH = 8704, PC_IK = 10752, PC_IW = 10816;
constexpr int NCS = PW + NGU;
constexpr size_t MiB = 1u << 20;
constexpr size_t WS_CTL = 0, CTL_BYTES = 1 * MiB;
constexpr size_t WS_PCS = 1 * MiB, WS_PBW = 4 * MiB, WS_CSV = 7 * MiB, WS_BWV = 7 * MiB + 131072, WS_Z1M = 7 * MiB + 262144, WS_ST1 = 8 * MiB, WS_ST2 = 9 * MiB, WS_ST3 = 10 * MiB;
constexpr size_t WS_WGU1 = 11 * MiB, WS_WD1 = 55 * MiB, WS_H0B = 77 * MiB, WS_G = 110 * MiB, WS_PROJ = 11 * MiB, WS_G2 = 11 * MiB;
constexpr size_t WS_WIN = 201 * MiB, WS_IKN = 201 * MiB, WS_SEL = 202 * MiB, WS_GCH = 206 * MiB, WS_YATT = 207 * MiB, WS_YHG = 223 * MiB;
constexpr size_t WS_WBA = 244 * MiB, WS_WBH = 248 * MiB, WS_WOUT = 252 * MiB, WS_WGU2 = 260 * MiB, WS_WD2 = 304 * MiB, WS_Z1B = 326 * MiB;
constexpr size_t WS_QT = 359 * MiB, WS_OI = 375 * MiB, WS_LST = 407 * MiB, WS_T1 = 359 * MiB, WS_MRG = 391 * MiB, WS_Z2B = 359 * MiB, WS_END = 440 * MiB;
static_assert(WS_G + (size_t)MPAD * DFF * 2 <= WS_WIN && WS_PROJ + (size_t)MPAD * PW * 2 <= WS_WIN && WS_LST + (size_t)16 * 65 * 32768 <= WS_END && WS_ST1 + (size_t)MPAD * 64 <= WS_ST2, "ws map");
constexpr int CW_BAR = 4096;
constexpr int RING_BYTES = 131072, MISC_OFF = RING_BYTES, MSTAT_OFF = RING_BYTES + 256, LDS_BYTES = 147456;

typedef unsigned v4u __attribute__((ext_vector_type(4)));
__device__ __forceinline__ unsigned f2bf(float f) { unsigned u = __builtin_bit_cast(unsigned, f); return (u + 0x7fffu + ((u >> 16) & 1u)) >> 16; }
__device__ __forceinline__ unsigned pk2(float lo, float hi) { return f2bf(lo) | (f2bf(hi) << 16); }
__device__ __forceinline__ float bf2f(unsigned short h) { return __uint_as_float(((unsigned)h) << 16); }
__device__ __forceinline__ float bfround(float x) { return __uint_as_float(f2bf(x) << 16); }
__device__ __forceinline__ float wave_sum(float v) {
#pragma unroll
    for (int o = 1; o < 64; o <<= 1) v += __shfl_xor(v, o);
    return v;
}
__device__ __forceinline__ int crow(int reg, int h) { return (reg & 3) + 8 * (reg >> 2) + 4 * h; }

#define XB_TMO      128
#define XB_XCNT(j)  (256  + 64 * (j))
#define XB_XSUB(j)  (1280 + 64 * (j))
#define XB_XGEN(j)  (2304 + 64 * (j))
#define XB_TOP      3328
#define XB_TOPGEN   3392
#define XCD_BAR_WORDS 3456
#define XB_SPIN_CAP (1u << 18)

__device__ __forceinline__ unsigned xb_ld(unsigned* p)              { return __hip_atomic_load(p, __ATOMIC_RELAXED, __HIP_MEMORY_SCOPE_AGENT); }
__device__ __forceinline__ unsigned xb_add(unsigned* p, unsigned v) { return __hip_atomic_fetch_add(p, v, __ATOMIC_RELAXED, __HIP_MEMORY_SCOPE_AGENT); }
__device__ __forceinline__ unsigned xb_xcc_id() { return (unsigned)__builtin_amdgcn_s_getreg((3 << 11) | 20) & 0xFu; }
#define XB_SPIN(cond, bar) do { unsigned _sp = 0; while (cond) { __builtin_amdgcn_s_sleep(1); \
    if ((++_sp & 255u) == 0u) { if (xb_ld(&(bar)[XB_TMO])) break; if (_sp > XB_SPIN_CAP) { atomicAdd(&(bar)[XB_TMO], 1u); break; } } } } while (0)

struct XcdBarrier {
    unsigned* bar; unsigned x;
    volatile LAS unsigned* st;
};

__device__ __forceinline__ XcdBarrier xcd_barrier_post(unsigned* bar, volatile LAS unsigned* st) {
    XcdBarrier b; b.bar = bar; b.x = xb_xcc_id(); b.st = st;
    if (threadIdx.x == 0) (void)xb_add(&bar[XB_XCNT(b.x)], 1u);
    return b;
}
__device__ __forceinline__ void xcd_barrier_complete(unsigned* bar, unsigned x, unsigned& nloc, unsigned& nx) {
    const unsigned G = gridDim.x * gridDim.y * gridDim.z;
    unsigned sum, cnt, mine, sp = 0u;
    for (;;) {
        sum = 0u; cnt = 0u; mine = 0u;
#pragma unroll
        for (unsigned j = 0; j < 16; ++j) { const unsigned c = xb_ld(&bar[XB_XCNT(j)]); sum += c; cnt += (c > 0u) ? 1u : 0u; mine = (j == x) ? c : mine; }
        if (sum == G) break;
        __builtin_amdgcn_s_sleep(1);
        if ((++sp & 255u) == 0u) { if (xb_ld(&bar[XB_TMO])) break; if (sp > XB_SPIN_CAP) { atomicAdd(&bar[XB_TMO], 1u); break; } }
    }
    nloc = mine > 0u ? mine : 1u; nx = cnt > 0u ? cnt : 1u;
}

__device__ __forceinline__ void xcd_barrier(const XcdBarrier& b) {
    asm volatile("s_waitcnt vmcnt(0)" ::: "memory");
    __syncthreads();
    if (threadIdx.x == 0) {
        unsigned* bar = b.bar;
        __builtin_amdgcn_s_waitcnt(0);
        unsigned nloc = b.st[0], nx = b.st[1];
        if (nloc == 0u) { xcd_barrier_complete(bar, b.x, nloc, nx); b.st[0] = nloc; b.st[1] = nx; }
        const unsigned old = xb_add(&bar[XB_XSUB(b.x)], 1u);
        const unsigned gen = old / nloc;
        if (old + 1u == (gen + 1u) * nloc) {
            __builtin_amdgcn_fence(__ATOMIC_RELEASE, "agent");
            asm volatile("s_waitcnt vmcnt(0)" ::: "memory");
            const unsigned og = xb_add(&bar[XB_TOP], 1u);
            const unsigned tg = og / nx;
            if (og + 1u == (tg + 1u) * nx) xb_add(&bar[XB_TOPGEN], 1u);
            else XB_SPIN(xb_ld(&bar[XB_TOPGEN]) == tg, bar);
            __builtin_amdgcn_fence(__ATOMIC_ACQUIRE, "agent");
            xb_add(&bar[XB_XGEN(b.x)], 1u);
            asm volatile("s_waitcnt vmcnt(0)" ::: "memory");
        } else {
            XB_SPIN(xb_ld(&bar[XB_XGEN(b.x)]) == gen, bar);
            __builtin_amdgcn_fence(__ATOMIC_ACQUIRE, "agent");
            asm volatile("s_waitcnt vmcnt(0)" ::: "memory");
        }
    }
    __syncthreads();
}
struct Frame {
    LAS unsigned char* lds;
    int tid, lane, wave, G, gw, NGW;
    const float* in[22]; float* out; unsigned char* ws;
};
#define WSP(T, off) ((T*)(F.ws + (off)))

__device__ __forceinline__ int dst_row(int map, int n) {
    if (map == 1) return ((n >> 7) << 8) + (n & 127);
    if (map == 2) return ((n >> 7) << 8) + 128 + (n & 127);
    if (map == 3) return n < 2560 ? n : (n < 2640 ? n + 8192 : n - 80);
    return n;
}
struct TrJob { const float* W; bf16_t* WT; const float* g; const float* b; int K, N, map, pcol0, item; };
__device__ __forceinline__ bool tr_decode(Frame& F, int it, TrJob& J) {
    constexpr int I_GU = 32 * 176, I_DN = 88 * 64, I_IN = 32 * 339, I_BR = 16 * 64, I_OUT = 32 * 64;
    constexpr int NITEMS = 6 * I_GU + I_IN + 2 * I_BR + I_OUT;
    static_assert(I_DN == I_GU, "items");
    if (it >= NITEMS) return false;
    int r = it; J.g = nullptr; J.b = nullptr; J.pcol0 = 0; J.map = 0;
    if (r < I_GU) { J.W = F.in[2]; J.K = DM; J.N = DFF; J.WT = WSP(bf16_t, WS_WGU1); J.map = 1; J.item = r; return true; } r -= I_GU;
    if (r < I_GU) { J.W = F.in[3]; J.K = DM; J.N = DFF; J.WT = WSP(bf16_t, WS_WGU1); J.map = 2; J.item = r; return true; } r -= I_GU;
    if (r < I_DN) { J.W = F.in[4]; J.K = DFF; J.N = DM; J.WT = WSP(bf16_t, WS_WD1); J.item = r; return true; } r -= I_DN;
    if (r < I_IN) { J.W = F.in[7]; J.K = DM; J.N = NPROJ; J.WT = WSP(bf16_t, WS_WIN); J.map = 3; J.g = F.in[5]; J.b = F.in[6]; J.item = r; return true; } r -= I_IN;
    if (r < I_BR) { J.W = F.in[12]; J.K = 1024; J.N = DM; J.WT = WSP(bf16_t, WS_WBA); J.item = r; return true; } r -= I_BR;
    if (r < I_BR) { J.W = F.in[13]; J.K = 1024; J.N = DM; J.WT = WSP(bf16_t, WS_WBH); J.item = r; return true; } r -= I_BR;
    if (r < I_OUT) { J.W = F.in[14]; J.K = DM; J.N = DM; J.WT = WSP(bf16_t, WS_WOUT); J.item = r; return true; } r -= I_OUT;
    if (r < I_GU) { J.W = F.in[17]; J.K = DM; J.N = DFF; J.WT = WSP(bf16_t, WS_WGU2); J.map = 1; J.g = F.in[15]; J.b = F.in[16]; J.pcol0 = PW; J.item = r; return true; } r -= I_GU;
    if (r < I_GU) { J.W = F.in[18]; J.K = DM; J.N = DFF; J.WT = WSP(bf16_t, WS_WGU2); J.map = 2; J.g = F.in[15]; J.b = F.in[16]; J.pcol0 = PW; J.item = r; return true; } r -= I_GU;
    J.W = F.in[19]; J.K = DFF; J.N = DM; J.WT = WSP(bf16_t, WS_WD2); J.item = r; return true;
}
__device__ __forceinline__ void tr_load(const TrJob& J, int lane, f32x4 (&v)[8]) {
    const int nblk = (J.N + 31) >> 5, kb = J.item / nblk, nb = J.item - kb * nblk, k0 = 64 * kb, nn = 32 * nb + 4 * (lane & 7);
    const float* p = J.W + (size_t)(k0 + (lane >> 3)) * J.N + nn; const bool ok = nn < J.N;
#pragma unroll
    for (int i = 0; i < 8; ++i) v[i] = ok ? *(const f32x4*)(p + (size_t)(8 * i) * J.N) : (f32x4){0.f, 0.f, 0.f, 0.f};
}
__device__ __forceinline__ void tr_process(const TrJob& J, f32x4 (&v)[8], float* pcs, float* pbw, LAS float* scr, int lane) {
    const int nblk = (J.N + 31) >> 5, kb = J.item / nblk, nb = J.item - kb * nblk, k0 = 64 * kb, n0 = 32 * nb, nn = n0 + 4 * (lane & 7);
    if (J.g) {
        float cs[4] = {0.f, 0.f, 0.f, 0.f}, bw[4] = {0.f, 0.f, 0.f, 0.f};
#pragma unroll
        for (int i = 0; i < 8; ++i) { const int k = k0 + (lane >> 3) + 8 * i; const float gk = J.g[k], bk = J.b[k];
#pragma unroll
            for (int e = 0; e < 4; ++e) { bw[e] += bk * v[i][e]; v[i][e] *= gk; cs[e] += bfround(v[i][e]); } }
#pragma unroll
        for (int e = 0; e < 4; ++e) { cs[e] += __shfl_xor(cs[e], 8); cs[e] += __shfl_xor(cs[e], 16); cs[e] += __shfl_xor(cs[e], 32); bw[e] += __shfl_xor(bw[e], 8); bw[e] += __shfl_xor(bw[e], 16); bw[e] += __shfl_xor(bw[e], 32); }
        if (lane < 8 && nn < J.N) {
#pragma unroll
            for (int e = 0; e < 4; ++e) { const int d = J.pcol0 + dst_row(J.map, nn + e); pcs[(size_t)kb * NCS + d] = cs[e]; pbw[(size_t)kb * NCS + d] = bw[e]; } }
    }
#pragma unroll
    for (int i = 0; i < 8; ++i) { LAS float* q = scr + ((lane >> 3) + 8 * i) * 33 + 4 * (lane & 7); q[0] = v[i][0]; q[1] = v[i][1]; q[2] = v[i][2]; q[3] = v[i][3]; }
    LDS_WAIT(); asm volatile("" ::: "memory");
    const int c = lane & 7;
#pragma unroll
    for (int j = 0; j < 4; ++j) { const int n = (lane >> 3) + 8 * j; const LAS float* s = scr + (8 * c) * 33 + n;
        if (n0 + n < J.N) { v4u o; o.x = pk2(s[0 * 33], s[1 * 33]); o.y = pk2(s[2 * 33], s[3 * 33]); o.z = pk2(s[4 * 33], s[5 * 33]); o.w = pk2(s[6 * 33], s[7 * 33]);
            *(v4u*)(J.WT + (size_t)dst_row(J.map, n0 + n) * J.K + k0 + 8 * c) = o; } }
    LDS_WAIT(); asm volatile("" ::: "memory");
}
__device__ __forceinline__ void p0_prologue(Frame& F) {
    LAS float* scr = (LAS float*)(F.lds + F.wave * 16384);
    float* pcs = WSP(float, WS_PCS); float* pbw = WSP(float, WS_PBW);
    {
        TrJob cur, nxt; f32x4 va[8], vb[8];
        bool have = tr_decode(F, F.gw, cur);
        if (have) tr_load(cur, F.lane, va);
        for (int it = F.gw; have; it += F.NGW) {
            const bool hn = tr_decode(F, it + F.NGW, nxt);
            if (hn) tr_load(nxt, F.lane, vb);
            tr_process(cur, va, pcs, pbw, scr, F.lane);
            cur = nxt; have = hn;
#pragma unroll
            for (int i = 0; i < 8; ++i) va[i] = vb[i];
        }
    }
    bf16_t* h0b = WSP(bf16_t, WS_H0B); bf16_t* z1b = WSP(bf16_t, WS_Z1B); bf16_t* wint = WSP(bf16_t, WS_WIN);
    for (int m = F.gw; m < MPAD + (PW - NPROJ); m += F.NGW) {
        if (m >= MPAD) { u32x2* o = (u32x2*)(wint + (size_t)(NPROJ + m - MPAD) * DM) + F.lane;
#pragma unroll
            for (int j = 0; j < 8; ++j) o[64 * j] = (u32x2){0u, 0u};
            continue; }
        const float* src = m < MR ? F.in[0] + (size_t)m * DM : (m < MR + NMETA ? F.in[1] + (size_t)(m - MR) * DM : nullptr);
        u32x2* o = (u32x2*)(h0b + (size_t)m * DM) + F.lane;
#pragma unroll
        for (int j = 0; j < 8; ++j) { u32x2 w = (u32x2){0u, 0u}; if (src) { const f32x4 v = ((const f32x4*)src)[F.lane + 64 * j]; w.x = pk2(v[0], v[1]); w.y = pk2(v[2], v[3]); } o[64 * j] = w; }
        if (m >= MR + NMETA) { u32x2* oz = (u32x2*)(z1b + (size_t)m * DM) + F.lane;
#pragma unroll
            for (int j = 0; j < 8; ++j) oz[64 * j] = (u32x2){0u, 0u}; }
    }
}
__device__ __forceinline__ void p1_colsums(Frame& F) {
    const float* pcs = WSP(float, WS_PCS); const float* pbw = WSP(float, WS_PBW); float* csv = WSP(float, WS_CSV); float* bwv = WSP(float, WS_BWV);
    for (int i = blockIdx.x * 512 + F.tid; i < NCS; i += F.G * 512) {
        float cs = 0.f, bw = 0.f;
        if (!(i >= NPROJ && i < PW)) {
#pragma unroll 8
            for (int kb = 0; kb < 32; ++kb) { cs += pcs[(size_t)kb * NCS + i]; bw += pbw[(size_t)kb * NCS + i]; } }
        csv[i] = cs; bwv[i] = bw;
    }
}
__device__ __forceinline__ void p2_meta_down(Frame& F) {
    const bf16_t* G = WSP(bf16_t, WS_G); const bf16_t* wd = WSP(bf16_t, WS_WD1); float* z1m = WSP(float, WS_Z1M); bf16_t* z1b = WSP(bf16_t, WS_Z1B);
    const int lane = F.lane;
    for (int c = F.gw; c < DM; c += F.NGW) {
        const bf16_t* wrow = wd + (size_t)c * DFF;
        float acc[16];
#pragma unroll
        for (int r = 0; r < 16; ++r) acc[r] = 0.f;
        for (int i = 0; i < 11; ++i) {
            const int k = 8 * lane + 512 * i;
            const v4u wv = *(const v4u*)(wrow + k);
            const float w0 = bflo(wv.x), w1 = bfhi(wv.x), w2 = bflo(wv.y), w3 = bfhi(wv.y), w4 = bflo(wv.z), w5 = bfhi(wv.z), w6 = bflo(wv.w), w7 = bfhi(wv.w);
#pragma unroll
            for (int r = 0; r < 16; ++r) { const v4u gv = *(const v4u*)(G + (size_t)(METAROW + r) * DFF + k);
                acc[r] += (bflo(gv.x) * w0 + bfhi(gv.x) * w1) + (bflo(gv.y) * w2 + bfhi(gv.y) * w3) + (bflo(gv.z) * w4 + bfhi(gv.z) * w5) + (bflo(gv.w) * w6 + bfhi(gv.w) * w7); }
        }
        float v8[8], v4[4], v2[2], v1;
#pragma unroll
        for (int i = 0; i < 8; ++i) { const bool hi = (lane & 32) != 0; const float send = hi ? acc[i] : acc[8 + i], keep = hi ? acc[8 + i] : acc[i]; v8[i] = keep + __shfl_xor(send, 32); }
#pragma unroll
        for (int i = 0; i < 4; ++i) { const bool hi = (lane & 16) != 0; const float send = hi ? v8[i] : v8[4 + i], keep = hi ? v8[4 + i] : v8[i]; v4[i] = keep + __shfl_xor(send, 16); }
#pragma unroll
        for (int i = 0; i < 2; ++i) { const bool hi = (lane & 8) != 0; const float send = hi ? v4[i] : v4[2 + i], keep = hi ? v4[2 + i] : v4[i]; v2[i] = keep + __shfl_xor(send, 8); }
        { const bool hi = (lane & 4) != 0; const float send = hi ? v2[0] : v2[1], keep = hi ? v2[1] : v2[0]; v1 = keep + __shfl_xor(send, 4); }
        v1 += __shfl_xor(v1, 1); v1 += __shfl_xor(v1, 2);
        const int r = ((lane >> 5) & 1) * 8 + ((lane >> 4) & 1) * 4 + ((lane >> 3) & 1) * 2 + ((lane >> 2) & 1);
        if ((lane & 3) == 0) { const float z = 1.18920711500272f * F.in[1][(size_t)r * DM + c] + 0.5f * v1; z1m[(size_t)r * DM + c] = z; z1b[(size_t)(METAROW + r) * DM + c] = (bf16_t)f2bf(z); }
    }
}
__device__ __forceinline__ void p3_meta_stats(Frame& F) {
    const float* z1m = WSP(float, WS_Z1M); LAS float* ms = (LAS float*)(F.lds + MSTAT_OFF);
#pragma unroll
    for (int q = 0; q < 2; ++q) { const int r = 2 * F.wave + q; float s = 0.f, s2 = 0.f;
#pragma unroll
        for (int j = 0; j < 8; ++j) { const f32x4 v = ((const f32x4*)(z1m + (size_t)r * DM))[F.lane + 64 * j]; s += (v[0] + v[1]) + (v[2] + v[3]); s2 += (v[0] * v[0] + v[1] * v[1]) + (v[2] * v[2] + v[3] * v[3]); }
        s = wave_sum(s); s2 = wave_sum(s2);
        const float mu = s * (1.f / DM), var = fmaxf(s2 * (1.f / DM) - mu * mu, 0.f);
        if (F.lane == 0) { ms[2 * r] = mu; ms[2 * r + 1] = __builtin_amdgcn_rsqf(var + 1e-5f); } }
    __syncthreads();
}
__device__ __forceinline__ void p4_ikn(Frame& F) {
    const bf16_t* proj = WSP(bf16_t, WS_PROJ); bf16_t* ikn = WSP(bf16_t, WS_IKN);
    const float g = F.in[8][F.lane], b = F.in[9][F.lane];
    for (int row = F.gw; row < MR; row += F.NGW) {
        const float v = bf2f(proj[(size_t)row * PW + PC_IK + F.lane]);
        const float mu = wave_sum(v) * (1.f / 64.f); const float d = v - mu; const float var = wave_sum(d * d) * (1.f / 64.f);
        ikn[(size_t)row * 64 + F.lane] = (bf16_t)f2bf(d * __builtin_amdgcn_rsqf(var + 1e-5f) * g + b);
    }
}
constexpr int QP = 136, TP = 72;
__device__ __forceinline__ void h1_item(Frame& F, int bh, int c) {
    const int b = bh >> 3, h = bh & 7, tid = F.tid, lane = F.lane, w = F.wave;
    const bf16_t* proj = WSP(bf16_t, WS_PROJ);
    LAS bf16_t* Qs = (LAS bf16_t*)F.lds; LAS bf16_t* Ks = Qs + 64 * QP; LAS bf16_t* KhT = Ks + 64 * QP; LAS bf16_t* VT = KhT + 128 * TP; LAS float* tot = (LAS float*)(VT + 128 * TP);
    const int ch = tid & 127, part = tid >> 7;
    const float l0 = F.in[10][h * 128 + ch], l1 = F.in[10][1024 + h * 128 + ch];
    const float lb = 1.f / (1.f + __expf(l1 - l0));
    float fgv[16], cum[16]; float run = 0.f;
#pragma unroll
    for (int i = 0; i < 16; ++i) { const int tt = 16 * part + i; const bool valid = (c > 0) || (tt < NMETA);
        const size_t row = c == 0 ? (size_t)(METAROW + (tt & 15)) : (size_t)(b * SEQ + (c - 1) * 64 + tt);
        const float f = bf2f(proj[row * PW + PC_HF + h * 128 + ch]);
        const float fg = valid ? lb + (1.f - lb) * sigm(f) : 1.f; run += __logf(fg); fgv[i] = fg; cum[i] = run; }
    tot[part * 128 + ch] = run;
    __syncthreads();
    float off = 0.f, blast = 0.f;
#pragma unroll
    for (int p = 0; p < 4; ++p) { const float t = tot[p * 128 + ch]; if (p < part) off += t; blast += t; }
    if (part == 0) WSP(float, WS_GCH)[(size_t)(bh * 65 + c) * 128 + ch] = __expf(blast);
    bf16_t* qtg = WSP(bf16_t, WS_QT);
#pragma unroll
    for (int i = 0; i < 16; ++i) { const int tt = 16 * part + i; const bool valid = (c > 0) || (tt < NMETA);
        const size_t row = c == 0 ? (size_t)(METAROW + (tt & 15)) : (size_t)(b * SEQ + (c - 1) * 64 + tt);
        const float bq = off + cum[i], fg = fgv[i];
        const float q = valid ? bf2f(proj[row * PW + PC_HQ + h * 128 + ch]) : 0.f, v = valid ? bf2f(proj[row * PW + PC_HI + h * 128 + ch]) : 0.f;
        const float qt = silu(q) * __expf(bq), kk = 1.f - fg, kt = kk * __expf(-bq), kh = kk * __expf(blast - bq);
        const bf16_t qb = (bf16_t)f2bf(qt);
        Qs[tt * QP + ch] = qb; Ks[tt * QP + ch] = (bf16_t)f2bf(kt); KhT[ch * TP + tt] = (bf16_t)f2bf(kh); VT[ch * TP + tt] = (bf16_t)f2bf(v);
        if (c > 0) qtg[((size_t)(bh * 64 + (c - 1)) * 64 + tt) * 128 + ch] = qb; }
    __syncthreads();
    const int tb = w >> 2, dvb = w & 3, r = lane & 31, hh = lane >> 5;
    if (c > 0) {
        f32x16 o;
#pragma unroll
        for (int i = 0; i < 16; ++i) o[i] = 0.f;
        for (int sb = 0; sb <= tb; ++sb) {
            f32x16 x;
#pragma unroll
            for (int i = 0; i < 16; ++i) x[i] = 0.f;
#pragma unroll
            for (int ks = 0; ks < 8; ++ks) { const bf16x8 a = *(const LAS bf16x8*)(Ks + (32 * sb + r) * QP + 16 * ks + 8 * hh); const bf16x8 bq = *(const LAS bf16x8*)(Qs + (32 * tb + r) * QP + 16 * ks + 8 * hh); x = MFMA32(a, bq, x); }
            if (sb == tb) {
#pragma unroll
                for (int i = 0; i < 16; ++i) if (crow(i, hh) > r) x[i] = 0.f; }
#pragma unroll
            for (int s2 = 0; s2 < 2; ++s2) {
                bf16x8 xb;
#pragma unroll
                for (int j = 0; j < 8; ++j) xb[j] = (short)f2bf(x[8 * s2 + j]);
                const LAS bf16_t* vp = VT + (32 * dvb + r) * TP + 32 * sb + 16 * s2 + 4 * hh;
                const s16x4 lo = *(const LAS s16x4*)vp, hi = *(const LAS s16x4*)(vp + 8);
                const bf16x8 a2 = __builtin_shufflevector(lo, hi, 0, 1, 2, 3, 4, 5, 6, 7);
                o = MFMA32(a2, xb, o);
            }
        }
        float* oi = WSP(float, WS_OI) + ((size_t)(bh * 64 + (c - 1)) * 8 + w) * 1024 + lane;
#pragma unroll
        for (int i = 0; i < 16; ++i) oi[i * 64] = o[i];
    }
    if (c < 64) {
        bf16_t* lst = WSP(bf16_t, WS_LST) + (size_t)(bh * 65 + c) * 16384;
#pragma unroll
        for (int q2 = 0; q2 < 2; ++q2) { const int db = (w >> 2) * 2 + q2;
            f32x16 l;
#pragma unroll
            for (int i = 0; i < 16; ++i) l[i] = 0.f;
#pragma unroll
            for (int ks = 0; ks < 4; ++ks) { const bf16x8 a = *(const LAS bf16x8*)(VT + (32 * dvb + r) * TP + 16 * ks + 8 * hh); const bf16x8 bb = *(const LAS bf16x8*)(KhT + (32 * db + r) * TP + 16 * ks + 8 * hh); l = MFMA32(a, bb, l); }
#pragma unroll
            for (int i = 0; i < 16; ++i) lst[(size_t)(32 * dvb + crow(i, hh)) * 128 + 32 * db + r] = (bf16_t)f2bf(l[i]); }
    }
    __syncthreads();
}
__device__ __forceinline__ void h2_item(Frame& F, int it) {
    const int bh = it >> 4, part = it & 15, dv = 8 * part + (F.tid >> 6), d0 = 2 * (F.tid & 63);
    bf16_t* p = WSP(bf16_t, WS_LST) + ((size_t)bh * 65 * 128 + dv) * 128 + d0; const float* g = WSP(float, WS_GCH) + (size_t)bh * 65 * 128 + d0;
    float s0 = 0.f, s1 = 0.f;
#pragma unroll 8
    for (int c = 0; c < 64; ++c) { const unsigned l = *(const unsigned*)(p + (size_t)c * 16384); const f32x2 gg = *(const f32x2*)(g + c * 128);
        s0 = gg.x * s0 + bflo(l); s1 = gg.y * s1 + bfhi(l); *(unsigned*)(p + (size_t)c * 16384) = pk2(s0, s1); }
}
__device__ __forceinline__ void h3_item(Frame& F, int bh, int c) {
    const int b = bh >> 3, h = bh & 7, lane = F.lane, w = F.wave, tid = F.tid;
    const bf16_t* st = WSP(bf16_t, WS_LST) + (size_t)(bh * 65 + (c - 1)) * 16384; const bf16_t* qg = WSP(bf16_t, WS_QT) + (size_t)(bh * 64 + (c - 1)) * 8192;
    const float* oi = WSP(float, WS_OI) + ((size_t)(bh * 64 + (c - 1)) * 8 + w) * 1024 + lane;
    LAS float* Ot = (LAS float*)F.lds; LAS float* ssq = Ot + 64 * 129;
    const int tb = w >> 2, dvb = w & 3, r = lane & 31, hh = lane >> 5;
    f32x16 o;
#pragma unroll
    for (int i = 0; i < 16; ++i) o[i] = oi[i * 64];
#pragma unroll
    for (int ks = 0; ks < 8; ++ks) { const bf16x8 a = *(const bf16x8*)(st + (size_t)(32 * dvb + r) * 128 + 16 * ks + 8 * hh); const bf16x8 bq = *(const bf16x8*)(qg + (size_t)(32 * tb + r) * 128 + 16 * ks + 8 * hh); o = MFMA32(a, bq, o); }
    float ss = 0.f;
#pragma unroll
    for (int i = 0; i < 16; ++i) { ss += o[i] * o[i]; Ot[(32 * tb + r) * 129 + 32 * dvb + crow(i, hh)] = o[i]; }
    ssq[(dvb * 2 + hh) * 64 + 32 * tb + r] = ss;
    __syncthreads();
    const int t = tid >> 3, d0 = (tid & 7) * 16;
    float sq = 0.f;
#pragma unroll
    for (int k = 0; k < 8; ++k) sq += ssq[k * 64 + t];
    const float rstd = __builtin_amdgcn_rsqf(sq * (1.f / 128.f) + 1e-6f);
    const size_t row = (size_t)(b * SEQ + (c - 1) * 64 + t);
    const bf16_t* gp = WSP(bf16_t, WS_PROJ) + row * PW + PC_HG + h * 128 + d0; const float* ng = F.in[11] + h * 128 + d0;
    bf16_t* yp = WSP(bf16_t, WS_YHG) + row * 1024 + h * 128 + d0;
#pragma unroll
    for (int q = 0; q < 2; ++q) { const v4u gz = *(const v4u*)(gp + 8 * q); const f32x4 n0 = *(const f32x4*)(ng + 8 * q), n1 = *(const f32x4*)(ng + 8 * q + 4);
        const LAS float* op = Ot + t * 129 + d0 + 8 * q;
        v4u wv; wv.x = pk2(op[0] * rstd * n0[0] * silu(bflo(gz.x)), op[1] * rstd * n0[1] * silu(bfhi(gz.x))); wv.y = pk2(op[2] * rstd * n0[2] * silu(bflo(gz.y)), op[3] * rstd * n0[3] * silu(bfhi(gz.y)));
        wv.z = pk2(op[4] * rstd * n1[0] * silu(bflo(gz.z)), op[5] * rstd * n1[1] * silu(bfhi(gz.z))); wv.w = pk2(op[6] * rstd * n1[2] * silu(bflo(gz.w)), op[7] * rstd * n1[3] * silu(bfhi(gz.w)));
        *(v4u*)(yp + 8 * q) = wv; }
    __syncthreads();
}
__device__ __forceinline__ void idx_item(Frame& F, int b, int qblk) {
    const int lane = F.lane, w = F.wave;
    const bf16_t* proj = WSP(bf16_t, WS_PROJ); const bf16_t* ikn = WSP(bf16_t, WS_IKN);
    LAS unsigned* sc = (LAS unsigned*)F.lds;
    const int r0 = 8 * qblk, ntile = (r0 + 8 + 31) >> 5;
    const int p = w & 3, kh = w >> 2, r = lane & 31, hh = lane >> 5;
    {
        const size_t rowq = (size_t)(b * SEQ + r0 + 2 * p + (r >> 4));
        bf16x8 a[4];
#pragma unroll
        for (int ks = 0; ks < 4; ++ks) a[ks] = *(const bf16x8*)(proj + rowq * PW + PC_IQ + (r & 15) * 64 + 16 * ks + 8 * hh);
        float wv[16];
#pragma unroll
        for (int i = 0; i < 16; ++i) { const int rw = crow(i, hh); wv[i] = bf2f(proj[(size_t)(b * SEQ + r0 + 2 * p + (rw >> 4)) * PW + PC_IW + (rw & 15)]) * (1.f / 32.f); }
        const int myr = r0 + 2 * p + hh;
        LAS unsigned* scq = sc + (2 * p + hh) * 4096;
#define IDX_LOAD(dst, j) do { int kt_ = kh + 2 * (j); if (kt_ >= ntile) kt_ = kh; const bf16_t* kp_ = ikn + (size_t)(b * SEQ + 32 * kt_ + r) * 64 + 8 * hh; \
    _Pragma("unroll") for (int ks = 0; ks < 4; ++ks) dst[ks] = *(const bf16x8*)(kp_ + 16 * ks); } while (0)
#define IDX_COMP(src, j) do { const int kt_ = kh + 2 * (j); if (kt_ < ntile) { f32x16 x; \
    _Pragma("unroll") for (int i = 0; i < 16; ++i) x[i] = 0.f; \
    _Pragma("unroll") for (int ks = 0; ks < 4; ++ks) x = MFMA32(a[ks], src[ks], x); \
    float p0 = 0.f, p1 = 0.f; \
    _Pragma("unroll") for (int i = 0; i < 8; ++i) { p0 += wv[i] * fmaxf(x[i], 0.f); p1 += wv[8 + i] * fmaxf(x[8 + i], 0.f); } \
    const float send = hh ? p0 : p1; const float recv = __shfl_xor(send, 32); const float tot = (hh ? p1 : p0) + recv; const int key = 32 * kt_ + r; \
    unsigned u = __float_as_uint(tot); u = (u & 0x80000000u) ? ~u : (u | 0x80000000u); if (key > myr) u = 0u; scq[key] = u; } } while (0)
        const int nmine = (ntile - kh + 1) >> 1;
        bf16x8 b0[4], b1[4], n0[4], n1[4];
        IDX_LOAD(b0, 0); IDX_LOAD(b1, 1);
        for (int j = 0; j < nmine; j += 2) {
            IDX_LOAD(n0, j + 2); IDX_LOAD(n1, j + 3);
            IDX_COMP(b0, j); IDX_COMP(b1, j + 1);
#pragma unroll
            for (int ks = 0; ks < 4; ++ks) { b0[ks] = n0[ks]; b1[ks] = n1[ks]; }
        }
#undef IDX_LOAD
#undef IDX_COMP
    }
    __syncthreads();
    {
        const int rq = r0 + w, nvalid = rq + 1, nk = ntile * 32;
        unsigned k[64];
#pragma unroll
        for (int i = 0; i < 64; ++i) { const int idx = lane + 64 * i; k[i] = idx < nk ? sc[w * 4096 + idx] : 0u; }
        unsigned thr = 0u;
        if (nvalid > 256) {
            for (int bit = 31; bit >= 0; --bit) { const unsigned cand = thr | (1u << bit); int cnt = 0;
#pragma unroll
                for (int i = 0; i < 64; ++i) cnt += __popcll(__ballot(k[i] >= cand));
                if (cnt >= 256) thr = cand; }
        }
        int ngt = 0;
#pragma unroll
        for (int i = 0; i < 64; ++i) ngt += __popcll(__ballot(k[i] > thr));
        const int quota = thr != 0u ? 256 - ngt : 0;
        int run = 0, eqrun = 0; unsigned short* out = WSP(unsigned short, WS_SEL) + (size_t)(b * SEQ + rq) * 256;
#pragma unroll
        for (int i = 0; i < 64; ++i) { const bool gt = k[i] > thr, eq = (k[i] == thr) && (thr != 0u);
            const unsigned long long meq = __ballot(eq); const int eqb = eqrun + (int)__builtin_amdgcn_mbcnt_hi((unsigned)(meq >> 32), __builtin_amdgcn_mbcnt_lo((unsigned)meq, 0u));
            const bool take = gt || (eq && eqb < quota);
            const unsigned long long m = __ballot(take); const int pos = run + (int)__builtin_amdgcn_mbcnt_hi((unsigned)(m >> 32), __builtin_amdgcn_mbcnt_lo((unsigned)m, 0u));
            if (take && pos < 256) out[pos] = (unsigned short)(lane + 64 * i);
            run += __popcll(m); eqrun += __popcll(meq); }
    }
    __syncthreads();
}
__device__ __forceinline__ void att_item(Frame& F, int it) {
    const int lane = F.lane, w = F.wave;
    const bf16_t* proj = WSP(bf16_t, WS_PROJ); const unsigned short* sel = WSP(unsigned short, WS_SEL);
    const int b = it >> 10, blk = it & 1023, q = w >> 1, kv = w & 1, rq = 4 * blk + q, tpos = rq + NMETA; const size_t rowq = (size_t)(b * SEQ + rq);
    const int nsel = rq + 1 < 256 ? rq + 1 : 256, ntot = NMETA + nsel;
    LAS int* rowl = (LAS int*)(F.lds + w * 8192); LAS float* dl = (LAS float*)(rowl + 288); LAS float* Pl = dl + 288;
#pragma unroll
    for (int i = 0; i < 5; ++i) { const int n = lane + 64 * i;
        if (n < 272) { int row; float d;
            if (n < NMETA) { row = METAROW + n; d = (float)(tpos - n); }
            else { const int j = n - NMETA; const bool ok = j < nsel; const int s = ok ? (int)sel[rowq * 256 + j] : 0; row = b * SEQ + s; d = ok ? (float)(rq - s) : INFINITY; }
            rowl[n] = row; dl[n] = d; } }
    __syncthreads();
    const int hh = lane & 15, g = lane >> 4;
    bf16x8 qf[4];
#pragma unroll
    for (int ks = 0; ks < 4; ++ks) { bf16x8 z = {0, 0, 0, 0, 0, 0, 0, 0}; if (hh < 4) z = *(const bf16x8*)(proj + rowq * PW + PC_AQ + (kv * 4 + hh) * 128 + 32 * ks + 8 * g); qf[ks] = z; }
    f32x4 acc[17];
#pragma unroll
    for (int T = 0; T < 17; ++T) { const int row = rowl[16 * T + hh]; const bf16_t* kp = proj + (size_t)row * PW + PC_AK + kv * 128 + 8 * g;
        f32x4 x = (f32x4){0.f, 0.f, 0.f, 0.f};
#pragma unroll
        for (int ks = 0; ks < 4; ++ks) { const bf16x8 a = *(const bf16x8*)(kp + 32 * ks); x = MFMA16(a, qf[ks], x); }
        acc[T] = x; }
    const float slope = exp2f(-(float)(kv * 4 + (hh & 3) + 1));
    float mx = -INFINITY;
#pragma unroll
    for (int T = 0; T < 17; ++T) { const f32x4 d4 = *(const LAS f32x4*)(dl + 16 * T + 4 * g);
#pragma unroll
        for (int j = 0; j < 4; ++j) { const float l = acc[T][j] * 0.08838834764831845f - slope * d4[j]; acc[T][j] = l; mx = fmaxf(mx, l); } }
    mx = fmaxf(mx, __shfl_xor(mx, 16)); mx = fmaxf(mx, __shfl_xor(mx, 32));
    float sum = 0.f;
#pragma unroll
    for (int T = 0; T < 17; ++T)
#pragma unroll
        for (int j = 0; j < 4; ++j) { const float e = __expf(acc[T][j] - mx); acc[T][j] = e; sum += e; }
    sum += __shfl_xor(sum, 16); sum += __shfl_xor(sum, 32);
    const float inv = 1.f / sum;
    if (hh < 4) {
#pragma unroll
        for (int T = 0; T < 17; ++T)
#pragma unroll
            for (int j = 0; j < 4; ++j) Pl[(16 * T + 4 * g + j) * 4 + hh] = acc[T][j] * inv; }
    __syncthreads();
    float o[4][8];
#pragma unroll
    for (int h = 0; h < 4; ++h)
#pragma unroll
        for (int e = 0; e < 8; ++e) o[h][e] = 0.f;
    const bf16_t* vbase = proj + PC_AV + kv * 128 + 8 * hh;
    for (int io = 0; io < 68; io += 17) {
        if (4 * io >= ntot) break;
#pragma unroll
        for (int ii = 0; ii < 17; ++ii) { const int n = 4 * (io + ii) + g; const int row = rowl[n]; const v4u vv = *(const v4u*)(vbase + (size_t)row * PW); const f32x4 p4 = *(const LAS f32x4*)(Pl + 4 * n);
            const float v0 = bflo(vv.x), v1 = bfhi(vv.x), v2 = bflo(vv.y), v3 = bfhi(vv.y), v4 = bflo(vv.z), v5 = bfhi(vv.z), v6 = bflo(vv.w), v7 = bfhi(vv.w);
#pragma unroll
            for (int h = 0; h < 4; ++h) { o[h][0] += p4[h] * v0; o[h][1] += p4[h] * v1; o[h][2] += p4[h] * v2; o[h][3] += p4[h] * v3; o[h][4] += p4[h] * v4; o[h][5] += p4[h] * v5; o[h][6] += p4[h] * v6; o[h][7] += p4[h] * v7; } }
    }
    float ov[8];
#pragma unroll
    for (int e = 0; e < 8; ++e) {
#pragma unroll
        for (int h = 0; h < 4; ++h) { o[h][e] += __shfl_xor(o[h][e], 16); o[h][e] += __shfl_xor(o[h][e], 32); }
        ov[e] = g == 0 ? o[0][e] : (g == 1 ? o[1][e] : (g == 2 ? o[2][e] : o[3][e])); }
    v4u wv; wv.x = pk2(ov[0], ov[1]); wv.y = pk2(ov[2], ov[3]); wv.z = pk2(ov[4], ov[5]); wv.w = pk2(ov[6], ov[7]);
    *(v4u*)(WSP(bf16_t, WS_YATT) + rowq * 1024 + (kv * 4 + g) * 128 + 8 * hh) = wv;
    __syncthreads();
}
__device__ __forceinline__ void p11_final_ln(Frame& F) {
    const float* st = WSP(float, WS_ST3); const float* g = F.in[20]; const float* b = F.in[21];
    for (int row = F.gw; row < MR; row += F.NGW) { float mu, rs; row_stats(st, row, mu, rs);
        f32x4* o = (f32x4*)(F.out + (size_t)row * DM);
#pragma unroll
        for (int j = 0; j < 8; ++j) { const int i = F.lane + 64 * j; const f32x4 z = o[i]; o[i] = (z - mu) * rs * ((const f32x4*)g)[i] + ((const f32x4*)b)[i]; } }
}
struct Args { const float* in[22]; float* out; unsigned char* ws; int ph_lo, ph_hi, li, pad; };
constexpr int NPH = 12;
__global__ void __launch_bounds__(512, 2) mk_fwd(Args args) {
    extern __shared__ __attribute__((aligned(16))) unsigned char lds_raw[];
    Frame F;
    F.lds = (LAS unsigned char*)lds_raw;
    F.tid = threadIdx.x; F.lane = F.tid & 63; F.wave = __builtin_amdgcn_readfirstlane(F.tid >> 6);
    F.G = gridDim.x; F.gw = blockIdx.x * 8 + F.wave; F.NGW = F.G * 8;
#pragma unroll
    for (int i = 0; i < 22; ++i) F.in[i] = args.in[i];
    F.out = args.out; F.ws = args.ws;
    volatile LAS unsigned* MISC = (volatile LAS unsigned*)(F.lds + MISC_OFF);
    if (F.tid < 64) MISC[F.tid] = 0u;
    __syncthreads();
    XcdBarrier bar = xcd_barrier_post((unsigned*)(F.ws + WS_CTL) + CW_BAR + args.li * XCD_BAR_WORDS, MISC + 8);
    const int lo = args.ph_lo, hi = args.ph_hi;
#define IN(k) (lo <= (k) && (k) < hi)
#define SEAM(k) do { if (IN(k) && IN((k) + 1)) xcd_barrier(bar); } while (0)
    const int bid = blockIdx.x;
#ifndef REP_MASK
#define REP_MASK 0
#endif
#define PBEG(k) if (IN(k)) { const int nrep_ = ((REP_MASK >> (k)) & 1) ? 2 : 1; for (int rep = 0; rep < nrep_; ++rep) { if (rep) xcd_barrier(bar);
#define PEND(k) } } SEAM(k);

    PBEG(0) p0_prologue(F); PEND(0)
    PBEG(1)
        p1_colsums(F);
        Gemm g{WSP(bf16_t, WS_H0B), WSP(bf16_t, WS_WGU1), MPAD, NGU, DM}; StaticOrder S; S.init(MPAD, NGU, F.G, bid);
        EpiSwiGLU<false> E{WSP(bf16_t, WS_G), DFF, nullptr, nullptr, nullptr};
        gemm_phase<EpiSwiGLU<false>, StaticOrder, true, true>(F.lds, g, S, E);
    PEND(1)
    PBEG(2)
        p2_meta_down(F);
        Gemm g{WSP(bf16_t, WS_G), WSP(bf16_t, WS_WD1), MR, DM, DFF}; StaticOrder S; S.init(MR, DM, F.G, bid);
        EpiResid<0> E{F.in[0], nullptr, nullptr, nullptr, nullptr, WSP(bf16_t, WS_Z1B), nullptr, WSP(float, WS_ST1), 0.5f};
        gemm_phase<EpiResid<0>, StaticOrder, false, true>(F.lds, g, S, E);
    PEND(2)
    PBEG(3)
        p3_meta_stats(F);
        Gemm g{WSP(bf16_t, WS_Z1B), WSP(bf16_t, WS_WIN), MPAD, PW, DM}; StaticOrder S; S.init(MPAD, PW, F.G, bid);
        EpiProj E{WSP(bf16_t, WS_PROJ), PW, WSP(float, WS_ST1), WSP(float, WS_CSV), WSP(float, WS_BWV), (const LAS float*)(F.lds + MSTAT_OFF)};
        gemm_phase<EpiProj, StaticOrder, true, true>(F.lds, g, S, E);
    PEND(3)
    PBEG(4)
        p4_ikn(F);
        for (int it = bid; it < 16 * 65; it += F.G) h1_item(F, it / 65, it % 65);
    PEND(4)
    PBEG(5)
        if (rep == 0) for (int it = bid; it < 256; it += F.G) h2_item(F, it);
        for (int it = bid; it < 1024; it += F.G) { const int j = it >> 8, x = it & 255; idx_item(F, j >> 1, (j & 1) ? 511 - x : x); }
    PEND(5)
    PBEG(6)
        for (int it = bid; it < 16 * 64; it += F.G) h3_item(F, it >> 6, (it & 63) + 1);
        for (int it = bid; it < 2048; it += F.G) att_item(F, it);
    PEND(6)
    PBEG(7)
        { Gemm g{WSP(bf16_t, WS_YATT), WSP(bf16_t, WS_WBA), MR, DM, 1024}; StaticOrder S; S.init(MR, DM, F.G, bid);
          EpiBranch<0> E{WSP(bf16_t, WS_PROJ), PW, PC_GA, WSP(bf16_t, WS_T1), nullptr};
          gemm_phase<EpiBranch<0>, StaticOrder, false, true>(F.lds, g, S, E); }
        __syncthreads();
        { Gemm g{WSP(bf16_t, WS_YHG), WSP(bf16_t, WS_WBH), MR, DM, 1024}; StaticOrder S; S.init(MR, DM, F.G, bid);
          EpiBranch<1> E{WSP(bf16_t, WS_PROJ), PW, PC_GH, WSP(bf16_t, WS_T1), WSP(bf16_t, WS_MRG)};
          gemm_phase<EpiBranch<1>, StaticOrder, false, true>(F.lds, g, S, E); }
    PEND(7)
    PBEG(8)
        Gemm g{WSP(bf16_t, WS_MRG), WSP(bf16_t, WS_WOUT), MR, DM, DM}; StaticOrder S; S.init(MR, DM, F.G, bid);
        EpiResid<1> E{nullptr, WSP(bf16_t, WS_Z1B), WSP(float, WS_ST1), F.in[5], F.in[6], WSP(bf16_t, WS_Z2B), nullptr, WSP(float, WS_ST2), 1.0f};
        gemm_phase<EpiResid<1>, StaticOrder, false, true>(F.lds, g, S, E);
    PEND(8)
    PBEG(9)
        Gemm g{WSP(bf16_t, WS_Z2B), WSP(bf16_t, WS_WGU2), MR, NGU, DM}; StaticOrder S; S.init(MR, NGU, F.G, bid);
        EpiSwiGLU<true> E{WSP(bf16_t, WS_G2), DFF, WSP(float, WS_ST2), WSP(float, WS_CSV) + PW, WSP(float, WS_BWV) + PW};
        gemm_phase<EpiSwiGLU<true>, StaticOrder, true, true>(F.lds, g, S, E);
    PEND(9)
    PBEG(10)
        Gemm g{WSP(bf16_t, WS_G2), WSP(bf16_t, WS_WD2), MR, DM, DFF}; StaticOrder S; S.init(MR, DM, F.G, bid);
        EpiResid<2> E{nullptr, WSP(bf16_t, WS_Z2B), WSP(float, WS_ST2), F.in[15], F.in[16], nullptr, F.out, WSP(float, WS_ST3), 0.5f};
        gemm_phase<EpiResid<2>, StaticOrder, false, true>(F.lds, g, S, E);
    PEND(10)
    if (IN(11)) { p11_final_ln(F); }
#undef IN
#undef SEAM
}

#ifndef MK_CUTS
#define MK_CUTS {0, NPH}
#endif
extern "C" void kernel_launch(void* const* d_in, const int* in_sizes, int n_in, void* d_out, int out_size, void* d_ws, size_t ws_size, hipStream_t stream) {
    static int grid = 0;
    if (grid == 0) {
        if (n_in != 22 || out_size != MR * DM || ws_size < WS_END) { fprintf(stderr, "kernel_launch: unexpected shapes (n_in %d, out %d, ws %zu < %zu)\n", n_in, out_size, ws_size, (size_t)WS_END); grid = -1; return; }
        int dev = 0, cus = 0, per_cu = 0;
        if (hipGetDevice(&dev) != hipSuccess || hipDeviceGetAttribute(&cus, hipDeviceAttributeMultiprocessorCount, dev) != hipSuccess) { grid = -1; return; }
        if (hipFuncSetAttribute((const void*)mk_fwd, hipFuncAttributeMaxDynamicSharedMemorySize, LDS_BYTES) != hipSuccess) { fprintf(stderr, "kernel_launch: hipFuncSetAttribute failed\n"); grid = -1; return; }
        if (hipOccupancyMaxActiveBlocksPerMultiprocessor(&per_cu, (const void*)mk_fwd, 512, LDS_BYTES) != hipSuccess || per_cu < 1) { fprintf(stderr, "kernel_launch: occupancy query says %d blocks per CU\n", per_cu); grid = -1; (void)hipGetLastError(); return; }
        grid = cus;
        if (grid != 256) fprintf(stderr, "kernel_launch: %d CUs; the one-unit-per-workgroup GEMM phases assume 256\n", grid);
    }
    if (grid < 0) return;
    (void)hipMemsetAsync((char*)d_ws + WS_CTL, 0, CTL_BYTES, stream);
    Args a{};
    for (int i = 0; i < 22; ++i) a.in[i] = (const float*)d_in[i];
    a.out = (float*)d_out; a.ws = (unsigned char*)d_ws;
    const int cuts[] = MK_CUTS; const int nl = (int)(sizeof(cuts) / sizeof(int)) - 1;
    for (int li = 0; li < nl; ++li) {
        a.ph_lo = cuts[li]; a.ph_hi = cuts[li + 1]; a.li = li; a.pad = 0;
        void* kargs[] = {&a};
        const hipError_t e = hipLaunchCooperativeKernel((const void*)mk_fwd, dim3(grid), dim3(512), kargs, LDS_BYTES, stream);
        if (e != hipSuccess) { fprintf(stderr, "kernel_launch: cooperative launch %d failed: %s\n", li, hipGetErrorString(e)); break; }
    }
}
```

```cpp
#include <hip/hip_runtime.h>
#include <cstdio>
#include <cstdint>
namespace pg8 {
#define PG8_LAS __attribute__((address_space(3)))
typedef unsigned short bf16_t;
typedef short bf16x8 __attribute__((ext_vector_type(8)));
typedef float f32x4 __attribute__((ext_vector_type(4)));
typedef unsigned u32x4 __attribute__((ext_vector_type(4)));
constexpr int BM = 256, BK = 64, HALF = 128, HTB = HALF * BK * 2  , STAGE_BYTES = 8 * HTB, NXCD = 8, WGM = 8;

__host__ __device__ __forceinline__ int lds_byte(int r, int c) { const int st = (r >> 4) * 2 + (c >> 5), rr = r & 15, cc = c & 31, ob = rr * 64 + cc * 2; return st * 1024 + (ob ^ (((ob >> 9) & 1) << 5)); }
__host__ __device__ __forceinline__ void stage_rc(int b, int& R, int& C) { const int st = b / 1024, sb = b % 1024, swz = sb ^ (((sb >> 9) & 1) << 5); R = (st >> 1) * 16 + swz / 64; C = (st & 1) * 32 + (swz % 64) / 2; }
__host__ __device__ __forceinline__ int perm32(int rho) { const int n = rho >> 4, i = rho & 15; return 8 * (i >> 2) + 4 * n + (i & 3); }

struct Unit { int pm, pn; };
struct Gemm { const bf16_t* A; const bf16_t* Bt; int M, N, K; };

struct StaticOrder {
    int nM, nN, nwg, G, c;
    __host__ __device__ void init(int M, int N, int G_, int c_) { nM = M / BM; nN = N / BM; nwg = nM * nN; G = G_; c = c_; }
    __host__ __device__ bool next(int i, Unit& u) const {
        const long L = (long)i * G + c; if (L >= nwg) return false;
        int wgid = (int)L; { const int q = nwg / NXCD, r = nwg % NXCD, xcd = wgid % NXCD, off = wgid / NXCD; wgid = (xcd < r ? xcd * (q + 1) : r * (q + 1) + (xcd - r) * q) + off; }
        const int nig = WGM * nN, gid = wgid / nig, fm = gid * WGM, gsz = (nM - fm) < WGM ? (nM - fm) : WGM;
        u.pm = fm + ((wgid % nig) % gsz); u.pn = (wgid % nig) / gsz; return true;
    }
    __device__ __forceinline__ void a_ready(const Unit&) const {}
    __device__ __forceinline__ void done(const Unit&) const {}
};

__device__ __forceinline__ unsigned cvt_pk_bf16(float lo, float hi) { unsigned r; asm volatile("v_cvt_pk_bf16_f32 %0, %1, %2" : "=v"(r) : "v"(lo), "v"(hi)); return r; }
typedef float f32x2 __attribute__((ext_vector_type(2)));
typedef unsigned u32x2 __attribute__((ext_vector_type(2)));
__device__ __forceinline__ float bflo(unsigned w) { return __uint_as_float(w << 16); }
__device__ __forceinline__ float bfhi(unsigned w) { return __uint_as_float(w & 0xffff0000u); }
__device__ __forceinline__ float sigm(float x) { return __builtin_amdgcn_rcpf(1.f + __expf(-x)); }
__device__ __forceinline__ float silu(float x) { return x * sigm(x); }
__device__ __forceinline__ void row_stats(const float* slab, int row, float& mu, float& rstd) {
    const f32x4* p = (const f32x4*)(slab + (size_t)row * 16);
    const f32x4 a = p[0], b = p[1], c = p[2], d = p[3];
    const float s = ((a[0] + a[2]) + (b[0] + b[2])) + ((c[0] + c[2]) + (d[0] + d[2]));
    const float q = ((a[1] + a[3]) + (b[1] + b[3])) + ((c[1] + c[3]) + (d[1] + d[3]));
    mu = s * (1.0f / 2048.0f);
    const float var = fmaxf(q * (1.0f / 2048.0f) - mu * mu, 0.f);
    rstd = __builtin_amdgcn_rsqf(var + 1e-5f);
}
struct StatTbl { const PG8_LAS int* slot; const PG8_LAS float* tbl;
    __device__ __forceinline__ void get(int pm, int lr, float& mu, float& rs) const { const int sl = slot[pm]; const PG8_LAS float* p = tbl + (sl * 256 + lr) * 2; mu = p[0]; rs = p[1]; } };
template <bool LNF> struct EpiSwiGLU {
    static constexpr bool PERM = true, AFTER_DRAIN = false;
    bf16_t* O; int ldc; StatTbl st; const float* cs; const float* bw;
    __device__ __forceinline__ void operator()(const f32x4 (&acc)[2][2][4][2], const Unit& u, int wr, int wc, int fr, int fq) const {
        const int row0 = u.pm * BM + wr * 64 + fr;
        const int ocol = u.pn * 128 + wc * 32 + 8 * fq;
        const int brow = u.pn * BM + wc * 32 + 8 * fq;
        f32x4 csg[2], csu[2], bwg[2], bwu[2];
        float mu[8], rs[8];
#pragma unroll
        for (int n = 0; n < 2; ++n) {
            if (LNF) { csg[n] = *(const f32x4*)(cs + brow + 4 * n); csu[n] = *(const f32x4*)(cs + brow + 128 + 4 * n); bwg[n] = *(const f32x4*)(bw + brow + 4 * n); bwu[n] = *(const f32x4*)(bw + brow + 128 + 4 * n); }
            else { csg[n] = csu[n] = bwg[n] = bwu[n] = (f32x4){0.f, 0.f, 0.f, 0.f}; }
        }
#pragma unroll
        for (int g = 0; g < 8; ++g) { mu[g] = 0.f; rs[g] = 1.f; if (LNF) st.get(u.pm, (g >> 2) * HALF + wr * 64 + (g & 3) * 16 + fr, mu[g], rs[g]); }
#pragma unroll
        for (int ai = 0; ai < 2; ++ai)
#pragma unroll
            for (int m = 0; m < 4; ++m) {
                const int row = row0 + ai * HALF + m * 16; const float mu_ = mu[ai * 4 + m], rs_ = rs[ai * 4 + m];
                u32x4 w;
#pragma unroll
                for (int n = 0; n < 2; ++n) {
                    f32x4 g = acc[ai][0][m][n], up = acc[ai][1][m][n];
                    if (LNF) { g = (g - mu_ * csg[n]) * rs_ + bwg[n]; up = (up - mu_ * csu[n]) * rs_ + bwu[n]; }
                    const float o0 = silu(g[0]) * up[0], o1 = silu(g[1]) * up[1], o2 = silu(g[2]) * up[2], o3 = silu(g[3]) * up[3];
                    w[2 * n] = cvt_pk_bf16(o0, o1); w[2 * n + 1] = cvt_pk_bf16(o2, o3);
                }
                *(u32x4*)(O + (size_t)row * ldc + ocol) = w;
            }
    }
};
struct EpiProj {
    static constexpr bool PERM = true, AFTER_DRAIN = false;
    bf16_t* O; int ldc; StatTbl st; const float* cs; const float* bw;
    __device__ __forceinline__ void operator()(const f32x4 (&acc)[2][2][4][2], const Unit& u, int wr, int wc, int fr, int fq) const {
        const int col0 = u.pn * BM + wc * 32 + 8 * fq;
        f32x4 cv[2][2], bv[2][2];
        float mu[8], rs[8];
#pragma unroll
        for (int bj = 0; bj < 2; ++bj)
#pragma unroll
            for (int n = 0; n < 2; ++n) { cv[bj][n] = *(const f32x4*)(cs + col0 + bj * HALF + 4 * n); bv[bj][n] = *(const f32x4*)(bw + col0 + bj * HALF + 4 * n); }
#pragma unroll
        for (int g = 0; g < 8; ++g) st.get(u.pm, (g >> 2) * HALF + wr * 64 + (g & 3) * 16 + fr, mu[g], rs[g]);
#pragma unroll
        for (int ai = 0; ai < 2; ++ai)
#pragma unroll
            for (int m = 0; m < 4; ++m) {
                const int lr = ai * HALF + wr * 64 + m * 16 + fr, row = u.pm * BM + lr; const float mu_ = mu[ai * 4 + m], rs_ = rs[ai * 4 + m];
#pragma unroll
                for (int bj = 0; bj < 2; ++bj) {
                    const f32x4 v0 = (acc[ai][bj][m][0] - mu_ * cv[bj][0]) * rs_ + bv[bj][0], v1 = (acc[ai][bj][m][1] - mu_ * cv[bj][1]) * rs_ + bv[bj][1];
                    u32x4 w; w.x = cvt_pk_bf16(v0[0], v0[1]); w.y = cvt_pk_bf16(v0[2], v0[3]); w.z = cvt_pk_bf16(v1[0], v1[1]); w.w = cvt_pk_bf16(v1[2], v1[3]);
                    *(u32x4*)(O + (size_t)row * ldc + col0 + bj * HALF) = w;
                }
            }
    }
};
template <int MODE> struct EpiResid {
    static constexpr bool PERM = false, AFTER_DRAIN = true;
    const float* xres; const bf16_t* zprev; StatTbl st; const float* lg; const float* lb; bf16_t* zb; float* zf; float* oslab; float sc;
    struct Pre { f32x4 x[4]; u32x2 z[4]; };
    __device__ __forceinline__ void load(Pre& P, int row, int col0) const {
#pragma unroll
        for (int q = 0; q < 4; ++q) { const size_t off = (size_t)row * 2048 + col0 + (q >> 1) * HALF + (q & 1) * 16;
            if (MODE == 0) P.x[q] = *(const f32x4*)(xres + off); else P.z[q] = *(const u32x2*)(zprev + off); }
    }
    __device__ __forceinline__ void fused(f32x4 (&acc)[2][2][4][2], const Unit& u, int wr, int wc, int fr, int fq, PG8_LAS unsigned char* lds, int wid, int lane) const {
        const float alpha = 1.18920711500272f;
        const int col0 = u.pn * BM + wc * 32 + 4 * fq;
        PG8_LAS float* P = (PG8_LAS float*)lds;
        f32x4 gv[4], bv[4]; float mu[8], rs[8];
#pragma unroll
        for (int q = 0; q < 4; ++q) { if (MODE != 0) { gv[q] = *(const f32x4*)(lg + col0 + (q >> 1) * HALF + (q & 1) * 16); bv[q] = *(const f32x4*)(lb + col0 + (q >> 1) * HALF + (q & 1) * 16); } else { gv[q] = bv[q] = (f32x4){0.f, 0.f, 0.f, 0.f}; } }
#pragma unroll
        for (int g = 0; g < 8; ++g) { mu[g] = 0.f; rs[g] = 1.f; if (MODE != 0) st.get(u.pm, (g >> 2) * HALF + wr * 64 + (g & 3) * 16 + fr, mu[g], rs[g]); }
        Pre cur, nxt;
        load(cur, u.pm * BM + wr * 64 + fr, col0);
#pragma unroll
        for (int g = 0; g < 8; ++g) {
            const int ai = g >> 2, m = g & 3;
            const int lr = ai * HALF + wr * 64 + m * 16 + fr, row = u.pm * BM + lr;
            if (g < 7) load(nxt, u.pm * BM + ((g + 1) >> 2) * HALF + wr * 64 + ((g + 1) & 3) * 16 + fr, col0);
            float s1 = 0.f, s2 = 0.f;
#pragma unroll
            for (int q = 0; q < 4; ++q) {
                const int bj = q >> 1, n = q & 1; const size_t off = (size_t)row * 2048 + col0 + bj * HALF + n * 16;
                f32x4 res;
                if (MODE == 0) res = cur.x[q];
                else { const u32x2 zz = cur.z[q]; const f32x4 zv = (f32x4){bflo(zz.x), bfhi(zz.x), bflo(zz.y), bfhi(zz.y)}; res = (zv - mu[g]) * rs[g] * gv[q] + bv[q]; }
                const f32x4 z = alpha * res + sc * acc[ai][bj][m][n];
                s1 += (z[0] + z[1]) + (z[2] + z[3]); s2 += (z[0] * z[0] + z[1] * z[1]) + (z[2] * z[2] + z[3] * z[3]);
                if (MODE == 2) *(f32x4*)(zf + off) = z;
                else { u32x2 w; w.x = cvt_pk_bf16(z[0], z[1]); w.y = cvt_pk_bf16(z[2], z[3]); *(u32x2*)(zb + off) = w; }
            }
            s1 += __shfl_xor(s1, 16); s1 += __shfl_xor(s1, 32); s2 += __shfl_xor(s2, 16); s2 += __shfl_xor(s2, 32);
            if (fq == 0) { P[(lr * 4 + wc) * 2] = s1; P[(lr * 4 + wc) * 2 + 1] = s2; }
            cur = nxt;
        }
        __syncthreads();
        const int tid = wid * 64 + lane;
        if (tid < 256) {
            const PG8_LAS float* p = P + tid * 8;
            const float a = (p[0] + p[2]) + (p[4] + p[6]), b = (p[1] + p[3]) + (p[5] + p[7]);
            float* o = oslab + ((size_t)(u.pm * BM + tid) * 8 + u.pn) * 2; o[0] = a; o[1] = b;
        }
    }
};
template <int SECOND> struct EpiBranch {
    static constexpr bool PERM = true, AFTER_DRAIN = false;
    const bf16_t* proj; int ldp, gcol; bf16_t* t1; bf16_t* out;
    struct Pre { u32x4 g[2], t[2]; };
    __device__ __forceinline__ void load(Pre& P, int row, int col0) const {
#pragma unroll
        for (int bj = 0; bj < 2; ++bj) { P.g[bj] = *(const u32x4*)(proj + (size_t)row * ldp + gcol + col0 + bj * HALF); if (SECOND) P.t[bj] = *(const u32x4*)(t1 + (size_t)row * 2048 + col0 + bj * HALF); else P.t[bj] = (u32x4){0u, 0u, 0u, 0u}; }
    }
    __device__ __forceinline__ void operator()(const f32x4 (&acc)[2][2][4][2], const Unit& u, int wr, int wc, int fr, int fq) const {
        const int col0 = u.pn * BM + wc * 32 + 8 * fq, row0 = u.pm * BM + wr * 64 + fr;
        Pre cur, nxt;
        load(cur, row0, col0);
#pragma unroll
        for (int g = 0; g < 8; ++g) {
            const int ai = g >> 2, m = g & 3, row = row0 + ai * HALF + m * 16;
            if (g < 7) load(nxt, row0 + ((g + 1) >> 2) * HALF + ((g + 1) & 3) * 16, col0);
#pragma unroll
            for (int bj = 0; bj < 2; ++bj) {
                const u32x4 gz = cur.g[bj], tz = cur.t[bj];
                const f32x4 a0 = acc[ai][bj][m][0], a1 = acc[ai][bj][m][1];
                const float v0 = bflo(tz.x) + sigm(bflo(gz.x)) * a0[0], v1 = bfhi(tz.x) + sigm(bfhi(gz.x)) * a0[1], v2 = bflo(tz.y) + sigm(bflo(gz.y)) * a0[2], v3 = bfhi(tz.y) + sigm(bfhi(gz.y)) * a0[3];
                const float v4 = bflo(tz.z) + sigm(bflo(gz.z)) * a1[0], v5 = bfhi(tz.z) + sigm(bfhi(gz.z)) * a1[1], v6 = bflo(tz.w) + sigm(bflo(gz.w)) * a1[2], v7 = bfhi(tz.w) + sigm(bfhi(gz.w)) * a1[3];
                u32x4 w; w.x = cvt_pk_bf16(v0, v1); w.y = cvt_pk_bf16(v2, v3); w.z = cvt_pk_bf16(v4, v5); w.w = cvt_pk_bf16(v6, v7);
                *(u32x4*)((SECOND ? out : t1) + (size_t)row * 2048 + col0 + bj * HALF) = w;
            }
            cur = nxt;
        }
    }
};

template <class Epi, class Sched, bool ALIGN_EPI = false, bool SP2 = false>
__device__ __forceinline__ void gemm_phase(PG8_LAS unsigned char* lds, const Gemm g, const Sched& S, const Epi& E) {
    const int tid = threadIdx.x, wid = __builtin_amdgcn_readfirstlane(tid >> 6), lane = tid & 63, wr = wid >> 2, wc = wid & 3, fr = lane & 15, fq = lane >> 4;
    const int K = g.K, nt = K / BK;
    unsigned voffA[2], voffB[2];
#pragma unroll
    for (int i = 0; i < 2; ++i) { int R, C; stage_rc(tid * 16 + i * 8192, R, C); const int Rb = Epi::PERM ? ((R & ~31) + perm32(R & 31)) : R;
        voffA[i] = (unsigned)(R * K + C) * 2u; voffB[i] = (unsigned)(Rb * K + C) * 2u; }
    const size_t kstep = (size_t)(BK * 2);
    const size_t hstep = (size_t)HALF * K * 2;
    const size_t tstep = 2 * hstep;
    const unsigned ldsw = (unsigned)wid * 1024u;
    const int aoff = lds_byte(wr * 64 + fr, fq * 8), boff = lds_byte(wc * 32 + fr, fq * 8);
#define PG8_SA(b, h) (((b) * 2 + (h)) * HTB)
#define PG8_SB(b, h) ((4 + (b) * 2 + (h)) * HTB)
#define PG8_STAGE(bufoff, gbase, voff) do { _Pragma("unroll") for (int _i = 0; _i < 2; ++_i) \
        __builtin_amdgcn_global_load_lds((const unsigned*)((const char*)(gbase) + (voff)[_i]), (PG8_LAS unsigned*)(lds + (bufoff) + ldsw + _i * 8192), 16, 0, 0); } while (0)
#define PG8_LDA(dst, b, h) do { _Pragma("unroll") for (int m = 0; m < 4; ++m) _Pragma("unroll") for (int k = 0; k < 2; ++k) dst[m][k] = *(const PG8_LAS bf16x8*)(lds + PG8_SA(b, h) + aoff + m * 2048 + k * 1024); } while (0)
#define PG8_LDB(dst, b, h) do { _Pragma("unroll") for (int n = 0; n < 2; ++n) _Pragma("unroll") for (int k = 0; k < 2; ++k) dst[n][k] = *(const PG8_LAS bf16x8*)(lds + PG8_SB(b, h) + boff + n * 2048 + k * 1024); } while (0)
#define PG8_MMA(ai, bj, At, Bt) do { __builtin_amdgcn_s_setprio(1); _Pragma("unroll") for (int m = 0; m < 4; ++m) _Pragma("unroll") for (int n = 0; n < 2; ++n) _Pragma("unroll") for (int k = 0; k < 2; ++k) \
        acc[ai][bj][m][n] = __builtin_amdgcn_mfma_f32_16x16x32_bf16(Bt[n][k], At[m][k], acc[ai][bj][m][n], 0, 0, 0); __builtin_amdgcn_s_setprio(0); } while (0)
#define PG8_WAIT_V(n) asm volatile("s_waitcnt vmcnt(" #n ")" ::: "memory")
#define PG8_WAIT_L(n) asm volatile("s_waitcnt lgkmcnt(" #n ")" ::: "memory")
#define PG8_BAR __builtin_amdgcn_s_barrier()
#define PG8_SCHED __builtin_amdgcn_sched_barrier(0)
    Unit cur, nxt; int ui = 0;
    if (!S.next(0, cur)) return;
    f32x4 acc[2][2][4][2];
#pragma unroll
    for (int a = 0; a < 2; ++a)
#pragma unroll
        for (int b = 0; b < 2; ++b)
#pragma unroll
            for (int m = 0; m < 4; ++m)
#pragma unroll
                for (int n = 0; n < 2; ++n) acc[a][b][m][n] = (f32x4){0.f, 0.f, 0.f, 0.f};
    bf16x8 At[4][2], B0[2][2], B1[2][2];
    const char* cA = (const char*)g.A + (size_t)cur.pm * tstep; const char* cB = (const char*)g.Bt + (size_t)cur.pn * tstep;
    S.a_ready(cur);
    if constexpr (SP2) {
        PG8_STAGE(PG8_SB(0, 0), cB, voffB); PG8_STAGE(PG8_SB(0, 1), cB + hstep, voffB); PG8_STAGE(PG8_SA(0, 0), cA, voffA); PG8_STAGE(PG8_SA(0, 1), cA + hstep, voffA);
        if (wr == 1) PG8_BAR;
        PG8_WAIT_V(2); PG8_BAR;
        PG8_STAGE(PG8_SB(1, 0), cB + kstep, voffB); PG8_STAGE(PG8_SA(1, 0), cA + kstep, voffA); PG8_STAGE(PG8_SB(1, 1), cB + hstep + kstep, voffB);
        PG8_WAIT_V(6); PG8_BAR;
    } else {
        PG8_STAGE(PG8_SB(0, 0), cB, voffB); PG8_STAGE(PG8_SA(0, 0), cA, voffA); PG8_STAGE(PG8_SB(0, 1), cB + hstep, voffB); PG8_STAGE(PG8_SA(0, 1), cA + hstep, voffA);
        if (wr == 1) PG8_BAR;
        PG8_WAIT_V(4); PG8_BAR;
        PG8_STAGE(PG8_SB(1, 0), cB + kstep, voffB); PG8_STAGE(PG8_SA(1, 0), cA + kstep, voffA); PG8_STAGE(PG8_SB(1, 1), cB + hstep + kstep, voffB);
        PG8_WAIT_V(6); PG8_BAR;
    }
    for (;;) {
        const bool has_next = S.next(ui + 1, nxt);
        const char* nA = has_next ? (const char*)g.A + (size_t)nxt.pm * tstep : cA; const char* nB = has_next ? (const char*)g.Bt + (size_t)nxt.pn * tstep : cB;
        for (int t = 0; t < nt; t += 2) {
            const bool last = (t == nt - 2);
            const char* a1 = cA + (size_t)(t + 1) * kstep;
            const char* a2 = last ? nA : cA + (size_t)(t + 2) * kstep; const char* b2 = last ? nB : cB + (size_t)(t + 2) * kstep;
            const char* a3 = a2 + kstep; const char* b3 = b2 + kstep;
            if (last && has_next) S.a_ready(nxt);
            if constexpr (SP2) {
            PG8_LDB(B0, 0, 0); PG8_LDB(B1, 0, 1); PG8_SCHED; PG8_LDA(At, 0, 0); PG8_STAGE(PG8_SA(1, 1), a1 + hstep, voffA);
            PG8_WAIT_V(8); PG8_WAIT_L(0); PG8_BAR; PG8_MMA(0, 0, At, B0); PG8_MMA(0, 1, At, B1); PG8_BAR; PG8_SCHED;
            PG8_LDA(At, 0, 1); PG8_STAGE(PG8_SB(0, 0), b2, voffB); PG8_STAGE(PG8_SB(0, 1), b2 + hstep, voffB); PG8_STAGE(PG8_SA(0, 0), a2, voffA);
            PG8_WAIT_V(8); PG8_WAIT_L(0); PG8_BAR; PG8_MMA(1, 0, At, B0); PG8_MMA(1, 1, At, B1); PG8_BAR; PG8_SCHED;
            PG8_LDB(B0, 1, 0); PG8_LDB(B1, 1, 1); PG8_SCHED; PG8_LDA(At, 1, 0); PG8_STAGE(PG8_SA(0, 1), a2 + hstep, voffA);
            PG8_WAIT_V(8); PG8_WAIT_L(0); PG8_BAR; PG8_MMA(0, 0, At, B0); PG8_MMA(0, 1, At, B1); PG8_BAR; PG8_SCHED;
            PG8_LDA(At, 1, 1); PG8_STAGE(PG8_SB(1, 0), b3, voffB); PG8_STAGE(PG8_SB(1, 1), b3 + hstep, voffB); PG8_STAGE(PG8_SA(1, 0), a3, voffA);
            PG8_WAIT_V(8); PG8_WAIT_L(0); PG8_BAR; PG8_MMA(1, 0, At, B0); PG8_MMA(1, 1, At, B1); PG8_BAR; PG8_SCHED;
            } else {
            PG8_LDB(B0, 0, 0); PG8_SCHED; PG8_LDA(At, 0, 0); PG8_STAGE(PG8_SA(1, 1), a1 + hstep, voffA);
            PG8_WAIT_L(8); PG8_BAR; PG8_WAIT_L(0); PG8_MMA(0, 0, At, B0); PG8_BAR; PG8_SCHED;
            PG8_LDB(B1, 0, 1); PG8_STAGE(PG8_SB(0, 0), b2, voffB);
            PG8_BAR; PG8_WAIT_L(0); PG8_MMA(0, 1, At, B1); PG8_BAR;
            PG8_LDA(At, 0, 1); PG8_STAGE(PG8_SA(0, 0), a2, voffA);
            PG8_BAR; PG8_WAIT_L(0); PG8_MMA(1, 0, At, B0); PG8_BAR; PG8_SCHED;
            PG8_STAGE(PG8_SB(0, 1), b2 + hstep, voffB);
            PG8_WAIT_V(6); PG8_BAR; PG8_MMA(1, 1, At, B1); PG8_BAR;
            PG8_LDB(B0, 1, 0); PG8_SCHED; PG8_LDA(At, 1, 0); PG8_STAGE(PG8_SA(0, 1), a2 + hstep, voffA);
            PG8_WAIT_L(8); PG8_BAR; PG8_WAIT_L(0); PG8_MMA(0, 0, At, B0); PG8_BAR; PG8_SCHED;
            PG8_LDB(B1, 1, 1); PG8_STAGE(PG8_SB(1, 0), b3, voffB);
            PG8_BAR; PG8_WAIT_L(0); PG8_MMA(0, 1, At, B1); PG8_BAR;
            PG8_LDA(At, 1, 1); PG8_STAGE(PG8_SA(1, 0), a3, voffA);
            PG8_BAR; PG8_WAIT_L(0); PG8_MMA(1, 0, At, B0); PG8_BAR; PG8_SCHED;
            PG8_STAGE(PG8_SB(1, 1), b3 + hstep, voffB);
            PG8_WAIT_V(6); PG8_BAR; PG8_MMA(1, 1, At, B1); PG8_BAR;
            }
        }
        if constexpr (ALIGN_EPI) { if (wr == 0) PG8_BAR; }
        if constexpr (!Epi::AFTER_DRAIN) { E(acc, cur, wr, wc, fr, fq); S.done(cur); }
        if (!has_next) break;
#pragma unroll
        for (int a = 0; a < 2; ++a)
#pragma unroll
            for (int b = 0; b < 2; ++b)
#pragma unroll
                for (int m = 0; m < 4; ++m)
#pragma unroll
                    for (int n = 0; n < 2; ++n) acc[a][b][m][n] = (f32x4){0.f, 0.f, 0.f, 0.f};
        cur = nxt; cA = nA; cB = nB; ++ui;
        if constexpr (ALIGN_EPI) { if (wr == 1) PG8_BAR; }
    }
    PG8_WAIT_V(0);
    if constexpr (!ALIGN_EPI) { if (wr == 0) PG8_BAR; }
    PG8_BAR;
    if constexpr (Epi::AFTER_DRAIN) { E.fused(acc, cur, wr, wc, fr, fq, lds, wid, lane); S.done(cur); }
#undef PG8_SA
#undef PG8_SB
#undef PG8_STAGE
#undef PG8_LDA
#undef PG8_LDB
#undef PG8_MMA
#undef PG8_WAIT_V
#undef PG8_WAIT_L
#undef PG8_BAR
#undef PG8_SCHED
}
}
using namespace pg8;
#define LAS __attribute__((address_space(3)))
typedef short s16x4 __attribute__((ext_vector_type(4)));
typedef float f32x16 __attribute__((ext_vector_type(16)));
typedef float f32x2 __attribute__((ext_vector_type(2)));
#define MFMA32(a, b, c) __builtin_amdgcn_mfma_f32_32x32x16_bf16((a), (b), (c), 0, 0, 0)
#define MFMA16(a, b, c) __builtin_amdgcn_mfma_f32_16x16x32_bf16((a), (b), (c), 0, 0, 0)
#define LDS_WAIT() asm volatile("s_waitcnt lgkmcnt(0)" ::: "memory")

constexpr int NBATCH = 2, SEQ = 4096, DM = 2048, NMETA = 16, MR = NBATCH * SEQ  , MPAD = 8448  , METAROW = 8192;
constexpr int DFF = 5632, NGU = 2 * DFF, PW = 11008  , NPROJ = 10832;
constexpr int PC_AQ = 0, PC_AK = 1024, PC_AV = 1280, PC_IQ = 1536, PC_HQ = 2560, PC_HF = 3584, PC_HI = 4608, PC_HG = 5632, PC_GA = 6656, PC_GH = 8704, PC_IK = 10752, PC_IW = 10816;
constexpr int NCS = PW + NGU;
constexpr size_t MiB = 1u << 20;
constexpr size_t WS_CTL = 0, CTL_BYTES = 1 * MiB;
constexpr size_t WS_PCS = 1 * MiB, WS_PBW = 4 * MiB, WS_CSV = 7 * MiB, WS_BWV = 7 * MiB + 131072, WS_Z1M = 7 * MiB + 262144, WS_ST1 = 8 * MiB, WS_ST2 = 9 * MiB, WS_ST3 = 10 * MiB;
constexpr size_t WS_WGU1 = 11 * MiB, WS_WD1 = 55 * MiB, WS_H0B = 77 * MiB, WS_G = 110 * MiB, WS_PROJ = 11 * MiB, WS_G2 = 11 * MiB;
constexpr size_t WS_WIN = 201 * MiB, WS_IKN = 201 * MiB, WS_SEL = 202 * MiB, WS_GCH = 206 * MiB, WS_YATT = 207 * MiB, WS_YHG = 223 * MiB;
constexpr size_t WS_WBA = 244 * MiB, WS_WBH = 248 * MiB, WS_WOUT = 252 * MiB, WS_WGU2 = 260 * MiB, WS_WD2 = 304 * MiB, WS_Z1B = 326 * MiB;
constexpr size_t WS_QT = 359 * MiB, WS_OI = 375 * MiB, WS_LST = 407 * MiB, WS_T1 = 359 * MiB, WS_MRG = 391 * MiB, WS_Z2B = 359 * MiB, WS_END = 440 * MiB;
static_assert(WS_G + (size_t)MPAD * DFF * 2 <= WS_WIN && WS_PROJ + (size_t)MPAD * PW * 2 <= WS_WIN && WS_LST + (size_t)16 * 65 * 32768 <= WS_END && WS_ST1 + (size_t)MPAD * 64 <= WS_ST2, "ws map");
constexpr int CW_BAR = 4096;
constexpr int RING_BYTES = 131072, MISC_OFF = RING_BYTES, WL_OFF = RING_BYTES + 512, STT_OFF = RING_BYTES + 1024, STT_TBL = STT_OFF + 256, LDS_BYTES = 163840;

typedef unsigned v4u __attribute__((ext_vector_type(4)));
__device__ __forceinline__ unsigned f2bf(float f) { unsigned u = __builtin_bit_cast(unsigned, f); return (u + 0x7fffu + ((u >> 16) & 1u)) >> 16; }
__device__ __forceinline__ unsigned pk2(float lo, float hi) { return f2bf(lo) | (f2bf(hi) << 16); }
__device__ __forceinline__ float bf2f(unsigned short h) { return __uint_as_float(((unsigned)h) << 16); }
__device__ __forceinline__ float bfround(float x) { return __uint_as_float(f2bf(x) << 16); }
__device__ __forceinline__ float wave_sum(float v) {
#pragma unroll
    for (int o = 1; o < 64; o <<= 1) v += __shfl_xor(v, o);
    return v;
}
__device__ __forceinline__ int crow(int reg, int h) { return (reg & 3) + 8 * (reg >> 2) + 4 * h; }

#define XB_TMO      128
#define XB_XCNT(j)  (256  + 64 * (j))
#define XB_XSUB(j)  (1280 + 64 * (j))
#define XB_XGEN(j)  (2304 + 64 * (j))
#define XB_TOP      3328
#define XB_TOPGEN   3392
#define XCD_BAR_WORDS 3456
#define XB_SPIN_CAP (1u << 18)

__device__ __forceinline__ unsigned xb_ld(unsigned* p)              { return __hip_atomic_load(p, __ATOMIC_RELAXED, __HIP_MEMORY_SCOPE_AGENT); }
__device__ __forceinline__ unsigned xb_add(unsigned* p, unsigned v) { return __hip_atomic_fetch_add(p, v, __ATOMIC_RELAXED, __HIP_MEMORY_SCOPE_AGENT); }
__device__ __forceinline__ unsigned xb_xcc_id() { return (unsigned)__builtin_amdgcn_s_getreg((3 << 11) | 20) & 0xFu; }
#define XB_SPIN(cond, bar) do { unsigned _sp = 0; while (cond) { __builtin_amdgcn_s_sleep(1); \
    if ((++_sp & 255u) == 0u) { if (xb_ld(&(bar)[XB_TMO])) break; if (_sp > XB_SPIN_CAP) { atomicAdd(&(bar)[XB_TMO], 1u); break; } } } } while (0)

struct XcdBarrier {
    unsigned* bar; unsigned x;
    volatile LAS unsigned* st;
};

__device__ __forceinline__ XcdBarrier xcd_barrier_post(unsigned* bar, volatile LAS unsigned* st) {
    XcdBarrier b; b.bar = bar; b.x = xb_xcc_id(); b.st = st;
    if (threadIdx.x == 0) (void)xb_add(&bar[XB_XCNT(b.x)], 1u);
    return b;
}
__device__ __forceinline__ void xcd_barrier_complete(unsigned* bar, unsigned x, unsigned& nloc, unsigned& nx) {
    const unsigned G = gridDim.x * gridDim.y * gridDim.z;
    unsigned sum, cnt, mine, sp = 0u;
    for (;;) {
        sum = 0u; cnt = 0u; mine = 0u;
#pragma unroll
        for (unsigned j = 0; j < 16; ++j) { const unsigned c = xb_ld(&bar[XB_XCNT(j)]); sum += c; cnt += (c > 0u) ? 1u : 0u; mine = (j == x) ? c : mine; }
        if (sum == G) break;
        __builtin_amdgcn_s_sleep(1);
        if ((++sp & 255u) == 0u) { if (xb_ld(&bar[XB_TMO])) break; if (sp > XB_SPIN_CAP) { atomicAdd(&bar[XB_TMO], 1u); break; } }
    }
    nloc = mine > 0u ? mine : 1u; nx = cnt > 0u ? cnt : 1u;
}

__device__ __forceinline__ void xcd_barrier(const XcdBarrier& b) {
    asm volatile("s_waitcnt vmcnt(0)" ::: "memory");
    __syncthreads();
    if (threadIdx.x == 0) {
        unsigned* bar = b.bar;
        __builtin_amdgcn_s_waitcnt(0);
        unsigned nloc = b.st[0], nx = b.st[1];
        if (nloc == 0u) { xcd_barrier_complete(bar, b.x, nloc, nx); b.st[0] = nloc; b.st[1] = nx; }
        const unsigned old = xb_add(&bar[XB_XSUB(b.x)], 1u);
        const unsigned gen = old / nloc;
        if (old + 1u == (gen + 1u) * nloc) {
            __builtin_amdgcn_fence(__ATOMIC_RELEASE, "agent");
            asm volatile("s_waitcnt vmcnt(0)" ::: "memory");
            const unsigned og = xb_add(&bar[XB_TOP], 1u);
            const unsigned tg = og / nx;
            if (og + 1u == (tg + 1u) * nx) xb_add(&bar[XB_TOPGEN], 1u);
            else XB_SPIN(xb_ld(&bar[XB_TOPGEN]) == tg, bar);
            __builtin_amdgcn_fence(__ATOMIC_ACQUIRE, "agent");
            xb_add(&bar[XB_XGEN(b.x)], 1u);
            asm volatile("s_waitcnt vmcnt(0)" ::: "memory");
        } else {
            XB_SPIN(xb_ld(&bar[XB_XGEN(b.x)]) == gen, bar);
            __builtin_amdgcn_fence(__ATOMIC_ACQUIRE, "agent");
            asm volatile("s_waitcnt vmcnt(0)" ::: "memory");
        }
    }
    __syncthreads();
}
struct Frame {
    LAS unsigned char* lds;
    int tid, lane, wave, G, gw, NGW;
    const float* in[22]; float* out; unsigned char* ws;
};
#define WSP(T, off) ((T*)(F.ws + (off)))

__device__ __forceinline__ int dst_row(int map, int n) {
    if (map == 1) return ((n >> 7) << 8) + (n & 127);
    if (map == 2) return ((n >> 7) << 8) + 128 + (n & 127);
    if (map == 3) return n < 2560 ? n : (n < 2640 ? n + 8192 : n - 80);
    return n;
}
struct TrJob { const float* W; bf16_t* WT; const float* g; const float* b; int K, N, map, pcol0, item; };
__device__ __forceinline__ bool tr_decode(Frame& F, int it, TrJob& J) {
    constexpr int I_GU = 32 * 176, I_DN = 88 * 64, I_IN = 32 * 339, I_BR = 16 * 64, I_OUT = 32 * 64;
    constexpr int NITEMS = 6 * I_GU + I_IN + 2 * I_BR + I_OUT;
    static_assert(I_DN == I_GU, "items");
    if (it >= NITEMS) return false;
    int r = it; J.g = nullptr; J.b = nullptr; J.pcol0 = 0; J.map = 0;
    if (r < I_GU) { J.W = F.in[2]; J.K = DM; J.N = DFF; J.WT = WSP(bf16_t, WS_WGU1); J.map = 1; J.item = r; return true; } r -= I_GU;
    if (r < I_GU) { J.W = F.in[3]; J.K = DM; J.N = DFF; J.WT = WSP(bf16_t, WS_WGU1); J.map = 2; J.item = r; return true; } r -= I_GU;
    if (r < I_DN) { J.W = F.in[4]; J.K = DFF; J.N = DM; J.WT = WSP(bf16_t, WS_WD1); J.item = r; return true; } r -= I_DN;
    if (r < I_IN) { J.W = F.in[7]; J.K = DM; J.N = NPROJ; J.WT = WSP(bf16_t, WS_WIN); J.map = 3; J.g = F.in[5]; J.b = F.in[6]; J.item = r; return true; } r -= I_IN;
    if (r < I_BR) { J.W = F.in[12]; J.K = 1024; J.N = DM; J.WT = WSP(bf16_t, WS_WBA); J.item = r; return true; } r -= I_BR;
    if (r < I_BR) { J.W = F.in[13]; J.K = 1024; J.N = DM; J.WT = WSP(bf16_t, WS_WBH); J.item = r; return true; } r -= I_BR;
    if (r < I_OUT) { J.W = F.in[14]; J.K = DM; J.N = DM; J.WT = WSP(bf16_t, WS_WOUT); J.item = r; return true; } r -= I_OUT;
    if (r < I_GU) { J.W = F.in[17]; J.K = DM; J.N = DFF; J.WT = WSP(bf16_t, WS_WGU2); J.map = 1; J.g = F.in[15]; J.b = F.in[16]; J.pcol0 = PW; J.item = r; return true; } r -= I_GU;
    if (r < I_GU) { J.W = F.in[18]; J.K = DM; J.N = DFF; J.WT = WSP(bf16_t, WS_WGU2); J.map = 2; J.g = F.in[15]; J.b = F.in[16]; J.pcol0 = PW; J.item = r; return true; } r -= I_GU;
    J.W = F.in[19]; J.K = DFF; J.N = DM; J.WT = WSP(bf16_t, WS_WD2); J.item = r; return true;
}
__device__ __forceinline__ void tr_load(const TrJob& J, int lane, f32x4 (&v)[8]) {
    const int nblk = (J.N + 31) >> 5, kb = J.item / nblk, nb = J.item - kb * nblk, k0 = 64 * kb, nn = 32 * nb + 4 * (lane & 7);
    const float* p = J.W + (size_t)(k0 + (lane >> 3)) * J.N + nn; const bool ok = nn < J.N;
#pragma unroll
    for (int i = 0; i < 8; ++i) v[i] = ok ? *(const f32x4*)(p + (size_t)(8 * i) * J.N) : (f32x4){0.f, 0.f, 0.f, 0.f};
}
__device__ __forceinline__ void tr_process(const TrJob& J, f32x4 (&v)[8], float* pcs, float* pbw, LAS float* scr, int lane) {
    const int nblk = (J.N + 31) >> 5, kb = J.item / nblk, nb = J.item - kb * nblk, k0 = 64 * kb, n0 = 32 * nb, nn = n0 + 4 * (lane & 7);
    if (J.g) {
        float cs[4] = {0.f, 0.f, 0.f, 0.f}, bw[4] = {0.f, 0.f, 0.f, 0.f};
#pragma unroll
        for (int i = 0; i < 8; ++i) { const int k = k0 + (lane >> 3) + 8 * i; const float gk = J.g[k], bk = J.b[k];
#pragma unroll
            for (int e = 0; e < 4; ++e) { bw[e] += bk * v[i][e]; v[i][e] *= gk; cs[e] += bfround(v[i][e]); } }
#pragma unroll
        for (int e = 0; e < 4; ++e) { cs[e] += __shfl_xor(cs[e], 8); cs[e] += __shfl_xor(cs[e], 16); cs[e] += __shfl_xor(cs[e], 32); bw[e] += __shfl_xor(bw[e], 8); bw[e] += __shfl_xor(bw[e], 16); bw[e] += __shfl_xor(bw[e], 32); }
        if (lane < 8 && nn < J.N) {
#pragma unroll
            for (int e = 0; e < 4; ++e) { const int d = J.pcol0 + dst_row(J.map, nn + e); pcs[(size_t)kb * NCS + d] = cs[e]; pbw[(size_t)kb * NCS + d] = bw[e]; } }
    }
#pragma unroll
    for (int i = 0; i < 8; ++i) { LAS float* q = scr + ((lane >> 3) + 8 * i) * 33 + 4 * (lane & 7); q[0] = v[i][0]; q[1] = v[i][1]; q[2] = v[i][2]; q[3] = v[i][3]; }
    LDS_WAIT(); asm volatile("" ::: "memory");
    const int c = lane & 7;
#pragma unroll
    for (int j = 0; j < 4; ++j) { const int n = (lane >> 3) + 8 * j; const LAS float* s = scr + (8 * c) * 33 + n;
        if (n0 + n < J.N) { v4u o; o.x = pk2(s[0 * 33], s[1 * 33]); o.y = pk2(s[2 * 33], s[3 * 33]); o.z = pk2(s[4 * 33], s[5 * 33]); o.w = pk2(s[6 * 33], s[7 * 33]);
            *(v4u*)(J.WT + (size_t)dst_row(J.map, n0 + n) * J.K + k0 + 8 * c) = o; } }
    LDS_WAIT(); asm volatile("" ::: "memory");
}
__device__ __forceinline__ void p0_prologue(Frame& F) {
    LAS float* scr = (LAS float*)(F.lds + F.wave * 16384);
    float* pcs = WSP(float, WS_PCS); float* pbw = WSP(float, WS_PBW);
    {
        TrJob cur, nxt; f32x4 va[8], vb[8];
        bool have = tr_decode(F, F.gw, cur);
        if (have) tr_load(cur, F.lane, va);
        for (int it = F.gw; have; it += F.NGW) {
            const bool hn = tr_decode(F, it + F.NGW, nxt);
            if (hn) tr_load(nxt, F.lane, vb);
            tr_process(cur, va, pcs, pbw, scr, F.lane);
            cur = nxt; have = hn;
#pragma unroll
            for (int i = 0; i < 8; ++i) va[i] = vb[i];
        }
    }
    bf16_t* h0b = WSP(bf16_t, WS_H0B); bf16_t* z1b = WSP(bf16_t, WS_Z1B); bf16_t* wint = WSP(bf16_t, WS_WIN);
    for (int m = F.gw; m < MPAD + (PW - NPROJ); m += F.NGW) {
        if (m >= MPAD) { u32x2* o = (u32x2*)(wint + (size_t)(NPROJ + m - MPAD) * DM) + F.lane;
#pragma unroll
            for (int j = 0; j < 8; ++j) o[64 * j] = (u32x2){0u, 0u};
            continue; }
        const float* src = m < MR ? F.in[0] + (size_t)m * DM : (m < MR + NMETA ? F.in[1] + (size_t)(m - MR) * DM : nullptr);
        u32x2* o = (u32x2*)(h0b + (size_t)m * DM) + F.lane;
        f32x4 xv[8];
#pragma unroll
        for (int j = 0; j < 8; ++j) xv[j] = src ? ((const f32x4*)src)[F.lane + 64 * j] : (f32x4){0.f, 0.f, 0.f, 0.f};
#pragma unroll
        for (int j = 0; j < 8; ++j) { u32x2 w; w.x = pk2(xv[j][0], xv[j][1]); w.y = pk2(xv[j][2], xv[j][3]); o[64 * j] = w; }
        if (m >= MR + NMETA) { u32x2* oz = (u32x2*)(z1b + (size_t)m * DM) + F.lane;
#pragma unroll
            for (int j = 0; j < 8; ++j) oz[64 * j] = (u32x2){0u, 0u}; }
    }
}
__device__ __forceinline__ void p1_colsums(Frame& F) {
    const float* pcs = WSP(float, WS_PCS); const float* pbw = WSP(float, WS_PBW); float* csv = WSP(float, WS_CSV); float* bwv = WSP(float, WS_BWV);
    for (int i = blockIdx.x * 512 + F.tid; i < NCS; i += F.G * 512) {
        float cs = 0.f, bw = 0.f;
        if (!(i >= NPROJ && i < PW)) {
#pragma unroll 8
            for (int kb = 0; kb < 32; ++kb) { cs += pcs[(size_t)kb * NCS + i]; bw += pbw[(size_t)kb * NCS + i]; } }
        csv[i] = cs; bwv[i] = bw;
    }
}
__device__ __forceinline__ void p2_meta_down(Frame& F) {
    const bf16_t* G = WSP(bf16_t, WS_G); const bf16_t* wd = WSP(bf16_t, WS_WD1); float* z1m = WSP(float, WS_Z1M); bf16_t* z1b = WSP(bf16_t, WS_Z1B);
    const int lane = F.lane;
    for (int c = F.gw; c < DM; c += F.NGW) {
        const bf16_t* wrow = wd + (size_t)c * DFF;
        float acc[16];
#pragma unroll
        for (int r = 0; r < 16; ++r) acc[r] = 0.f;
        for (int i = 0; i < 11; ++i) {
            const int k = 8 * lane + 512 * i;
            const v4u wv = *(const v4u*)(wrow + k);
            const float w0 = bflo(wv.x), w1 = bfhi(wv.x), w2 = bflo(wv.y), w3 = bfhi(wv.y), w4 = bflo(wv.z), w5 = bfhi(wv.z), w6 = bflo(wv.w), w7 = bfhi(wv.w);
#pragma unroll
            for (int r = 0; r < 16; ++r) { const v4u gv = *(const v4u*)(G + (size_t)(METAROW + r) * DFF + k);
                acc[r] += (bflo(gv.x) * w0 + bfhi(gv.x) * w1) + (bflo(gv.y) * w2 + bfhi(gv.y) * w3) + (bflo(gv.z) * w4 + bfhi(gv.z) * w5) + (bflo(gv.w) * w6 + bfhi(gv.w) * w7); }
        }
        float v8[8], v4[4], v2[2], v1;
#pragma unroll
        for (int i = 0; i < 8; ++i) { const bool hi = (lane & 32) != 0; const float send = hi ? acc[i] : acc[8 + i], keep = hi ? acc[8 + i] : acc[i]; v8[i] = keep + __shfl_xor(send, 32); }
#pragma unroll
        for (int i = 0; i < 4; ++i) { const bool hi = (lane & 16) != 0; const float send = hi ? v8[i] : v8[4 + i], keep = hi ? v8[4 + i] : v8[i]; v4[i] = keep + __shfl_xor(send, 16); }
#pragma unroll
        for (int i = 0; i < 2; ++i) { const bool hi = (lane & 8) != 0; const float send = hi ? v4[i] : v4[2 + i], keep = hi ? v4[2 + i] : v4[i]; v2[i] = keep + __shfl_xor(send, 8); }
        { const bool hi = (lane & 4) != 0; const float send = hi ? v2[0] : v2[1], keep = hi ? v2[1] : v2[0]; v1 = keep + __shfl_xor(send, 4); }
        v1 += __shfl_xor(v1, 1); v1 += __shfl_xor(v1, 2);
        const int r = ((lane >> 5) & 1) * 8 + ((lane >> 4) & 1) * 4 + ((lane >> 3) & 1) * 2 + ((lane >> 2) & 1);
        if ((lane & 3) == 0) { const float z = 1.18920711500272f * F.in[1][(size_t)r * DM + c] + 0.5f * v1; z1m[(size_t)r * DM + c] = z; z1b[(size_t)(METAROW + r) * DM + c] = (bf16_t)f2bf(z); }
    }
}
__device__ __forceinline__ StatTbl fill_stats(Frame& F, const StaticOrder& S, const float* slab, const float* z1m) {
    LAS int* slot = (LAS int*)(F.lds + STT_OFF); LAS float* tbl = (LAS float*)(F.lds + STT_TBL);
    if (F.tid < 64) slot[F.tid] = -1;
    __syncthreads();
    int ns = 0; Unit u;
    for (int i = 0; S.next(i, u); ++i) {
        const int have = slot[u.pm];
        __syncthreads();
        if (have < 0) {
            if (F.tid == 0) slot[u.pm] = ns;
            if (u.pm == 32) {
                if (F.tid < 256) { tbl[(ns * 256 + F.tid) * 2] = 0.f; tbl[(ns * 256 + F.tid) * 2 + 1] = 0.f; }
                __syncthreads();
#pragma unroll
                for (int q = 0; q < 2; ++q) { const int r = 2 * F.wave + q; float s1 = 0.f, s2 = 0.f;
#pragma unroll
                    for (int j = 0; j < 8; ++j) { const f32x4 v = ((const f32x4*)(z1m + (size_t)r * DM))[F.lane + 64 * j]; s1 += (v[0] + v[1]) + (v[2] + v[3]); s2 += (v[0] * v[0] + v[1] * v[1]) + (v[2] * v[2] + v[3] * v[3]); }
                    s1 = wave_sum(s1); s2 = wave_sum(s2);
                    const float mu = s1 * (1.f / DM), var = fmaxf(s2 * (1.f / DM) - mu * mu, 0.f);
                    if (F.lane == 0) { tbl[(ns * 256 + r) * 2] = mu; tbl[(ns * 256 + r) * 2 + 1] = __builtin_amdgcn_rsqf(var + 1e-5f); } }
            } else if (F.tid < 256) { float mu, rs; row_stats(slab, u.pm * 256 + F.tid, mu, rs); tbl[(ns * 256 + F.tid) * 2] = mu; tbl[(ns * 256 + F.tid) * 2 + 1] = rs; }
            ++ns;
            __syncthreads();
        }
    }
    StatTbl t; t.slot = slot; t.tbl = tbl; return t;
}
__device__ __forceinline__ void p4_ikn(Frame& F) {
    const bf16_t* proj = WSP(bf16_t, WS_PROJ); bf16_t* ikn = WSP(bf16_t, WS_IKN);
    const float g = F.in[8][F.lane], b = F.in[9][F.lane];
    for (int row = F.gw; row < MR; row += F.NGW) {
        const float v = bf2f(proj[(size_t)row * PW + PC_IK + F.lane]);
        const float mu = wave_sum(v) * (1.f / 64.f); const float d = v - mu; const float var = wave_sum(d * d) * (1.f / 64.f);
        ikn[(size_t)row * 64 + F.lane] = (bf16_t)f2bf(d * __builtin_amdgcn_rsqf(var + 1e-5f) * g + b);
    }
}
constexpr int QP = 136, TP = 72;
__device__ __forceinline__ void h1_item(Frame& F, int bh, int c) {
    const int b = bh >> 3, h = bh & 7, tid = F.tid, lane = F.lane, w = F.wave;
    const bf16_t* proj = WSP(bf16_t, WS_PROJ);
    LAS bf16_t* Qs = (LAS bf16_t*)F.lds; LAS bf16_t* Ks = Qs + 64 * QP; LAS bf16_t* KhT = Ks + 64 * QP; LAS bf16_t* VT = KhT + 128 * TP; LAS float* tot = (LAS float*)(VT + 128 * TP);
    const int ch = tid & 127, part = tid >> 7;
    const float l0 = F.in[10][h * 128 + ch], l1 = F.in[10][1024 + h * 128 + ch];
    const float lb = 1.f / (1.f + __expf(l1 - l0));
    float fgv[16], cum[16]; float run = 0.f;
    const size_t prow0 = c == 0 ? (size_t)METAROW : (size_t)(b * SEQ + (c - 1) * 64 + 16 * part);
    const bf16_t* pf = proj + prow0 * PW + PC_HF + h * 128 + ch; const bf16_t* pq = proj + prow0 * PW + PC_HQ + h * 128 + ch; const bf16_t* pv = proj + prow0 * PW + PC_HI + h * 128 + ch;
    unsigned short fraw[16], qraw[16], vraw[16];
#pragma unroll
    for (int i = 0; i < 16; ++i) fraw[i] = pf[(size_t)i * PW];
#pragma unroll
    for (int i = 0; i < 16; ++i) { qraw[i] = pq[(size_t)i * PW]; vraw[i] = pv[(size_t)i * PW]; }
#pragma unroll
    for (int i = 0; i < 16; ++i) { const int tt = 16 * part + i; const bool valid = (c > 0) || (tt < NMETA);
        const float f = bf2f(fraw[i]);
        const float fg = valid ? lb + (1.f - lb) * sigm(f) : 1.f; run += __logf(fg); fgv[i] = fg; cum[i] = run; }
    tot[part * 128 + ch] = run;
    __syncthreads();
    float off = 0.f, blast = 0.f;
#pragma unroll
    for (int p = 0; p < 4; ++p) { const float t = tot[p * 128 + ch]; if (p < part) off += t; blast += t; }
    if (part == 0) WSP(float, WS_GCH)[(size_t)(bh * 65 + c) * 128 + ch] = __expf(blast);
    bf16_t* qtg = WSP(bf16_t, WS_QT);
#pragma unroll
    for (int i = 0; i < 16; ++i) { const int tt = 16 * part + i; const bool valid = (c > 0) || (tt < NMETA);
        const float bq = off + cum[i], fg = fgv[i];
        const float q = valid ? bf2f(qraw[i]) : 0.f, v = valid ? bf2f(vraw[i]) : 0.f;
        const float qt = silu(q) * __expf(bq), kk = 1.f - fg, kt = kk * __expf(-bq), kh = kk * __expf(blast - bq);
        const bf16_t qb = (bf16_t)f2bf(qt);
        Qs[tt * QP + ch] = qb; Ks[tt * QP + ch] = (bf16_t)f2bf(kt); KhT[ch * TP + tt] = (bf16_t)f2bf(kh); VT[ch * TP + tt] = (bf16_t)f2bf(v);
        if (c > 0) qtg[((size_t)(bh * 64 + (c - 1)) * 64 + tt) * 128 + ch] = qb; }
    __syncthreads();
    const int tb = w >> 2, dvb = w & 3, r = lane & 31, hh = lane >> 5;
    if (c > 0) {
        f32x16 o;
#pragma unroll
        for (int i = 0; i < 16; ++i) o[i] = 0.f;
        for (int sb = 0; sb <= tb; ++sb) {
            f32x16 x;
#pragma unroll
            for (int i = 0; i < 16; ++i) x[i] = 0.f;
#pragma unroll
            for (int ks = 0; ks < 8; ++ks) { const bf16x8 a = *(const LAS bf16x8*)(Ks + (32 * sb + r) * QP + 16 * ks + 8 * hh); const bf16x8 bq = *(const LAS bf16x8*)(Qs + (32 * tb + r) * QP + 16 * ks + 8 * hh); x = MFMA32(a, bq, x); }
            if (sb == tb) {
#pragma unroll
                for (int i = 0; i < 16; ++i) if (crow(i, hh) > r) x[i] = 0.f; }
#pragma unroll
            for (int s2 = 0; s2 < 2; ++s2) {
                bf16x8 xb;
#pragma unroll
                for (int j = 0; j < 8; ++j) xb[j] = (short)f2bf(x[8 * s2 + j]);
                const LAS bf16_t* vp = VT + (32 * dvb + r) * TP + 32 * sb + 16 * s2 + 4 * hh;
                const s16x4 lo = *(const LAS s16x4*)vp, hi = *(const LAS s16x4*)(vp + 8);
                const bf16x8 a2 = __builtin_shufflevector(lo, hi, 0, 1, 2, 3, 4, 5, 6, 7);
                o = MFMA32(a2, xb, o);
            }
        }
        float* oi = WSP(float, WS_OI) + ((size_t)(bh * 64 + (c - 1)) * 8 + w) * 1024 + lane;
#pragma unroll
        for (int i = 0; i < 16; ++i) oi[i * 64] = o[i];
    }
    if (c < 64) {
        bf16_t* lst = WSP(bf16_t, WS_LST) + (size_t)(bh * 65 + c) * 16384;
#pragma unroll
        for (int q2 = 0; q2 < 2; ++q2) { const int db = (w >> 2) * 2 + q2;
            f32x16 l;
#pragma unroll
            for (int i = 0; i < 16; ++i) l[i] = 0.f;
#pragma unroll
            for (int ks = 0; ks < 4; ++ks) { const bf16x8 a = *(const LAS bf16x8*)(VT + (32 * dvb + r) * TP + 16 * ks + 8 * hh); const bf16x8 bb = *(const LAS bf16x8*)(KhT + (32 * db + r) * TP + 16 * ks + 8 * hh); l = MFMA32(a, bb, l); }
#pragma unroll
            for (int i = 0; i < 16; ++i) lst[(size_t)(32 * dvb + crow(i, hh)) * 128 + 32 * db + r] = (bf16_t)f2bf(l[i]); }
    }
    __syncthreads();
}
__device__ __forceinline__ void h2_item(Frame& F, int it) {
    const int bh = it >> 4, part = it & 15, dv = 8 * part + (F.tid >> 6), d0 = 2 * (F.tid & 63);
    bf16_t* p = WSP(bf16_t, WS_LST) + ((size_t)bh * 65 * 128 + dv) * 128 + d0; const float* g = WSP(float, WS_GCH) + (size_t)bh * 65 * 128 + d0;
    float s0 = 0.f, s1 = 0.f;
#pragma unroll 8
    for (int c = 0; c < 64; ++c) { const unsigned l = *(const unsigned*)(p + (size_t)c * 16384); const f32x2 gg = *(const f32x2*)(g + c * 128);
        s0 = gg.x * s0 + bflo(l); s1 = gg.y * s1 + bfhi(l); *(unsigned*)(p + (size_t)c * 16384) = pk2(s0, s1); }
}
__device__ __forceinline__ void h3_item(Frame& F, int bh, int c) {
    const int b = bh >> 3, h = bh & 7, lane = F.lane, w = F.wave, tid = F.tid;
    const bf16_t* st = WSP(bf16_t, WS_LST) + (size_t)(bh * 65 + (c - 1)) * 16384; const bf16_t* qg = WSP(bf16_t, WS_QT) + (size_t)(bh * 64 + (c - 1)) * 8192;
    const float* oi = WSP(float, WS_OI) + ((size_t)(bh * 64 + (c - 1)) * 8 + w) * 1024 + lane;
    LAS float* Ot = (LAS float*)F.lds; LAS float* ssq = Ot + 64 * 129;
    const int tb = w >> 2, dvb = w & 3, r = lane & 31, hh = lane >> 5;
    f32x16 o;
#pragma unroll
    for (int i = 0; i < 16; ++i) o[i] = oi[i * 64];
#pragma unroll
    for (int ks = 0; ks < 8; ++ks) { const bf16x8 a = *(const bf16x8*)(st + (size_t)(32 * dvb + r) * 128 + 16 * ks + 8 * hh); const bf16x8 bq = *(const bf16x8*)(qg + (size_t)(32 * tb + r) * 128 + 16 * ks + 8 * hh); o = MFMA32(a, bq, o); }
    float ss = 0.f;
#pragma unroll
    for (int i = 0; i < 16; ++i) { ss += o[i] * o[i]; Ot[(32 * tb + r) * 129 + 32 * dvb + crow(i, hh)] = o[i]; }
    ssq[(dvb * 2 + hh) * 64 + 32 * tb + r] = ss;
    __syncthreads();
    const int t = tid >> 3, d0 = (tid & 7) * 16;
    float sq = 0.f;
#pragma unroll
    for (int k = 0; k < 8; ++k) sq += ssq[k * 64 + t];
    const float rstd = __builtin_amdgcn_rsqf(sq * (1.f / 128.f) + 1e-6f);
    const size_t row = (size_t)(b * SEQ + (c - 1) * 64 + t);
    const bf16_t* gp = WSP(bf16_t, WS_PROJ) + row * PW + PC_HG + h * 128 + d0; const float* ng = F.in[11] + h * 128 + d0;
    bf16_t* yp = WSP(bf16_t, WS_YHG) + row * 1024 + h * 128 + d0;
#pragma unroll
    for (int q = 0; q < 2; ++q) { const v4u gz = *(const v4u*)(gp + 8 * q); const f32x4 n0 = *(const f32x4*)(ng + 8 * q), n1 = *(const f32x4*)(ng + 8 * q + 4);
        const LAS float* op = Ot + t * 129 + d0 + 8 * q;
        v4u wv; wv.x = pk2(op[0] * rstd * n0[0] * silu(bflo(gz.x)), op[1] * rstd * n0[1] * silu(bfhi(gz.x))); wv.y = pk2(op[2] * rstd * n0[2] * silu(bflo(gz.y)), op[3] * rstd * n0[3] * silu(bfhi(gz.y)));
        wv.z = pk2(op[4] * rstd * n1[0] * silu(bflo(gz.z)), op[5] * rstd * n1[1] * silu(bfhi(gz.z))); wv.w = pk2(op[6] * rstd * n1[2] * silu(bflo(gz.w)), op[7] * rstd * n1[3] * silu(bfhi(gz.w)));
        *(v4u*)(yp + 8 * q) = wv; }
    __syncthreads();
}
__device__ __forceinline__ int wave_total(int v) {
    v += __builtin_amdgcn_update_dpp(0, v, 0xB1, 0xF, 0xF, true);
    v += __builtin_amdgcn_update_dpp(0, v, 0x4E, 0xF, 0xF, true);
    v += __builtin_amdgcn_update_dpp(0, v, 0x141, 0xF, 0xF, true);
    v += __builtin_amdgcn_update_dpp(0, v, 0x140, 0xF, 0xF, true);
    v += __builtin_amdgcn_update_dpp(0, v, 0x142, 0xA, 0xF, true);
    v += __builtin_amdgcn_update_dpp(0, v, 0x143, 0xC, 0xF, true);
    return __builtin_amdgcn_readlane(v, 63);
}
__device__ __forceinline__ void cnt4_ge(int& cnt, unsigned mid, unsigned a, unsigned b, unsigned c, unsigned d) {
    unsigned long long m0, m1, m2, m3; int t0, t1, t2, t3;
    asm volatile("v_cmp_le_u32_e64 %1, %9, %10\n\tv_cmp_le_u32_e64 %2, %9, %11\n\tv_cmp_le_u32_e64 %3, %9, %12\n\tv_cmp_le_u32_e64 %4, %9, %13\n\t"
                 "s_bcnt1_i32_b64 %5, %1\n\ts_bcnt1_i32_b64 %6, %2\n\ts_bcnt1_i32_b64 %7, %3\n\ts_bcnt1_i32_b64 %8, %4\n\t"
                 "s_add_i32 %0, %0, %5\n\ts_add_i32 %0, %0, %6\n\ts_add_i32 %0, %0, %7\n\ts_add_i32 %0, %0, %8"
                 : "+s"(cnt), "=&s"(m0), "=&s"(m1), "=&s"(m2), "=&s"(m3), "=&s"(t0), "=&s"(t1), "=&s"(t2), "=&s"(t3)
                 : "s"(mid), "v"(a), "v"(b), "v"(c), "v"(d) : "scc");
}
__device__ __forceinline__ void cnt4_gt(int& cnt, unsigned mid, unsigned a, unsigned b, unsigned c, unsigned d) {
    unsigned long long m0, m1, m2, m3; int t0, t1, t2, t3;
    asm volatile("v_cmp_lt_u32_e64 %1, %9, %10\n\tv_cmp_lt_u32_e64 %2, %9, %11\n\tv_cmp_lt_u32_e64 %3, %9, %12\n\tv_cmp_lt_u32_e64 %4, %9, %13\n\t"
                 "s_bcnt1_i32_b64 %5, %1\n\ts_bcnt1_i32_b64 %6, %2\n\ts_bcnt1_i32_b64 %7, %3\n\ts_bcnt1_i32_b64 %8, %4\n\t"
                 "s_add_i32 %0, %0, %5\n\ts_add_i32 %0, %0, %6\n\ts_add_i32 %0, %0, %7\n\ts_add_i32 %0, %0, %8"
                 : "+s"(cnt), "=&s"(m0), "=&s"(m1), "=&s"(m2), "=&s"(m3), "=&s"(t0), "=&s"(t1), "=&s"(t2), "=&s"(t3)
                 : "s"(mid), "v"(a), "v"(b), "v"(c), "v"(d) : "scc");
}
__device__ __forceinline__ void idx_item(Frame& F, int b, int qblk) {
    const int lane = F.lane, w = F.wave;
#ifdef TS_A0
    unsigned long long* tsx = (unsigned long long*)(F.ws + WS_CTL + 65536); const bool tsl = blockIdx.x == 0 && F.tid == 0;
    const unsigned long long t0_ = __builtin_amdgcn_s_memrealtime();
#endif
    const bf16_t* proj = WSP(bf16_t, WS_PROJ); const bf16_t* ikn = WSP(bf16_t, WS_IKN);
    LAS unsigned* sc = (LAS unsigned*)F.lds;
    const int r0 = 8 * qblk, ntile = (r0 + 8 + 31) >> 5;
    const int r = lane & 31, hh = lane >> 5;
    {
        LAS float* wl = (LAS float*)(F.lds + WL_OFF);
        LAS bf16_t* iql = (LAS bf16_t*)(wl + 128);
        if (F.tid < 128) wl[F.tid] = bf2f(proj[(size_t)(b * SEQ + r0 + (F.tid >> 4)) * PW + PC_IW + (F.tid & 15)]) * (1.f / 32.f);
        {
            const int q = F.tid >> 6, d = F.tid & 63; const bf16_t* pw = proj + (size_t)(b * SEQ + r0 + q) * PW;
            unsigned short wr_[16], qr_[16];
#pragma unroll
            for (int hd = 0; hd < 16; ++hd) { wr_[hd] = pw[PC_IW + hd]; qr_[hd] = pw[PC_IQ + hd * 64 + d]; }
            float acc_ = 0.f;
#pragma unroll
            for (int hd = 0; hd < 16; ++hd) acc_ += bf2f(wr_[hd]) * bf2f(qr_[hd]);
            iql[q * 64 + d] = (bf16_t)f2bf(acc_ * (1.f / 32.f));
        }
        bf16x8 a[4][4];
#pragma unroll
        for (int p = 0; p < 4; ++p) {
            const size_t rowq = (size_t)(b * SEQ + r0 + 2 * p + (r >> 4));
#pragma unroll
            for (int ks = 0; ks < 4; ++ks) a[p][ks] = *(const bf16x8*)(proj + rowq * PW + PC_IQ + (r & 15) * 64 + 16 * ks + 8 * hh);
        }
        __syncthreads();
        bf16x8 al[4];
#pragma unroll
        for (int ks = 0; ks < 4; ++ks) { bf16x8 z = {0, 0, 0, 0, 0, 0, 0, 0}; if (r < 8) z = *(const LAS bf16x8*)(iql + (2 * (r & 3) + (r >> 2)) * 64 + 16 * ks + 8 * hh); al[ks] = z; }
        bf16x8 bc[4], bn[4];
#define IDX_LOAD(dst, kt) do { int kt_ = (kt); if (kt_ >= ntile) kt_ = w < ntile ? w : 0; const bf16_t* kp_ = ikn + (size_t)(b * SEQ + 32 * kt_ + r) * 64 + 8 * hh; \
    _Pragma("unroll") for (int ks = 0; ks < 4; ++ks) dst[ks] = *(const bf16x8*)(kp_ + 16 * ks); } while (0)
        IDX_LOAD(bc, w);
        for (int kt = w; kt < ntile; kt += 8) {
            IDX_LOAD(bn, kt + 8);
            const int key = 32 * kt + r;
            f32x16 xl;
#pragma unroll
            for (int i = 0; i < 16; ++i) xl[i] = 0.f;
#pragma unroll
            for (int ks = 0; ks < 4; ++ks) xl = MFMA32(al[ks], bc[ks], xl);
#pragma unroll
            for (int p = 0; p < 4; ++p) {
                f32x16 x;
#pragma unroll
                for (int i = 0; i < 16; ++i) x[i] = 0.f;
#pragma unroll
                for (int ks = 0; ks < 4; ++ks) x = MFMA32(a[p][ks], bc[ks], x);
                const LAS f32x4* wq = (const LAS f32x4*)(wl + (2 * p) * 16 + 4 * hh);
                const f32x4 w0 = wq[0], w1 = wq[2], w2 = wq[4], w3 = wq[6];
                float p0 = 0.f, p1 = 0.f;
#pragma unroll
                for (int i = 0; i < 4; ++i) { p0 += w0[i] * fabsf(x[i]); p0 += w1[i] * fabsf(x[4 + i]); p1 += w2[i] * fabsf(x[8 + i]); p1 += w3[i] * fabsf(x[12 + i]); }
                const auto sw = __builtin_amdgcn_permlane32_swap(__float_as_uint(p0), __float_as_uint(p1), false, false);
                const float tot = 0.5f * ((__uint_as_float(sw[0]) + __uint_as_float(sw[1])) + xl[p]);
                unsigned u = __float_as_uint(tot); u = (u & 0x80000000u) ? ~u : (u | 0x80000000u); if (key > r0 + 2 * p + hh) u = 0u;
                sc[(2 * p + hh) * 4096 + key] = u;
            }
#pragma unroll
            for (int ks = 0; ks < 4; ++ks) bc[ks] = bn[ks];
        }
#undef IDX_LOAD
    }
    __syncthreads();
#ifdef TS_A0
    const unsigned long long t1_ = __builtin_amdgcn_s_memrealtime(); if (tsl) tsx[21] += t1_ - t0_;
#endif
    {
        const int rq = r0 + w, nvalid = rq + 1, nk = ntile * 32;
        unsigned k[64];
#pragma unroll
        for (int i = 0; i < 64; ++i) { const int idx = lane + 64 * i; k[i] = idx < nk ? sc[w * 4096 + idx] : 0u; }
        unsigned thr = 0u; bool exact = false;
        if (nvalid > 256) {
            unsigned lo = 1u, hi = 0xFFFFFFFFu;
            while (hi - lo > 1u) { const unsigned mid = lo + ((hi - lo) >> 1); int cnt = 0;
#pragma unroll
                for (int i = 0; i < 64; i += 4) cnt4_ge(cnt, mid, k[i], k[i + 1], k[i + 2], k[i + 3]);
                if (cnt == 256) { lo = mid; exact = true; break; }
                if (cnt > 256) lo = mid; else hi = mid; }
            thr = lo;
        }
        int quota = 0;
        if (thr != 0u && !exact) { int ngt = 0;
#pragma unroll
            for (int i = 0; i < 64; i += 4) cnt4_gt(ngt, thr, k[i], k[i + 1], k[i + 2], k[i + 3]);
            quota = 256 - ngt; }
        int run = 0, eqrun = 0; unsigned short* out = WSP(unsigned short, WS_SEL) + (size_t)(b * SEQ + rq) * 256;
#pragma unroll
        for (int i = 0; i < 64; ++i) { const bool gt = exact ? (k[i] >= thr) : (k[i] > thr), eq = (k[i] == thr) && (thr != 0u) && !exact;
            const unsigned long long meq = __ballot(eq); const int eqb = eqrun + (int)__builtin_amdgcn_mbcnt_hi((unsigned)(meq >> 32), __builtin_amdgcn_mbcnt_lo((unsigned)meq, 0u));
            const bool take = gt || (eq && eqb < quota);
            const unsigned long long m = __ballot(take); const int pos = run + (int)__builtin_amdgcn_mbcnt_hi((unsigned)(m >> 32), __builtin_amdgcn_mbcnt_lo((unsigned)m, 0u));
            if (take && pos < 256) out[pos] = (unsigned short)(lane + 64 * i);
            run += __popcll(m); eqrun += __popcll(meq); }
    }
    __syncthreads();
#ifdef TS_A0
    if (tsl) tsx[23] += __builtin_amdgcn_s_memrealtime() - t1_;
#endif
}
__device__ __forceinline__ void att_item(Frame& F, int it) {
    const int lane = F.lane, w = F.wave;
    const bf16_t* proj = WSP(bf16_t, WS_PROJ); const unsigned short* sel = WSP(unsigned short, WS_SEL);
    const int b = it >> 10, blk = it & 1023, q = w >> 1, kv = w & 1, rq = 4 * blk + q, tpos = rq + NMETA; const size_t rowq = (size_t)(b * SEQ + rq);
    const int nsel = rq + 1 < 256 ? rq + 1 : 256, ntot = NMETA + nsel;
    LAS int* rowl = (LAS int*)(F.lds + w * 8192); LAS float* dl = (LAS float*)(rowl + 288); LAS float* Pl = dl + 288;
#ifdef TS_A0
    unsigned long long* tsx = (unsigned long long*)(F.ws + WS_CTL + 65536); const bool tsl = blockIdx.x == 0 && F.tid == 0;
    unsigned long long tq0 = __builtin_amdgcn_s_memrealtime(), tq1;
#define ATT_MARK(i) do { asm volatile("s_waitcnt vmcnt(0) lgkmcnt(0)" ::: "memory"); tq1 = __builtin_amdgcn_s_memrealtime(); if (tsl) tsx[i] += tq1 - tq0; tq0 = tq1; } while (0)
#else
#define ATT_MARK(i) do { } while (0)
#endif
    unsigned short sraw[5];
#pragma unroll
    for (int i = 0; i < 5; ++i) { const int j = lane + 64 * i - NMETA; sraw[i] = (j >= 0 && j < nsel) ? sel[rowq * 256 + j] : (unsigned short)0; }
#pragma unroll
    for (int i = 0; i < 5; ++i) { const int n = lane + 64 * i;
        if (n < 272) { int row; float d;
            if (n < NMETA) { row = METAROW + n; d = (float)(tpos - n); }
            else { const int j = n - NMETA; const bool ok = j < nsel; const int s = (int)sraw[i]; row = b * SEQ + s; d = ok ? (float)(rq - s) : INFINITY; }
            rowl[n] = row; dl[n] = d; } }
    __syncthreads();
    ATT_MARK(25);
    const int hh = lane & 15, g = lane >> 4;
    bf16x8 qf[4];
#pragma unroll
    for (int ks = 0; ks < 4; ++ks) { bf16x8 z = {0, 0, 0, 0, 0, 0, 0, 0}; if (hh < 4) z = *(const bf16x8*)(proj + rowq * PW + PC_AQ + (kv * 4 + hh) * 128 + 32 * ks + 8 * g); qf[ks] = z; }
    f32x4 acc[17];
#pragma unroll
    for (int T = 0; T < 17; ++T) { const int row = rowl[16 * T + hh]; const bf16_t* kp = proj + (size_t)row * PW + PC_AK + kv * 128 + 8 * g;
        f32x4 x = (f32x4){0.f, 0.f, 0.f, 0.f};
#pragma unroll
        for (int ks = 0; ks < 4; ++ks) { const bf16x8 a = *(const bf16x8*)(kp + 32 * ks); x = MFMA16(a, qf[ks], x); }
        acc[T] = x; }
    asm volatile("" : "+v"(acc[0]), "+v"(acc[16]));
    ATT_MARK(27);
    const float slope = exp2f(-(float)(kv * 4 + (hh & 3) + 1));
    float mx = -INFINITY;
#pragma unroll
    for (int T = 0; T < 17; ++T) { const f32x4 d4 = *(const LAS f32x4*)(dl + 16 * T + 4 * g);
#pragma unroll
        for (int j = 0; j < 4; ++j) { const float l = acc[T][j] * 0.08838834764831845f - slope * d4[j]; acc[T][j] = l; mx = fmaxf(mx, l); } }
    mx = fmaxf(mx, __shfl_xor(mx, 16)); mx = fmaxf(mx, __shfl_xor(mx, 32));
    float sum = 0.f;
#pragma unroll
    for (int T = 0; T < 17; ++T)
#pragma unroll
        for (int j = 0; j < 4; ++j) { const float e = __expf(acc[T][j] - mx); acc[T][j] = e; sum += e; }
    sum += __shfl_xor(sum, 16); sum += __shfl_xor(sum, 32);
    const float inv = 1.f / sum;
    if (hh < 4) {
#pragma unroll
        for (int T = 0; T < 17; ++T)
#pragma unroll
            for (int j = 0; j < 4; ++j) Pl[(16 * T + 4 * g + j) * 4 + hh] = acc[T][j] * inv; }
    __syncthreads();
    ATT_MARK(29);
    float o[4][8];
#pragma unroll
    for (int h = 0; h < 4; ++h)
#pragma unroll
        for (int e = 0; e < 8; ++e) o[h][e] = 0.f;
    const bf16_t* vbase = proj + PC_AV + kv * 128 + 8 * hh;
    for (int io = 0; io < 68; io += 17) {
        if (4 * io >= ntot) break;
        int rw[17]; v4u vv[17];
#pragma unroll
        for (int ii = 0; ii < 17; ++ii) rw[ii] = rowl[4 * (io + ii) + g];
#pragma unroll
        for (int ii = 0; ii < 17; ++ii) vv[ii] = *(const v4u*)(vbase + (size_t)rw[ii] * PW);
#pragma unroll
        for (int ii = 0; ii < 17; ++ii) { const f32x4 p4 = *(const LAS f32x4*)(Pl + 4 * (4 * (io + ii) + g));
            const float v0 = bflo(vv[ii].x), v1 = bfhi(vv[ii].x), v2 = bflo(vv[ii].y), v3 = bfhi(vv[ii].y), v4 = bflo(vv[ii].z), v5 = bfhi(vv[ii].z), v6 = bflo(vv[ii].w), v7 = bfhi(vv[ii].w);
#pragma unroll
            for (int h = 0; h < 4; ++h) { o[h][0] += p4[h] * v0; o[h][1] += p4[h] * v1; o[h][2] += p4[h] * v2; o[h][3] += p4[h] * v3; o[h][4] += p4[h] * v4; o[h][5] += p4[h] * v5; o[h][6] += p4[h] * v6; o[h][7] += p4[h] * v7; } }
    }
    float ov[8];
#pragma unroll
    for (int e = 0; e < 8; ++e) {
#pragma unroll
        for (int h = 0; h < 4; ++h) { o[h][e] += __shfl_xor(o[h][e], 16); o[h][e] += __shfl_xor(o[h][e], 32); }
        ov[e] = g == 0 ? o[0][e] : (g == 1 ? o[1][e] : (g == 2 ? o[2][e] : o[3][e])); }
    v4u wv; wv.x = pk2(ov[0], ov[1]); wv.y = pk2(ov[2], ov[3]); wv.z = pk2(ov[4], ov[5]); wv.w = pk2(ov[6], ov[7]);
    *(v4u*)(WSP(bf16_t, WS_YATT) + rowq * 1024 + (kv * 4 + g) * 128 + 8 * hh) = wv;
    ATT_MARK(31);
    __syncthreads();
}
__device__ __forceinline__ void p11_final_ln(Frame& F) {
    const float* st = WSP(float, WS_ST3); const float* g = F.in[20]; const float* b = F.in[21];
    for (int row = F.gw; row < MR; row += F.NGW) { float mu, rs; row_stats(st, row, mu, rs);
        f32x4* o = (f32x4*)(F.out + (size_t)row * DM);
#pragma unroll
        for (int j = 0; j < 8; ++j) { const int i = F.lane + 64 * j; const f32x4 z = o[i]; o[i] = (z - mu) * rs * ((const f32x4*)g)[i] + ((const f32x4*)b)[i]; } }
}
struct Args { const float* in[22]; float* out; unsigned char* ws; int ph_lo, ph_hi, li, pad; };
constexpr int NPH = 12;
__global__ void __launch_bounds__(512, 2) mk_fwd(Args args) {
    extern __shared__ __attribute__((aligned(16))) unsigned char lds_raw[];
    Frame F;
    F.lds = (LAS unsigned char*)lds_raw;
    F.tid = threadIdx.x; F.lane = F.tid & 63; F.wave = __builtin_amdgcn_readfirstlane(F.tid >> 6);
    F.G = gridDim.x; F.gw = blockIdx.x * 8 + F.wave; F.NGW = F.G * 8;
#pragma unroll
    for (int i = 0; i < 22; ++i) F.in[i] = args.in[i];
    F.out = args.out; F.ws = args.ws;
    volatile LAS unsigned* MISC = (volatile LAS unsigned*)(F.lds + MISC_OFF);
    if (F.tid < 64) MISC[F.tid] = 0u;
    __syncthreads();
    XcdBarrier bar = xcd_barrier_post((unsigned*)(F.ws + WS_CTL) + CW_BAR + args.li * XCD_BAR_WORDS, MISC + 8);
    const int lo = args.ph_lo, hi = args.ph_hi;
#define IN(k) (lo <= (k) && (k) < hi)
#ifdef TS_A0
    unsigned long long* ts = (unsigned long long*)(F.ws + WS_CTL + 65536);
#define MARK(i) do { if (blockIdx.x == 0 && F.tid == 0) ts[i] = __builtin_amdgcn_s_memrealtime(); } while (0)
#else
#define MARK(i) do { } while (0)
#endif
    MARK(0);
#define SEAM(k) do { if (IN(k) && IN((k) + 1)) xcd_barrier(bar); MARK((k) + 1); } while (0)
    const int bid = blockIdx.x;
#ifndef REP_MASK
#define REP_MASK 0
#endif
#define PBEG(k) if (IN(k)) { const int nrep_ = ((REP_MASK >> (k)) & 1) ? 2 : 1; for (int rep = 0; rep < nrep_; ++rep) { if (rep) xcd_barrier(bar);
#define PEND(k) } } SEAM(k);

    PBEG(0) p0_prologue(F); PEND(0)
    PBEG(1)
        p1_colsums(F); MARK(16);
        Gemm g{WSP(bf16_t, WS_H0B), WSP(bf16_t, WS_WGU1), MPAD, NGU, DM}; StaticOrder S; S.init(MPAD, NGU, F.G, bid);
        EpiSwiGLU<false> E{WSP(bf16_t, WS_G), DFF, StatTbl{nullptr, nullptr}, nullptr, nullptr};
        gemm_phase<EpiSwiGLU<false>, StaticOrder, true, true>(F.lds, g, S, E);
    PEND(1)
    PBEG(2)
        p2_meta_down(F); MARK(17);
        Gemm g{WSP(bf16_t, WS_G), WSP(bf16_t, WS_WD1), MR, DM, DFF}; StaticOrder S; S.init(MR, DM, F.G, bid);
        EpiResid<0> E{F.in[0], nullptr, StatTbl{nullptr, nullptr}, nullptr, nullptr, WSP(bf16_t, WS_Z1B), nullptr, WSP(float, WS_ST1), 0.5f};
        gemm_phase<EpiResid<0>, StaticOrder, false, true>(F.lds, g, S, E);
    PEND(2)
    PBEG(3)
        Gemm g{WSP(bf16_t, WS_Z1B), WSP(bf16_t, WS_WIN), MPAD, PW, DM}; StaticOrder S; S.init(MPAD, PW, F.G, bid);
        const StatTbl st = fill_stats(F, S, WSP(float, WS_ST1), WSP(float, WS_Z1M)); MARK(18);
        EpiProj E{WSP(bf16_t, WS_PROJ), PW, st, WSP(float, WS_CSV), WSP(float, WS_BWV)};
        gemm_phase<EpiProj, StaticOrder, true, true>(F.lds, g, S, E);
    PEND(3)
    PBEG(4)
        p4_ikn(F); MARK(13);
        for (int it = bid; it < 16 * 65; it += F.G) h1_item(F, it / 65, it % 65);
    PEND(4)
    PBEG(5)
        if (rep == 0) for (int it = bid; it < 256; it += F.G) h2_item(F, it);
        MARK(14);
        for (int it = bid; it < 1024; it += F.G) { const int j = it >> 8, x = it & 255; idx_item(F, j >> 1, (j & 1) ? 511 - x : x); }
    PEND(5)
    PBEG(6)
#ifndef REP_H3
#define REP_H3 1
#endif
#ifndef REP_ATT
#define REP_ATT 1
#endif
        for (int r2 = 0; r2 < REP_H3; ++r2) for (int it = bid; it < 16 * 64; it += F.G) h3_item(F, it >> 6, (it & 63) + 1);
        MARK(15);
        for (int r2 = 0; r2 < REP_ATT; ++r2) for (int it = bid; it < 2048; it += F.G) att_item(F, it);
    PEND(6)
    PBEG(7)
        { Gemm g{WSP(bf16_t, WS_YATT), WSP(bf16_t, WS_WBA), MR, DM, 1024}; StaticOrder S; S.init(MR, DM, F.G, bid);
          EpiBranch<0> E{WSP(bf16_t, WS_PROJ), PW, PC_GA, WSP(bf16_t, WS_T1), nullptr};
          gemm_phase<EpiBranch<0>, StaticOrder, false, true>(F.lds, g, S, E); }
        __syncthreads(); MARK(19);
        { Gemm g{WSP(bf16_t, WS_YHG), WSP(bf16_t, WS_WBH), MR, DM, 1024}; StaticOrder S; S.init(MR, DM, F.G, bid);
          EpiBranch<1> E{WSP(bf16_t, WS_PROJ), PW, PC_GH, WSP(bf16_t, WS_T1), WSP(bf16_t, WS_MRG)};
          gemm_phase<EpiBranch<1>, StaticOrder, false, true>(F.lds, g, S, E); }
    PEND(7)
    PBEG(8)
        Gemm g{WSP(bf16_t, WS_MRG), WSP(bf16_t, WS_WOUT), MR, DM, DM}; StaticOrder S; S.init(MR, DM, F.G, bid);
        const StatTbl st = fill_stats(F, S, WSP(float, WS_ST1), nullptr);
        EpiResid<1> E{nullptr, WSP(bf16_t, WS_Z1B), st, F.in[5], F.in[6], WSP(bf16_t, WS_Z2B), nullptr, WSP(float, WS_ST2), 1.0f};
        gemm_phase<EpiResid<1>, StaticOrder, false, true>(F.lds, g, S, E);
    PEND(8)
    PBEG(9)
        Gemm g{WSP(bf16_t, WS_Z2B), WSP(bf16_t, WS_WGU2), MR, NGU, DM}; StaticOrder S; S.init(MR, NGU, F.G, bid);
        const StatTbl st = fill_stats(F, S, WSP(float, WS_ST2), nullptr);
        EpiSwiGLU<true> E{WSP(bf16_t, WS_G2), DFF, st, WSP(float, WS_CSV) + PW, WSP(float, WS_BWV) + PW};
        gemm_phase<EpiSwiGLU<true>, StaticOrder, true, true>(F.lds, g, S, E);
    PEND(9)
    PBEG(10)
        Gemm g{WSP(bf16_t, WS_G2), WSP(bf16_t, WS_WD2), MR, DM, DFF}; StaticOrder S; S.init(MR, DM, F.G, bid);
        const StatTbl st = fill_stats(F, S, WSP(float, WS_ST2), nullptr);
        EpiResid<2> E{nullptr, WSP(bf16_t, WS_Z2B), st, F.in[15], F.in[16], nullptr, F.out, WSP(float, WS_ST3), 0.5f};
        gemm_phase<EpiResid<2>, StaticOrder, false, true>(F.lds, g, S, E);
    PEND(10)
    if (IN(11)) { p11_final_ln(F); }
#ifdef TS_A0
    if (blockIdx.x == 0 && F.tid == 0) {
        const unsigned long long now = __builtin_amdgcn_s_memrealtime(); ts[12] = now;
        unsigned long long qa = (ts[TS_A1] - ts[TS_A0]) / TS_UNIT, qb = (ts[TS_B1] - ts[TS_B0]) / TS_UNIT; if (qa > 99) qa = 99; if (qb > 99) qb = 99;
        const unsigned long long target = now + 2000ull * (100ull * qa + qb);
        while (__builtin_amdgcn_s_memrealtime() < target) __builtin_amdgcn_s_sleep(32);
    }
#endif
#undef IN
#undef SEAM
}

#ifndef MK_CUTS
#define MK_CUTS {0, NPH}
#endif
extern "C" void kernel_launch(void* const* d_in, const int* in_sizes, int n_in, void* d_out, int out_size, void* d_ws, size_t ws_size, hipStream_t stream) {
    static int grid = 0;
    if (grid == 0) {
        if (n_in != 22 || out_size != MR * DM || ws_size < WS_END) { fprintf(stderr, "kernel_launch: unexpected shapes (n_in %d, out %d, ws %zu < %zu)\n", n_in, out_size, ws_size, (size_t)WS_END); grid = -1; return; }
        int dev = 0, cus = 0, per_cu = 0;
        if (hipGetDevice(&dev) != hipSuccess || hipDeviceGetAttribute(&cus, hipDeviceAttributeMultiprocessorCount, dev) != hipSuccess) { grid = -1; return; }
        if (hipFuncSetAttribute((const void*)mk_fwd, hipFuncAttributeMaxDynamicSharedMemorySize, LDS_BYTES) != hipSuccess) { fprintf(stderr, "kernel_launch: hipFuncSetAttribute failed\n"); grid = -1; return; }
        if (hipOccupancyMaxActiveBlocksPerMultiprocessor(&per_cu, (const void*)mk_fwd, 512, LDS_BYTES) != hipSuccess || per_cu < 1) { fprintf(stderr, "kernel_launch: occupancy query says %d blocks per CU\n", per_cu); grid = -1; (void)hipGetLastError(); return; }
        grid = cus;
        if (grid != 256) fprintf(stderr, "kernel_launch: %d CUs; the one-unit-per-workgroup GEMM phases assume 256\n", grid);
    }
    if (grid < 0) return;
    (void)hipMemsetAsync((char*)d_ws + WS_CTL, 0, CTL_BYTES, stream);
    Args a{};
    for (int i = 0; i < 22; ++i) a.in[i] = (const float*)d_in[i];
    a.out = (float*)d_out; a.ws = (unsigned char*)d_ws;
    const int cuts[] = MK_CUTS; const int nl = (int)(sizeof(cuts) / sizeof(int)) - 1;
    for (int li = 0; li < nl; ++li) {
        a.ph_lo = cuts[li]; a.ph_hi = cuts[li + 1]; a.li = li; a.pad = 0;
        void* kargs[] = {&a};
        const hipError_t e = hipLaunchCooperativeKernel((const void*)mk_fwd, dim3(grid), dim3(512), kargs, LDS_BYTES, stream);
        if (e != hipSuccess) { fprintf(stderr, "kernel_launch: cooperative launch %d failed: %s\n", li, hipGetErrorString(e)); break; }
    }
}
```

```cpp
#include <hip/hip_runtime.h>
#include <cstdio>
#include <cstdint>
namespace pg8 {
#define PG8_LAS __attribute__((address_space(3)))
typedef unsigned short bf16_t;
typedef short bf16x8 __attribute__((ext_vector_type(8)));
typedef float f32x4 __attribute__((ext_vector_type(4)));
typedef unsigned u32x4 __attribute__((ext_vector_type(4)));
constexpr int BM = 256, BK = 64, HALF = 128, HTB = HALF * BK * 2  , STAGE_BYTES = 8 * HTB, NXCD = 8, WGM = 8;

__host__ __device__ __forceinline__ int lds_byte(int r, int c) { const int st = (r >> 4) * 2 + (c >> 5), rr = r & 15, cc = c & 31, ob = rr * 64 + cc * 2; return st * 1024 + (ob ^ (((ob >> 9) & 1) << 5)); }
__host__ __device__ __forceinline__ void stage_rc(int b, int& R, int& C) { const int st = b / 1024, sb = b % 1024, swz = sb ^ (((sb >> 9) & 1) << 5); R = (st >> 1) * 16 + swz / 64; C = (st & 1) * 32 + (swz % 64) / 2; }
__host__ __device__ __forceinline__ int perm32(int rho) { const int n = rho >> 4, i = rho & 15; return 8 * (i >> 2) + 4 * n + (i & 3); }

struct Unit { int pm, pn; };
struct Gemm { const bf16_t* A; const bf16_t* Bt; int M, N, K; };

struct StaticOrder {
    int nM, nN, nwg, G, c;
    __host__ __device__ void init(int M, int N, int G_, int c_) { nM = M / BM; nN = N / BM; nwg = nM * nN; G = G_; c = c_; }
    __host__ __device__ bool next(int i, Unit& u) const {
        const long L = (long)i * G + c; if (L >= nwg) return false;
        int wgid = (int)L; { const int q = nwg / NXCD, r = nwg % NXCD, xcd = wgid % NXCD, off = wgid / NXCD; wgid = (xcd < r ? xcd * (q + 1) : r * (q + 1) + (xcd - r) * q) + off; }
        const int nig = WGM * nN, gid = wgid / nig, fm = gid * WGM, gsz = (nM - fm) < WGM ? (nM - fm) : WGM;
        u.pm = fm + ((wgid % nig) % gsz); u.pn = (wgid % nig) / gsz; return true;
    }
    __device__ __forceinline__ void a_ready(const Unit&) const {}
    __device__ __forceinline__ void done(const Unit&) const {}
};

__device__ __forceinline__ unsigned cvt_pk_bf16(float lo, float hi) { unsigned r; asm volatile("v_cvt_pk_bf16_f32 %0, %1, %2" : "=v"(r) : "v"(lo), "v"(hi)); return r; }
typedef float f32x2 __attribute__((ext_vector_type(2)));
typedef unsigned u32x2 __attribute__((ext_vector_type(2)));
__device__ __forceinline__ float bflo(unsigned w) { return __uint_as_float(w << 16); }
__device__ __forceinline__ float bfhi(unsigned w) { return __uint_as_float(w & 0xffff0000u); }
__device__ __forceinline__ float sigm(float x) { return __builtin_amdgcn_rcpf(1.f + __expf(-x)); }
__device__ __forceinline__ float silu(float x) { return x * sigm(x); }
__device__ __forceinline__ void row_stats(const float* slab, int row, float& mu, float& rstd) {
    const f32x4* p = (const f32x4*)(slab + (size_t)row * 16);
    const f32x4 a = p[0], b = p[1], c = p[2], d = p[3];
    const float s = ((a[0] + a[2]) + (b[0] + b[2])) + ((c[0] + c[2]) + (d[0] + d[2]));
    const float q = ((a[1] + a[3]) + (b[1] + b[3])) + ((c[1] + c[3]) + (d[1] + d[3]));
    mu = s * (1.0f / 2048.0f);
    const float var = fmaxf(q * (1.0f / 2048.0f) - mu * mu, 0.f);
    rstd = __builtin_amdgcn_rsqf(var + 1e-5f);
}
struct StatTbl { const PG8_LAS int* slot; const PG8_LAS float* tbl;
    __device__ __forceinline__ void get(int pm, int lr, float& mu, float& rs) const { const int sl = slot[pm]; const PG8_LAS float* p = tbl + (sl * 256 + lr) * 2; mu = p[0]; rs = p[1]; } };
template <bool LNF> struct EpiSwiGLU {
    static constexpr bool PERM = true, AFTER_DRAIN = false;
    bf16_t* O; int ldc; StatTbl st; const float* cs; const float* bw;
    __device__ __forceinline__ void operator()(const f32x4 (&acc)[2][2][4][2], const Unit& u, int wr, int wc, int fr, int fq) const {
        const int row0 = u.pm * BM + wr * 64 + fr;
        const int ocol = u.pn * 128 + wc * 32 + 8 * fq;
        const int brow = u.pn * BM + wc * 32 + 8 * fq;
        f32x4 csg[2], csu[2], bwg[2], bwu[2];
        float mu[8], rs[8];
#pragma unroll
        for (int n = 0; n < 2; ++n) {
            if (LNF) { csg[n] = *(const f32x4*)(cs + brow + 4 * n); csu[n] = *(const f32x4*)(cs + brow + 128 + 4 * n); bwg[n] = *(const f32x4*)(bw + brow + 4 * n); bwu[n] = *(const f32x4*)(bw + brow + 128 + 4 * n); }
            else { csg[n] = csu[n] = bwg[n] = bwu[n] = (f32x4){0.f, 0.f, 0.f, 0.f}; }
        }
#pragma unroll
        for (int g = 0; g < 8; ++g) { mu[g] = 0.f; rs[g] = 1.f; if (LNF) st.get(u.pm, (g >> 2) * HALF + wr * 64 + (g & 3) * 16 + fr, mu[g], rs[g]); }
#pragma unroll
        for (int ai = 0; ai < 2; ++ai)
#pragma unroll
            for (int m = 0; m < 4; ++m) {
                const int row = row0 + ai * HALF + m * 16; const float mu_ = mu[ai * 4 + m], rs_ = rs[ai * 4 + m];
                u32x4 w;
#pragma unroll
                for (int n = 0; n < 2; ++n) {
                    f32x4 g = acc[ai][0][m][n], up = acc[ai][1][m][n];
                    if (LNF) { g = (g - mu_ * csg[n]) * rs_ + bwg[n]; up = (up - mu_ * csu[n]) * rs_ + bwu[n]; }
                    const float o0 = silu(g[0]) * up[0], o1 = silu(g[1]) * up[1], o2 = silu(g[2]) * up[2], o3 = silu(g[3]) * up[3];
                    w[2 * n] = cvt_pk_bf16(o0, o1); w[2 * n + 1] = cvt_pk_bf16(o2, o3);
                }
                *(u32x4*)(O + (size_t)row * ldc + ocol) = w;
            }
    }
};
struct EpiProj {
    static constexpr bool PERM = true, AFTER_DRAIN = false;
    bf16_t* O; int ldc; StatTbl st; const float* cs; const float* bw;
    __device__ __forceinline__ void operator()(const f32x4 (&acc)[2][2][4][2], const Unit& u, int wr, int wc, int fr, int fq) const {
        const int col0 = u.pn * BM + wc * 32 + 8 * fq;
        f32x4 cv[2][2], bv[2][2];
        float mu[8], rs[8];
#pragma unroll
        for (int bj = 0; bj < 2; ++bj)
#pragma unroll
            for (int n = 0; n < 2; ++n) { cv[bj][n] = *(const f32x4*)(cs + col0 + bj * HALF + 4 * n); bv[bj][n] = *(const f32x4*)(bw + col0 + bj * HALF + 4 * n); }
#pragma unroll
        for (int g = 0; g < 8; ++g) st.get(u.pm, (g >> 2) * HALF + wr * 64 + (g & 3) * 16 + fr, mu[g], rs[g]);
#pragma unroll
        for (int ai = 0; ai < 2; ++ai)
#pragma unroll
            for (int m = 0; m < 4; ++m) {
                const int lr = ai * HALF + wr * 64 + m * 16 + fr, row = u.pm * BM + lr; const float mu_ = mu[ai * 4 + m], rs_ = rs[ai * 4 + m];
#pragma unroll
                for (int bj = 0; bj < 2; ++bj) {
                    const f32x4 v0 = (acc[ai][bj][m][0] - mu_ * cv[bj][0]) * rs_ + bv[bj][0], v1 = (acc[ai][bj][m][1] - mu_ * cv[bj][1]) * rs_ + bv[bj][1];
                    u32x4 w; w.x = cvt_pk_bf16(v0[0], v0[1]); w.y = cvt_pk_bf16(v0[2], v0[3]); w.z = cvt_pk_bf16(v1[0], v1[1]); w.w = cvt_pk_bf16(v1[2], v1[3]);
                    *(u32x4*)(O + (size_t)row * ldc + col0 + bj * HALF) = w;
                }
            }
    }
};
template <int MODE> struct EpiResid {
    static constexpr bool PERM = false, AFTER_DRAIN = true;
    const float* xres; const bf16_t* zprev; StatTbl st; const float* lg; const float* lb; bf16_t* zb; float* zf; float* oslab; float sc;
    struct Pre { f32x4 x[4]; u32x2 z[4]; };
    __device__ __forceinline__ void load(Pre& P, int row, int col0) const {
#pragma unroll
        for (int q = 0; q < 4; ++q) { const size_t off = (size_t)row * 2048 + col0 + (q >> 1) * HALF + (q & 1) * 16;
            if (MODE == 0) P.x[q] = *(const f32x4*)(xres + off); else P.z[q] = *(const u32x2*)(zprev + off); }
    }
    __device__ __forceinline__ void fused(f32x4 (&acc)[2][2][4][2], const Unit& u, int wr, int wc, int fr, int fq, PG8_LAS unsigned char* lds, int wid, int lane) const {
        const float alpha = 1.18920711500272f;
        const int col0 = u.pn * BM + wc * 32 + 4 * fq;
        PG8_LAS float* P = (PG8_LAS float*)lds;
        f32x4 gv[4], bv[4]; float mu[8], rs[8];
#pragma unroll
        for (int q = 0; q < 4; ++q) { if (MODE != 0) { gv[q] = *(const f32x4*)(lg + col0 + (q >> 1) * HALF + (q & 1) * 16); bv[q] = *(const f32x4*)(lb + col0 + (q >> 1) * HALF + (q & 1) * 16); } else { gv[q] = bv[q] = (f32x4){0.f, 0.f, 0.f, 0.f}; } }
#pragma unroll
        for (int g = 0; g < 8; ++g) { mu[g] = 0.f; rs[g] = 1.f; if (MODE != 0) st.get(u.pm, (g >> 2) * HALF + wr * 64 + (g & 3) * 16 + fr, mu[g], rs[g]); }
        Pre cur, nxt;
        load(cur, u.pm * BM + wr * 64 + fr, col0);
#pragma unroll
        for (int g = 0; g < 8; ++g) {
            const int ai = g >> 2, m = g & 3;
            const int lr = ai * HALF + wr * 64 + m * 16 + fr, row = u.pm * BM + lr;
            if (g < 7) load(nxt, u.pm * BM + ((g + 1) >> 2) * HALF + wr * 64 + ((g + 1) & 3) * 16 + fr, col0);
            float s1 = 0.f, s2 = 0.f;
#pragma unroll
            for (int q = 0; q < 4; ++q) {
                const int bj = q >> 1, n = q & 1; const size_t off = (size_t)row * 2048 + col0 + bj * HALF + n * 16;
                f32x4 res;
                if (MODE == 0) res = cur.x[q];
                else { const u32x2 zz = cur.z[q]; const f32x4 zv = (f32x4){bflo(zz.x), bfhi(zz.x), bflo(zz.y), bfhi(zz.y)}; res = (zv - mu[g]) * rs[g] * gv[q] + bv[q]; }
                const f32x4 z = alpha * res + sc * acc[ai][bj][m][n];
                s1 += (z[0] + z[1]) + (z[2] + z[3]); s2 += (z[0] * z[0] + z[1] * z[1]) + (z[2] * z[2] + z[3] * z[3]);
                if (MODE == 2) *(f32x4*)(zf + off) = z;
                else { u32x2 w; w.x = cvt_pk_bf16(z[0], z[1]); w.y = cvt_pk_bf16(z[2], z[3]); *(u32x2*)(zb + off) = w; }
            }
            s1 += __shfl_xor(s1, 16); s1 += __shfl_xor(s1, 32); s2 += __shfl_xor(s2, 16); s2 += __shfl_xor(s2, 32);
            if (fq == 0) { P[(lr * 4 + wc) * 2] = s1; P[(lr * 4 + wc) * 2 + 1] = s2; }
            cur = nxt;
        }
        __syncthreads();
        const int tid = wid * 64 + lane;
        if (tid < 256) {
            const PG8_LAS float* p = P + tid * 8;
            const float a = (p[0] + p[2]) + (p[4] + p[6]), b = (p[1] + p[3]) + (p[5] + p[7]);
            float* o = oslab + ((size_t)(u.pm * BM + tid) * 8 + u.pn) * 2; o[0] = a; o[1] = b;
        }
    }
};
template <int SECOND> struct EpiBranch {
    static constexpr bool PERM = true, AFTER_DRAIN = false;
    const bf16_t* proj; int ldp, gcol; bf16_t* t1; bf16_t* out;
    struct Pre { u32x4 g[2], t[2]; };
    __device__ __forceinline__ void load(Pre& P, int row, int col0) const {
#pragma unroll
        for (int bj = 0; bj < 2; ++bj) { P.g[bj] = *(const u32x4*)(proj + (size_t)row * ldp + gcol + col0 + bj * HALF); if (SECOND) P.t[bj] = *(const u32x4*)(t1 + (size_t)row * 2048 + col0 + bj * HALF); else P.t[bj] = (u32x4){0u, 0u, 0u, 0u}; }
    }
    __device__ __forceinline__ void operator()(const f32x4 (&acc)[2][2][4][2], const Unit& u, int wr, int wc, int fr, int fq) const {
        const int col0 = u.pn * BM + wc * 32 + 8 * fq, row0 = u.pm * BM + wr * 64 + fr;
        Pre cur, nxt;
        load(cur, row0, col0);
#pragma unroll
        for (int g = 0; g < 8; ++g) {
            const int ai = g >> 2, m = g & 3, row = row0 + ai * HALF + m * 16;
            if (g < 7) load(nxt, row0 + ((g + 1) >> 2) * HALF + ((g + 1) & 3) * 16, col0);
#pragma unroll
            for (int bj = 0; bj < 2; ++bj) {
                const u32x4 gz = cur.g[bj], tz = cur.t[bj];
                const f32x4 a0 = acc[ai][bj][m][0], a1 = acc[ai][bj][m][1];
                const float v0 = bflo(tz.x) + sigm(bflo(gz.x)) * a0[0], v1 = bfhi(tz.x) + sigm(bfhi(gz.x)) * a0[1], v2 = bflo(tz.y) + sigm(bflo(gz.y)) * a0[2], v3 = bfhi(tz.y) + sigm(bfhi(gz.y)) * a0[3];
                const float v4 = bflo(tz.z) + sigm(bflo(gz.z)) * a1[0], v5 = bfhi(tz.z) + sigm(bfhi(gz.z)) * a1[1], v6 = bflo(tz.w) + sigm(bflo(gz.w)) * a1[2], v7 = bfhi(tz.w) + sigm(bfhi(gz.w)) * a1[3];
                u32x4 w; w.x = cvt_pk_bf16(v0, v1); w.y = cvt_pk_bf16(v2, v3); w.z = cvt_pk_bf16(v4, v5); w.w = cvt_pk_bf16(v6, v7);
                *(u32x4*)((SECOND ? out : t1) + (size_t)row * 2048 + col0 + bj * HALF) = w;
            }
            cur = nxt;
        }
    }
};

template <class Epi, class Sched, bool ALIGN_EPI = false, bool SP2 = false>
__device__ __forceinline__ void gemm_phase(PG8_LAS unsigned char* lds, const Gemm g, const Sched& S, const Epi& E) {
    const int tid = threadIdx.x, wid = __builtin_amdgcn_readfirstlane(tid >> 6), lane = tid & 63, wr = wid >> 2, wc = wid & 3, fr = lane & 15, fq = lane >> 4;
    const int K = g.K, nt = K / BK;
    unsigned voffA[2], voffB[2];
#pragma unroll
    for (int i = 0; i < 2; ++i) { int R, C; stage_rc(tid * 16 + i * 8192, R, C); const int Rb = Epi::PERM ? ((R & ~31) + perm32(R & 31)) : R;
        voffA[i] = (unsigned)(R * K + C) * 2u; voffB[i] = (unsigned)(Rb * K + C) * 2u; }
    const size_t kstep = (size_t)(BK * 2);
    const size_t hstep = (size_t)HALF * K * 2;
    const size_t tstep = 2 * hstep;
    const unsigned ldsw = (unsigned)wid * 1024u;
    const int aoff = lds_byte(wr * 64 + fr, fq * 8), boff = lds_byte(wc * 32 + fr, fq * 8);
#define PG8_SA(b, h) (((b) * 2 + (h)) * HTB)
#define PG8_SB(b, h) ((4 + (b) * 2 + (h)) * HTB)
#define PG8_STAGE(bufoff, gbase, voff) do { _Pragma("unroll") for (int _i = 0; _i < 2; ++_i) \
        __builtin_amdgcn_global_load_lds((const unsigned*)((const char*)(gbase) + (voff)[_i]), (PG8_LAS unsigned*)(lds + (bufoff) + ldsw + _i * 8192), 16, 0, 0); } while (0)
#define PG8_LDA(dst, b, h) do { _Pragma("unroll") for (int m = 0; m < 4; ++m) _Pragma("unroll") for (int k = 0; k < 2; ++k) dst[m][k] = *(const PG8_LAS bf16x8*)(lds + PG8_SA(b, h) + aoff + m * 2048 + k * 1024); } while (0)
#define PG8_LDB(dst, b, h) do { _Pragma("unroll") for (int n = 0; n < 2; ++n) _Pragma("unroll") for (int k = 0; k < 2; ++k) dst[n][k] = *(const PG8_LAS bf16x8*)(lds + PG8_SB(b, h) + boff + n * 2048 + k * 1024); } while (0)
#define PG8_MMA(ai, bj, At, Bt) do { __builtin_amdgcn_s_setprio(1); _Pragma("unroll") for (int m = 0; m < 4; ++m) _Pragma("unroll") for (int n = 0; n < 2; ++n) _Pragma("unroll") for (int k = 0; k < 2; ++k) \
        acc[ai][bj][m][n] = __builtin_amdgcn_mfma_f32_16x16x32_bf16(Bt[n][k], At[m][k], acc[ai][bj][m][n], 0, 0, 0); __builtin_amdgcn_s_setprio(0); } while (0)
#define PG8_WAIT_V(n) asm volatile("s_waitcnt vmcnt(" #n ")" ::: "memory")
#define PG8_WAIT_L(n) asm volatile("s_waitcnt lgkmcnt(" #n ")" ::: "memory")
#define PG8_BAR __builtin_amdgcn_s_barrier()
#define PG8_SCHED __builtin_amdgcn_sched_barrier(0)
    Unit cur, nxt; int ui = 0;
    if (!S.next(0, cur)) return;
    f32x4 acc[2][2][4][2];
#pragma unroll
    for (int a = 0; a < 2; ++a)
#pragma unroll
        for (int b = 0; b < 2; ++b)
#pragma unroll
            for (int m = 0; m < 4; ++m)
#pragma unroll
                for (int n = 0; n < 2; ++n) acc[a][b][m][n] = (f32x4){0.f, 0.f, 0.f, 0.f};
    bf16x8 At[4][2], B0[2][2], B1[2][2];
    const char* cA = (const char*)g.A + (size_t)cur.pm * tstep; const char* cB = (const char*)g.Bt + (size_t)cur.pn * tstep;
    S.a_ready(cur);
    if constexpr (SP2) {
        PG8_STAGE(PG8_SB(0, 0), cB, voffB); PG8_STAGE(PG8_SB(0, 1), cB + hstep, voffB); PG8_STAGE(PG8_SA(0, 0), cA, voffA); PG8_STAGE(PG8_SA(0, 1), cA + hstep, voffA);
        if (wr == 1) PG8_BAR;
        PG8_WAIT_V(2); PG8_BAR;
        PG8_STAGE(PG8_SB(1, 0), cB + kstep, voffB); PG8_STAGE(PG8_SA(1, 0), cA + kstep, voffA); PG8_STAGE(PG8_SB(1, 1), cB + hstep + kstep, voffB);
        PG8_WAIT_V(6); PG8_BAR;
    } else {
        PG8_STAGE(PG8_SB(0, 0), cB, voffB); PG8_STAGE(PG8_SA(0, 0), cA, voffA); PG8_STAGE(PG8_SB(0, 1), cB + hstep, voffB); PG8_STAGE(PG8_SA(0, 1), cA + hstep, voffA);
        if (wr == 1) PG8_BAR;
        PG8_WAIT_V(4); PG8_BAR;
        PG8_STAGE(PG8_SB(1, 0), cB + kstep, voffB); PG8_STAGE(PG8_SA(1, 0), cA + kstep, voffA); PG8_STAGE(PG8_SB(1, 1), cB + hstep + kstep, voffB);
        PG8_WAIT_V(6); PG8_BAR;
    }
    for (;;) {
        const bool has_next = S.next(ui + 1, nxt);
        const char* nA = has_next ? (const char*)g.A + (size_t)nxt.pm * tstep : cA; const char* nB = has_next ? (const char*)g.Bt + (size_t)nxt.pn * tstep : cB;
        for (int t = 0; t < nt; t += 2) {
            const bool last = (t == nt - 2);
            const char* a1 = cA + (size_t)(t + 1) * kstep;
            const char* a2 = last ? nA : cA + (size_t)(t + 2) * kstep; const char* b2 = last ? nB : cB + (size_t)(t + 2) * kstep;
            const char* a3 = a2 + kstep; const char* b3 = b2 + kstep;
            if (last && has_next) S.a_ready(nxt);
            if constexpr (SP2) {
            PG8_LDB(B0, 0, 0); PG8_LDB(B1, 0, 1); PG8_SCHED; PG8_LDA(At, 0, 0); PG8_STAGE(PG8_SA(1, 1), a1 + hstep, voffA);
            PG8_WAIT_V(8); PG8_WAIT_L(0); PG8_BAR; PG8_MMA(0, 0, At, B0); PG8_MMA(0, 1, At, B1); PG8_BAR; PG8_SCHED;
            PG8_LDA(At, 0, 1); PG8_STAGE(PG8_SB(0, 0), b2, voffB); PG8_STAGE(PG8_SB(0, 1), b2 + hstep, voffB); PG8_STAGE(PG8_SA(0, 0), a2, voffA);
            PG8_WAIT_V(8); PG8_WAIT_L(0); PG8_BAR; PG8_MMA(1, 0, At, B0); PG8_MMA(1, 1, At, B1); PG8_BAR; PG8_SCHED;
            PG8_LDB(B0, 1, 0); PG8_LDB(B1, 1, 1); PG8_SCHED; PG8_LDA(At, 1, 0); PG8_STAGE(PG8_SA(0, 1), a2 + hstep, voffA);
            PG8_WAIT_V(8); PG8_WAIT_L(0); PG8_BAR; PG8_MMA(0, 0, At, B0); PG8_MMA(0, 1, At, B1); PG8_BAR; PG8_SCHED;
            PG8_LDA(At, 1, 1); PG8_STAGE(PG8_SB(1, 0), b3, voffB); PG8_STAGE(PG8_SB(1, 1), b3 + hstep, voffB); PG8_STAGE(PG8_SA(1, 0), a3, voffA);
            PG8_WAIT_V(8); PG8_WAIT_L(0); PG8_BAR; PG8_MMA(1, 0, At, B0); PG8_MMA(1, 1, At, B1); PG8_BAR; PG8_SCHED;
            } else {
            PG8_LDB(B0, 0, 0); PG8_SCHED; PG8_LDA(At, 0, 0); PG8_STAGE(PG8_SA(1, 1), a1 + hstep, voffA);
            PG8_WAIT_L(8); PG8_BAR; PG8_WAIT_L(0); PG8_MMA(0, 0, At, B0); PG8_BAR; PG8_SCHED;
            PG8_LDB(B1, 0, 1); PG8_STAGE(PG8_SB(0, 0), b2, voffB);
            PG8_BAR; PG8_WAIT_L(0); PG8_MMA(0, 1, At, B1); PG8_BAR;
            PG8_LDA(At, 0, 1); PG8_STAGE(PG8_SA(0, 0), a2, voffA);
            PG8_BAR; PG8_WAIT_L(0); PG8_MMA(1, 0, At, B0); PG8_BAR; PG8_SCHED;
            PG8_STAGE(PG8_SB(0, 1), b2 + hstep, voffB);
            PG8_WAIT_V(6); PG8_BAR; PG8_MMA(1, 1, At, B1); PG8_BAR;
            PG8_LDB(B0, 1, 0); PG8_SCHED; PG8_LDA(At, 1, 0); PG8_STAGE(PG8_SA(0, 1), a2 + hstep, voffA);
            PG8_WAIT_L(8); PG8_BAR; PG8_WAIT_L(0); PG8_MMA(0, 0, At, B0); PG8_BAR; PG8_SCHED;
            PG8_LDB(B1, 1, 1); PG8_STAGE(PG8_SB(1, 0), b3, voffB);
            PG8_BAR; PG8_WAIT_L(0); PG8_MMA(0, 1, At, B1); PG8_BAR;
            PG8_LDA(At, 1, 1); PG8_STAGE(PG8_SA(1, 0), a3, voffA);
            PG8_BAR; PG8_WAIT_L(0); PG8_MMA(1, 0, At, B0); PG8_BAR; PG8_SCHED;
            PG8_STAGE(PG8_SB(1, 1), b3 + hstep, voffB);
            PG8_WAIT_V(6); PG8_BAR; PG8_MMA(1, 1, At, B1); PG8_BAR;
            }
        }
        if constexpr (ALIGN_EPI) { if (wr == 0) PG8_BAR; }
        if constexpr (!Epi::AFTER_DRAIN) { E(acc, cur, wr, wc, fr, fq); S.done(cur); }
        if (!has_next) break;
#pragma unroll
        for (int a = 0; a < 2; ++a)
#pragma unroll
            for (int b = 0; b < 2; ++b)
#pragma unroll
                for (int m = 0; m < 4; ++m)
#pragma unroll
                    for (int n = 0; n < 2; ++n) acc[a][b][m][n] = (f32x4){0.f, 0.f, 0.f, 0.f};
        cur = nxt; cA = nA; cB = nB; ++ui;
        if constexpr (ALIGN_EPI) { if (wr == 1) PG8_BAR; }
    }
    PG8_WAIT_V(0);
    if constexpr (!ALIGN_EPI) { if (wr == 0) PG8_BAR; }
    PG8_BAR;
    if constexpr (Epi::AFTER_DRAIN) { E.fused(acc, cur, wr, wc, fr, fq, lds, wid, lane); S.done(cur); }
#undef PG8_SA
#undef PG8_SB
#undef PG8_STAGE
#undef PG8_LDA
#undef PG8_LDB
#undef PG8_MMA
#undef PG8_WAIT_V
#undef PG8_WAIT_L
#undef PG8_BAR
#undef PG8_SCHED
}
}
using namespace pg8;
#define LAS __attribute__((address_space(3)))
typedef short s16x4 __attribute__((ext_vector_type(4)));
typedef float f32x16 __attribute__((ext_vector_type(16)));
typedef float f32x2 __attribute__((ext_vector_type(2)));
#define MFMA32(a, b, c) __builtin_amdgcn_mfma_f32_32x32x16_bf16((a), (b), (c), 0, 0, 0)
#define MFMA16(a, b, c) __builtin_amdgcn_mfma_f32_16x16x32_bf16((a), (b), (c), 0, 0, 0)
#define LDS_WAIT() asm volatile("s_waitcnt lgkmcnt(0)" ::: "memory")

constexpr int NBATCH = 2, SEQ = 4096, DM = 2048, NMETA = 16, MR = NBATCH * SEQ  , MPAD = 8448  , METAROW = 8192;
constexpr int DFF = 5632, NGU = 2 * DFF, PW = 11008  , NPROJ = 10832;
constexpr int PC_AQ = 0, PC_AK = 1024, PC_AV = 1280, PC_IQ = 1536, PC_HQ = 2560, PC_HF = 3584, PC_HI = 4608, PC_HG = 5632, PC_GA = 6656, PC_GH = 8704, PC_IK = 10752, PC_IW = 10816;
constexpr int NCS = PW + NGU;
constexpr size_t MiB = 1u << 20;
constexpr size_t WS_CTL = 0, CTL_BYTES = 1 * MiB;
constexpr size_t WS_PCS = 1 * MiB, WS_PBW = 4 * MiB, WS_CSV = 7 * MiB, WS_BWV = 7 * MiB + 131072, WS_Z1M = 7 * MiB + 262144, WS_ST1 = 8 * MiB, WS_ST2 = 9 * MiB, WS_ST3 = 10 * MiB;
constexpr size_t WS_WGU1 = 11 * MiB, WS_WD1 = 55 * MiB, WS_H0B = 77 * MiB, WS_G = 110 * MiB, WS_PROJ = 11 * MiB, WS_G2 = 11 * MiB;
constexpr size_t WS_WIN = 201 * MiB, WS_IKN = 201 * MiB, WS_SEL = 202 * MiB, WS_GCH = 206 * MiB, WS_YATT = 207 * MiB, WS_YHG = 223 * MiB;
constexpr size_t WS_WBA = 244 * MiB, WS_WBH = 248 * MiB, WS_WOUT = 252 * MiB, WS_WGU2 = 260 * MiB, WS_WD2 = 304 * MiB, WS_Z1B = 326 * MiB;
constexpr size_t WS_APART = 187 * MiB  , WS_APML = 196 * MiB;
constexpr size_t WS_QT = 359 * MiB, WS_OI = 375 * MiB, WS_LST = 407 * MiB, WS_T1 = 359 * MiB, WS_MRG = 391 * MiB, WS_Z2B = 359 * MiB, WS_END = 440 * MiB;
static_assert(WS_G + (size_t)MPAD * DFF * 2 <= WS_WIN && WS_PROJ + (size_t)MPAD * PW * 2 <= WS_WIN && WS_LST + (size_t)16 * 65 * 32768 <= WS_END && WS_ST1 + (size_t)MPAD * 64 <= WS_ST2, "ws map");
constexpr int CW_AFLAG = 8192;
constexpr int CW_Q6 = 2048;
constexpr int CW_BAR = 4096;
constexpr int RING_BYTES = 131072, MISC_OFF = 163840 - 256, WL_OFF = RING_BYTES + 512, STT_OFF = RING_BYTES + 1024, STT_TBL = STT_OFF + 256, LDS_BYTES = 163840;

typedef unsigned v4u __attribute__((ext_vector_type(4)));
__device__ __forceinline__ unsigned f2bf(float f) { unsigned u = __builtin_bit_cast(unsigned, f); return (u + 0x7fffu + ((u >> 16) & 1u)) >> 16; }
__device__ __forceinline__ unsigned pk2(float lo, float hi) { return f2bf(lo) | (f2bf(hi) << 16); }
__device__ __forceinline__ float bf2f(unsigned short h) { return __uint_as_float(((unsigned)h) << 16); }
__device__ __forceinline__ float bfround(float x) { return __uint_as_float(f2bf(x) << 16); }
__device__ __forceinline__ float wave_sum(float v) {
#pragma unroll
    for (int o = 1; o < 64; o <<= 1) v += __shfl_xor(v, o);
    return v;
}
__device__ __forceinline__ int crow(int reg, int h) { return (reg & 3) + 8 * (reg >> 2) + 4 * h; }

#define XB_TMO      128
#define XB_XCNT(j)  (256  + 64 * (j))
#define XB_XSUB(j)  (1280 + 64 * (j))
#define XB_XGEN(j)  (2304 + 64 * (j))
#define XB_TOP      3328
#define XB_TOPGEN   3392
#define XCD_BAR_WORDS 3456
#define XB_SPIN_CAP (1u << 18)

__device__ __forceinline__ unsigned xb_ld(unsigned* p)              { return __hip_atomic_load(p, __ATOMIC_RELAXED, __HIP_MEMORY_SCOPE_AGENT); }
__device__ __forceinline__ unsigned xb_add(unsigned* p, unsigned v) { return __hip_atomic_fetch_add(p, v, __ATOMIC_RELAXED, __HIP_MEMORY_SCOPE_AGENT); }
__device__ __forceinline__ unsigned xb_xcc_id() { return (unsigned)__builtin_amdgcn_s_getreg((3 << 11) | 20) & 0xFu; }
#define XB_SPIN(cond, bar) do { unsigned _sp = 0; while (cond) { __builtin_amdgcn_s_sleep(1); \
    if ((++_sp & 255u) == 0u) { if (xb_ld(&(bar)[XB_TMO])) break; if (_sp > XB_SPIN_CAP) { atomicAdd(&(bar)[XB_TMO], 1u); break; } } } } while (0)

struct XcdBarrier {
    unsigned* bar; unsigned x;
    volatile LAS unsigned* st;
};

__device__ __forceinline__ XcdBarrier xcd_barrier_post(unsigned* bar, volatile LAS unsigned* st) {
    XcdBarrier b; b.bar = bar; b.x = xb_xcc_id(); b.st = st;
    if (threadIdx.x == 0) (void)xb_add(&bar[XB_XCNT(b.x)], 1u);
    return b;
}
__device__ __forceinline__ void xcd_barrier_complete(unsigned* bar, unsigned x, unsigned& nloc, unsigned& nx) {
    const unsigned G = gridDim.x * gridDim.y * gridDim.z;
    unsigned sum, cnt, mine, sp = 0u;
    for (;;) {
        sum = 0u; cnt = 0u; mine = 0u;
#pragma unroll
        for (unsigned j = 0; j < 16; ++j) { const unsigned c = xb_ld(&bar[XB_XCNT(j)]); sum += c; cnt += (c > 0u) ? 1u : 0u; mine = (j == x) ? c : mine; }
        if (sum == G) break;
        __builtin_amdgcn_s_sleep(1);
        if ((++sp & 255u) == 0u) { if (xb_ld(&bar[XB_TMO])) break; if (sp > XB_SPIN_CAP) { atomicAdd(&bar[XB_TMO], 1u); break; } }
    }
    nloc = mine > 0u ? mine : 1u; nx = cnt > 0u ? cnt : 1u;
}

__device__ __forceinline__ void xcd_barrier(const XcdBarrier& b) {
    asm volatile("s_waitcnt vmcnt(0)" ::: "memory");
    __syncthreads();
    if (threadIdx.x == 0) {
        unsigned* bar = b.bar;
        __builtin_amdgcn_s_waitcnt(0);
        unsigned nloc = b.st[0], nx = b.st[1];
        if (nloc == 0u) { xcd_barrier_complete(bar, b.x, nloc, nx); b.st[0] = nloc; b.st[1] = nx; }
        const unsigned old = xb_add(&bar[XB_XSUB(b.x)], 1u);
        const unsigned gen = old / nloc;
        if (old + 1u == (gen + 1u) * nloc) {
            __builtin_amdgcn_fence(__ATOMIC_RELEASE, "agent");
            asm volatile("s_waitcnt vmcnt(0)" ::: "memory");
            const unsigned og = xb_add(&bar[XB_TOP], 1u);
            const unsigned tg = og / nx;
            if (og + 1u == (tg + 1u) * nx) xb_add(&bar[XB_TOPGEN], 1u);
            else XB_SPIN(xb_ld(&bar[XB_TOPGEN]) == tg, bar);
            __builtin_amdgcn_fence(__ATOMIC_ACQUIRE, "agent");
            xb_add(&bar[XB_XGEN(b.x)], 1u);
            asm volatile("s_waitcnt vmcnt(0)" ::: "memory");
        } else {
            XB_SPIN(xb_ld(&bar[XB_XGEN(b.x)]) == gen, bar);
            __builtin_amdgcn_fence(__ATOMIC_ACQUIRE, "agent");
            asm volatile("s_waitcnt vmcnt(0)" ::: "memory");
        }
    }
    __syncthreads();
}
struct Frame {
    LAS unsigned char* lds;
    int tid, lane, wave, G, gw, NGW;
    const float* in[22]; float* out; unsigned char* ws;
};
#define WSP(T, off) ((T*)(F.ws + (off)))

__device__ __forceinline__ int dst_row(int map, int n) {
    if (map == 1) return ((n >> 7) << 8) + (n & 127);
    if (map == 2) return ((n >> 7) << 8) + 128 + (n & 127);
    if (map == 3) return n < 2560 ? n : (n < 2640 ? n + 8192 : n - 80);
    return n;
}
struct TrJob { const float* W; bf16_t* WT; const float* g; const float* b; int K, N, map, pcol0, item; };
__device__ __forceinline__ bool tr_decode(Frame& F, int it, TrJob& J) {
    constexpr int I_GU = 32 * 176, I_DN = 88 * 64, I_IN = 32 * 339, I_BR = 16 * 64, I_OUT = 32 * 64;
    constexpr int NITEMS = 6 * I_GU + I_IN + 2 * I_BR + I_OUT;
    static_assert(I_DN == I_GU, "items");
    if (it >= NITEMS) return false;
    int r = it; J.g = nullptr; J.b = nullptr; J.pcol0 = 0; J.map = 0;
    if (r < I_GU) { J.W = F.in[2]; J.K = DM; J.N = DFF; J.WT = WSP(bf16_t, WS_WGU1); J.map = 1; J.item = r; return true; } r -= I_GU;
    if (r < I_GU) { J.W = F.in[3]; J.K = DM; J.N = DFF; J.WT = WSP(bf16_t, WS_WGU1); J.map = 2; J.item = r; return true; } r -= I_GU;
    if (r < I_DN) { J.W = F.in[4]; J.K = DFF; J.N = DM; J.WT = WSP(bf16_t, WS_WD1); J.item = r; return true; } r -= I_DN;
    if (r < I_IN) { J.W = F.in[7]; J.K = DM; J.N = NPROJ; J.WT = WSP(bf16_t, WS_WIN); J.map = 3; J.g = F.in[5]; J.b = F.in[6]; J.item = r; return true; } r -= I_IN;
    if (r < I_BR) { J.W = F.in[12]; J.K = 1024; J.N = DM; J.WT = WSP(bf16_t, WS_WBA); J.item = r; return true; } r -= I_BR;
    if (r < I_BR) { J.W = F.in[13]; J.K = 1024; J.N = DM; J.WT = WSP(bf16_t, WS_WBH); J.item = r; return true; } r -= I_BR;
    if (r < I_OUT) { J.W = F.in[14]; J.K = DM; J.N = DM; J.WT = WSP(bf16_t, WS_WOUT); J.item = r; return true; } r -= I_OUT;
    if (r < I_GU) { J.W = F.in[17]; J.K = DM; J.N = DFF; J.WT = WSP(bf16_t, WS_WGU2); J.map = 1; J.g = F.in[15]; J.b = F.in[16]; J.pcol0 = PW; J.item = r; return true; } r -= I_GU;
    if (r < I_GU) { J.W = F.in[18]; J.K = DM; J.N = DFF; J.WT = WSP(bf16_t, WS_WGU2); J.map = 2; J.g = F.in[15]; J.b = F.in[16]; J.pcol0 = PW; J.item = r; return true; } r -= I_GU;
    J.W = F.in[19]; J.K = DFF; J.N = DM; J.WT = WSP(bf16_t, WS_WD2); J.item = r; return true;
}
__device__ __forceinline__ void tr_load(const TrJob& J, int lane, f32x4 (&v)[8]) {
    const int nblk = (J.N + 31) >> 5, kb = J.item / nblk, nb = J.item - kb * nblk, k0 = 64 * kb, nn = 32 * nb + 4 * (lane & 7);
    const float* p = J.W + (size_t)(k0 + (lane >> 3)) * J.N + nn; const bool ok = nn < J.N;
#pragma unroll
    for (int i = 0; i < 8; ++i) v[i] = ok ? *(const f32x4*)(p + (size_t)(8 * i) * J.N) : (f32x4){0.f, 0.f, 0.f, 0.f};
}
__device__ __forceinline__ void tr_process(const TrJob& J, f32x4 (&v)[8], float* pcs, float* pbw, LAS float* scr, int lane) {
    const int nblk = (J.N + 31) >> 5, kb = J.item / nblk, nb = J.item - kb * nblk, k0 = 64 * kb, n0 = 32 * nb, nn = n0 + 4 * (lane & 7);
    if (J.g) {
        float cs[4] = {0.f, 0.f, 0.f, 0.f}, bw[4] = {0.f, 0.f, 0.f, 0.f};
#pragma unroll
        for (int i = 0; i < 8; ++i) { const int k = k0 + (lane >> 3) + 8 * i; const float gk = J.g[k], bk = J.b[k];
#pragma unroll
            for (int e = 0; e < 4; ++e) { bw[e] += bk * v[i][e]; v[i][e] *= gk; cs[e] += bfround(v[i][e]); } }
#pragma unroll
        for (int e = 0; e < 4; ++e) { cs[e] += __shfl_xor(cs[e], 8); cs[e] += __shfl_xor(cs[e], 16); cs[e] += __shfl_xor(cs[e], 32); bw[e] += __shfl_xor(bw[e], 8); bw[e] += __shfl_xor(bw[e], 16); bw[e] += __shfl_xor(bw[e], 32); }
        if (lane < 8 && nn < J.N) {
#pragma unroll
            for (int e = 0; e < 4; ++e) { const int d = J.pcol0 + dst_row(J.map, nn + e); pcs[(size_t)kb * NCS + d] = cs[e]; pbw[(size_t)kb * NCS + d] = bw[e]; } }
    }
#pragma unroll
    for (int i = 0; i < 8; ++i) { LAS float* q = scr + ((lane >> 3) + 8 * i) * 33 + 4 * (lane & 7); q[0] = v[i][0]; q[1] = v[i][1]; q[2] = v[i][2]; q[3] = v[i][3]; }
    LDS_WAIT(); asm volatile("" ::: "memory");
    const int c = lane & 7;
#pragma unroll
    for (int j = 0; j < 4; ++j) { const int n = (lane >> 3) + 8 * j; const LAS float* s = scr + (8 * c) * 33 + n;
        if (n0 + n < J.N) { v4u o; o.x = pk2(s[0 * 33], s[1 * 33]); o.y = pk2(s[2 * 33], s[3 * 33]); o.z = pk2(s[4 * 33], s[5 * 33]); o.w = pk2(s[6 * 33], s[7 * 33]);
            *(v4u*)(J.WT + (size_t)dst_row(J.map, n0 + n) * J.K + k0 + 8 * c) = o; } }
    LDS_WAIT(); asm volatile("" ::: "memory");
}
__device__ __forceinline__ void p0_prologue(Frame& F) {
    LAS float* scr = (LAS float*)(F.lds + F.wave * 16384);
    float* pcs = WSP(float, WS_PCS); float* pbw = WSP(float, WS_PBW);
    {
        TrJob j0, j1, j2; f32x4 v0[8], v1[8], v2[8];
        bool h0 = tr_decode(F, F.gw, j0);
        if (h0) tr_load(j0, F.lane, v0);
        bool h1 = tr_decode(F, F.gw + F.NGW, j1);
        if (h1) tr_load(j1, F.lane, v1);
        for (int it = F.gw; h0; it += F.NGW) {
            const bool h2 = tr_decode(F, it + 2 * F.NGW, j2);
            if (h2) tr_load(j2, F.lane, v2);
            tr_process(j0, v0, pcs, pbw, scr, F.lane);
            j0 = j1; h0 = h1; j1 = j2; h1 = h2;
#pragma unroll
            for (int i = 0; i < 8; ++i) { v0[i] = v1[i]; v1[i] = v2[i]; }
        }
    }
    bf16_t* h0b = WSP(bf16_t, WS_H0B); bf16_t* z1b = WSP(bf16_t, WS_Z1B); bf16_t* wint = WSP(bf16_t, WS_WIN);
    for (int m = F.gw; m < MPAD + (PW - NPROJ); m += F.NGW) {
        if (m >= MPAD) { u32x2* o = (u32x2*)(wint + (size_t)(NPROJ + m - MPAD) * DM) + F.lane;
#pragma unroll
            for (int j = 0; j < 8; ++j) o[64 * j] = (u32x2){0u, 0u};
            continue; }
        const float* src = m < MR ? F.in[0] + (size_t)m * DM : (m < MR + NMETA ? F.in[1] + (size_t)(m - MR) * DM : nullptr);
        u32x2* o = (u32x2*)(h0b + (size_t)m * DM) + F.lane;
        f32x4 xv[8];
#pragma unroll
        for (int j = 0; j < 8; ++j) xv[j] = src ? ((const f32x4*)src)[F.lane + 64 * j] : (f32x4){0.f, 0.f, 0.f, 0.f};
#pragma unroll
        for (int j = 0; j < 8; ++j) { u32x2 w; w.x = pk2(xv[j][0], xv[j][1]); w.y = pk2(xv[j][2], xv[j][3]); o[64 * j] = w; }
        if (m >= MR + NMETA) { u32x2* oz = (u32x2*)(z1b + (size_t)m * DM) + F.lane;
#pragma unroll
            for (int j = 0; j < 8; ++j) oz[64 * j] = (u32x2){0u, 0u}; }
    }
}
__device__ __forceinline__ void p1_colsums(Frame& F) {
    const float* pcs = WSP(float, WS_PCS); const float* pbw = WSP(float, WS_PBW); float* csv = WSP(float, WS_CSV); float* bwv = WSP(float, WS_BWV);
    for (int i = blockIdx.x * 512 + F.tid; i < NCS; i += F.G * 512) {
        float cs = 0.f, bw = 0.f;
        if (!(i >= NPROJ && i < PW)) {
#pragma unroll 8
            for (int kb = 0; kb < 32; ++kb) { cs += pcs[(size_t)kb * NCS + i]; bw += pbw[(size_t)kb * NCS + i]; } }
        csv[i] = cs; bwv[i] = bw;
    }
}
__device__ __forceinline__ void p2_meta_down(Frame& F) {
    const bf16_t* G = WSP(bf16_t, WS_G); const bf16_t* wd = WSP(bf16_t, WS_WD1); float* z1m = WSP(float, WS_Z1M); bf16_t* z1b = WSP(bf16_t, WS_Z1B);
    const int lane = F.lane;
    for (int c = F.gw; c < DM; c += F.NGW) {
        const bf16_t* wrow = wd + (size_t)c * DFF;
        float acc[16];
#pragma unroll
        for (int r = 0; r < 16; ++r) acc[r] = 0.f;
        for (int i = 0; i < 11; ++i) {
            const int k = 8 * lane + 512 * i;
            const v4u wv = *(const v4u*)(wrow + k);
            const float w0 = bflo(wv.x), w1 = bfhi(wv.x), w2 = bflo(wv.y), w3 = bfhi(wv.y), w4 = bflo(wv.z), w5 = bfhi(wv.z), w6 = bflo(wv.w), w7 = bfhi(wv.w);
#pragma unroll
            for (int r = 0; r < 16; ++r) { const v4u gv = *(const v4u*)(G + (size_t)(METAROW + r) * DFF + k);
                acc[r] += (bflo(gv.x) * w0 + bfhi(gv.x) * w1) + (bflo(gv.y) * w2 + bfhi(gv.y) * w3) + (bflo(gv.z) * w4 + bfhi(gv.z) * w5) + (bflo(gv.w) * w6 + bfhi(gv.w) * w7); }
        }
        float v8[8], v4[4], v2[2], v1;
#pragma unroll
        for (int i = 0; i < 8; ++i) { const bool hi = (lane & 32) != 0; const float send = hi ? acc[i] : acc[8 + i], keep = hi ? acc[8 + i] : acc[i]; v8[i] = keep + __shfl_xor(send, 32); }
#pragma unroll
        for (int i = 0; i < 4; ++i) { const bool hi = (lane & 16) != 0; const float send = hi ? v8[i] : v8[4 + i], keep = hi ? v8[4 + i] : v8[i]; v4[i] = keep + __shfl_xor(send, 16); }
#pragma unroll
        for (int i = 0; i < 2; ++i) { const bool hi = (lane & 8) != 0; const float send = hi ? v4[i] : v4[2 + i], keep = hi ? v4[2 + i] : v4[i]; v2[i] = keep + __shfl_xor(send, 8); }
        { const bool hi = (lane & 4) != 0; const float send = hi ? v2[0] : v2[1], keep = hi ? v2[1] : v2[0]; v1 = keep + __shfl_xor(send, 4); }
        v1 += __shfl_xor(v1, 1); v1 += __shfl_xor(v1, 2);
        const int r = ((lane >> 5) & 1) * 8 + ((lane >> 4) & 1) * 4 + ((lane >> 3) & 1) * 2 + ((lane >> 2) & 1);
        if ((lane & 3) == 0) { const float z = 1.18920711500272f * F.in[1][(size_t)r * DM + c] + 0.5f * v1; z1m[(size_t)r * DM + c] = z; z1b[(size_t)(METAROW + r) * DM + c] = (bf16_t)f2bf(z); }
    }
}
__device__ __forceinline__ StatTbl fill_stats(Frame& F, const StaticOrder& S, const float* slab, const float* z1m) {
    LAS int* slot = (LAS int*)(F.lds + STT_OFF); LAS float* tbl = (LAS float*)(F.lds + STT_TBL);
    if (F.tid < 64) slot[F.tid] = -1;
    __syncthreads();
    int ns = 0; Unit u;
    for (int i = 0; S.next(i, u); ++i) {
        const int have = slot[u.pm];
        __syncthreads();
        if (have < 0) {
            if (F.tid == 0) slot[u.pm] = ns;
            if (u.pm == 32) {
                if (F.tid < 256) { tbl[(ns * 256 + F.tid) * 2] = 0.f; tbl[(ns * 256 + F.tid) * 2 + 1] = 0.f; }
                __syncthreads();
#pragma unroll
                for (int q = 0; q < 2; ++q) { const int r = 2 * F.wave + q; float s1 = 0.f, s2 = 0.f;
#pragma unroll
                    for (int j = 0; j < 8; ++j) { const f32x4 v = ((const f32x4*)(z1m + (size_t)r * DM))[F.lane + 64 * j]; s1 += (v[0] + v[1]) + (v[2] + v[3]); s2 += (v[0] * v[0] + v[1] * v[1]) + (v[2] * v[2] + v[3] * v[3]); }
                    s1 = wave_sum(s1); s2 = wave_sum(s2);
                    const float mu = s1 * (1.f / DM), var = fmaxf(s2 * (1.f / DM) - mu * mu, 0.f);
                    if (F.lane == 0) { tbl[(ns * 256 + r) * 2] = mu; tbl[(ns * 256 + r) * 2 + 1] = __builtin_amdgcn_rsqf(var + 1e-5f); } }
            } else if (F.tid < 256) { float mu, rs; row_stats(slab, u.pm * 256 + F.tid, mu, rs); tbl[(ns * 256 + F.tid) * 2] = mu; tbl[(ns * 256 + F.tid) * 2 + 1] = rs; }
            ++ns;
            __syncthreads();
        }
    }
    StatTbl t; t.slot = slot; t.tbl = tbl; return t;
}
__device__ __forceinline__ void p4_ikn(Frame& F) {
    const bf16_t* proj = WSP(bf16_t, WS_PROJ); bf16_t* ikn = WSP(bf16_t, WS_IKN);
    const float g = F.in[8][F.lane], b = F.in[9][F.lane];
    for (int row = F.gw; row < MR; row += F.NGW) {
        const float v = bf2f(proj[(size_t)row * PW + PC_IK + F.lane]);
        const float mu = wave_sum(v) * (1.f / 64.f); const float d = v - mu; const float var = wave_sum(d * d) * (1.f / 64.f);
        ikn[(size_t)row * 64 + F.lane] = (bf16_t)f2bf(d * __builtin_amdgcn_rsqf(var + 1e-5f) * g + b);
    }
}
constexpr int QP = 136, TP = 72;
__device__ __forceinline__ void h1_item(Frame& F, int bh, int c) {
    const int b = bh >> 3, h = bh & 7, tid = F.tid, lane = F.lane, w = F.wave;
    const bf16_t* proj = WSP(bf16_t, WS_PROJ);
    LAS bf16_t* Qs = (LAS bf16_t*)F.lds; LAS bf16_t* Ks = Qs + 64 * QP; LAS bf16_t* KhT = Ks + 64 * QP; LAS bf16_t* VT = KhT + 128 * TP; LAS float* tot = (LAS float*)(VT + 128 * TP);
    const int ch = tid & 127, part = tid >> 7;
    const float l0 = F.in[10][h * 128 + ch], l1 = F.in[10][1024 + h * 128 + ch];
    const float lb = 1.f / (1.f + __expf(l1 - l0));
    float fgv[16], cum[16]; float run = 0.f;
    const size_t prow0 = c == 0 ? (size_t)METAROW : (size_t)(b * SEQ + (c - 1) * 64 + 16 * part);
    const bf16_t* pf = proj + prow0 * PW + PC_HF + h * 128 + ch; const bf16_t* pq = proj + prow0 * PW + PC_HQ + h * 128 + ch; const bf16_t* pv = proj + prow0 * PW + PC_HI + h * 128 + ch;
    unsigned short fraw[16], qraw[16], vraw[16];
#pragma unroll
    for (int i = 0; i < 16; ++i) fraw[i] = pf[(size_t)i * PW];
#pragma unroll
    for (int i = 0; i < 16; ++i) { qraw[i] = pq[(size_t)i * PW]; vraw[i] = pv[(size_t)i * PW]; }
#pragma unroll
    for (int i = 0; i < 16; ++i) { const int tt = 16 * part + i; const bool valid = (c > 0) || (tt < NMETA);
        const float f = bf2f(fraw[i]);
        const float fg = valid ? lb + (1.f - lb) * sigm(f) : 1.f; run += __logf(fg); fgv[i] = fg; cum[i] = run; }
    tot[part * 128 + ch] = run;
    __syncthreads();
    float off = 0.f, blast = 0.f;
#pragma unroll
    for (int p = 0; p < 4; ++p) { const float t = tot[p * 128 + ch]; if (p < part) off += t; blast += t; }
    if (part == 0) WSP(float, WS_GCH)[(size_t)(bh * 65 + c) * 128 + ch] = __expf(blast);
    bf16_t* qtg = WSP(bf16_t, WS_QT);
#pragma unroll
    for (int i = 0; i < 16; ++i) { const int tt = 16 * part + i; const bool valid = (c > 0) || (tt < NMETA);
        const float bq = off + cum[i], fg = fgv[i];
        const float q = valid ? bf2f(qraw[i]) : 0.f, v = valid ? bf2f(vraw[i]) : 0.f;
        const float qt = silu(q) * __expf(bq), kk = 1.f - fg, kt = kk * __expf(-bq), kh = kk * __expf(blast - bq);
        const bf16_t qb = (bf16_t)f2bf(qt);
        Qs[tt * QP + ch] = qb; Ks[tt * QP + ch] = (bf16_t)f2bf(kt); KhT[ch * TP + tt] = (bf16_t)f2bf(kh); VT[ch * TP + tt] = (bf16_t)f2bf(v);
        if (c > 0) qtg[((size_t)(bh * 64 + (c - 1)) * 64 + tt) * 128 + ch] = qb; }
    __syncthreads();
    const int tb = w >> 2, dvb = w & 3, r = lane & 31, hh = lane >> 5;
    if (c > 0) {
        f32x16 o;
#pragma unroll
        for (int i = 0; i < 16; ++i) o[i] = 0.f;
        for (int sb = 0; sb <= tb; ++sb) {
            f32x16 x;
#pragma unroll
            for (int i = 0; i < 16; ++i) x[i] = 0.f;
#pragma unroll
            for (int ks = 0; ks < 8; ++ks) { const bf16x8 a = *(const LAS bf16x8*)(Ks + (32 * sb + r) * QP + 16 * ks + 8 * hh); const bf16x8 bq = *(const LAS bf16x8*)(Qs + (32 * tb + r) * QP + 16 * ks + 8 * hh); x = MFMA32(a, bq, x); }
            if (sb == tb) {
#pragma unroll
                for (int i = 0; i < 16; ++i) if (crow(i, hh) > r) x[i] = 0.f; }
#pragma unroll
            for (int s2 = 0; s2 < 2; ++s2) {
                bf16x8 xb;
#pragma unroll
                for (int j = 0; j < 8; ++j) xb[j] = (short)f2bf(x[8 * s2 + j]);
                const LAS bf16_t* vp = VT + (32 * dvb + r) * TP + 32 * sb + 16 * s2 + 4 * hh;
                const s16x4 lo = *(const LAS s16x4*)vp, hi = *(const LAS s16x4*)(vp + 8);
                const bf16x8 a2 = __builtin_shufflevector(lo, hi, 0, 1, 2, 3, 4, 5, 6, 7);
                o = MFMA32(a2, xb, o);
            }
        }
        float* oi = WSP(float, WS_OI) + ((size_t)(bh * 64 + (c - 1)) * 8 + w) * 1024 + lane;
#pragma unroll
        for (int i = 0; i < 16; ++i) oi[i * 64] = o[i];
    }
    if (c < 64) {
        bf16_t* lst = WSP(bf16_t, WS_LST) + (size_t)(bh * 65 + c) * 16384;
#pragma unroll
        for (int q2 = 0; q2 < 2; ++q2) { const int db = (w >> 2) * 2 + q2;
            f32x16 l;
#pragma unroll
            for (int i = 0; i < 16; ++i) l[i] = 0.f;
#pragma unroll
            for (int ks = 0; ks < 4; ++ks) { const bf16x8 a = *(const LAS bf16x8*)(VT + (32 * dvb + r) * TP + 16 * ks + 8 * hh); const bf16x8 bb = *(const LAS bf16x8*)(KhT + (32 * db + r) * TP + 16 * ks + 8 * hh); l = MFMA32(a, bb, l); }
#pragma unroll
            for (int i = 0; i < 16; ++i) lst[(size_t)(32 * dvb + crow(i, hh)) * 128 + 32 * db + r] = (bf16_t)f2bf(l[i]); }
    }
    __syncthreads();
}
__device__ __forceinline__ void h2_item(Frame& F, int it) {
    const int bh = it >> 4, part = it & 15, dv = 8 * part + (F.tid >> 6), d0 = 2 * (F.tid & 63);
    bf16_t* p = WSP(bf16_t, WS_LST) + ((size_t)bh * 65 * 128 + dv) * 128 + d0; const float* g = WSP(float, WS_GCH) + (size_t)bh * 65 * 128 + d0;
    float s0 = 0.f, s1 = 0.f;
#pragma unroll 8
    for (int c = 0; c < 64; ++c) { const unsigned l = *(const unsigned*)(p + (size_t)c * 16384); const f32x2 gg = *(const f32x2*)(g + c * 128);
        s0 = gg.x * s0 + bflo(l); s1 = gg.y * s1 + bfhi(l); *(unsigned*)(p + (size_t)c * 16384) = pk2(s0, s1); }
}
__device__ __forceinline__ void h3_item(Frame& F, int bh, int c) {
    const int b = bh >> 3, h = bh & 7, lane = F.lane, w = F.wave, tid = F.tid;
    const bf16_t* st = WSP(bf16_t, WS_LST) + (size_t)(bh * 65 + (c - 1)) * 16384; const bf16_t* qg = WSP(bf16_t, WS_QT) + (size_t)(bh * 64 + (c - 1)) * 8192;
    const float* oi = WSP(float, WS_OI) + ((size_t)(bh * 64 + (c - 1)) * 8 + w) * 1024 + lane;
    LAS float* Ot = (LAS float*)F.lds; LAS float* ssq = Ot + 64 * 129;
    const int tb = w >> 2, dvb = w & 3, r = lane & 31, hh = lane >> 5;
    f32x16 o;
#pragma unroll
    for (int i = 0; i < 16; ++i) o[i] = oi[i * 64];
#pragma unroll
    for (int ks = 0; ks < 8; ++ks) { const bf16x8 a = *(const bf16x8*)(st + (size_t)(32 * dvb + r) * 128 + 16 * ks + 8 * hh); const bf16x8 bq = *(const bf16x8*)(qg + (size_t)(32 * tb + r) * 128 + 16 * ks + 8 * hh); o = MFMA32(a, bq, o); }
    float ss = 0.f;
#pragma unroll
    for (int i = 0; i < 16; ++i) { ss += o[i] * o[i]; Ot[(32 * tb + r) * 129 + 32 * dvb + crow(i, hh)] = o[i]; }
    ssq[(dvb * 2 + hh) * 64 + 32 * tb + r] = ss;
    __syncthreads();
    const int t = tid >> 3, d0 = (tid & 7) * 16;
    float sq = 0.f;
#pragma unroll
    for (int k = 0; k < 8; ++k) sq += ssq[k * 64 + t];
    const float rstd = __builtin_amdgcn_rsqf(sq * (1.f / 128.f) + 1e-6f);
    const size_t row = (size_t)(b * SEQ + (c - 1) * 64 + t);
    const bf16_t* gp = WSP(bf16_t, WS_PROJ) + row * PW + PC_HG + h * 128 + d0; const float* ng = F.in[11] + h * 128 + d0;
    bf16_t* yp = WSP(bf16_t, WS_YHG) + row * 1024 + h * 128 + d0;
#pragma unroll
    for (int q = 0; q < 2; ++q) { const v4u gz = *(const v4u*)(gp + 8 * q); const f32x4 n0 = *(const f32x4*)(ng + 8 * q), n1 = *(const f32x4*)(ng + 8 * q + 4);
        const LAS float* op = Ot + t * 129 + d0 + 8 * q;
        v4u wv; wv.x = pk2(op[0] * rstd * n0[0] * silu(bflo(gz.x)), op[1] * rstd * n0[1] * silu(bfhi(gz.x))); wv.y = pk2(op[2] * rstd * n0[2] * silu(bflo(gz.y)), op[3] * rstd * n0[3] * silu(bfhi(gz.y)));
        wv.z = pk2(op[4] * rstd * n1[0] * silu(bflo(gz.z)), op[5] * rstd * n1[1] * silu(bfhi(gz.z))); wv.w = pk2(op[6] * rstd * n1[2] * silu(bflo(gz.w)), op[7] * rstd * n1[3] * silu(bfhi(gz.w)));
        *(v4u*)(yp + 8 * q) = wv; }
    __syncthreads();
}
__device__ __forceinline__ int wave_total(int v) {
    v += __builtin_amdgcn_update_dpp(0, v, 0xB1, 0xF, 0xF, true);
    v += __builtin_amdgcn_update_dpp(0, v, 0x4E, 0xF, 0xF, true);
    v += __builtin_amdgcn_update_dpp(0, v, 0x141, 0xF, 0xF, true);
    v += __builtin_amdgcn_update_dpp(0, v, 0x140, 0xF, 0xF, true);
    v += __builtin_amdgcn_update_dpp(0, v, 0x142, 0xA, 0xF, true);
    v += __builtin_amdgcn_update_dpp(0, v, 0x143, 0xC, 0xF, true);
    return __builtin_amdgcn_readlane(v, 63);
}
__device__ __forceinline__ void cnt4_ge(int& cnt, unsigned mid, unsigned a, unsigned b, unsigned c, unsigned d) {
    unsigned long long m0, m1, m2, m3; int t0, t1, t2, t3;
    asm volatile("v_cmp_le_u32_e64 %1, %9, %10\n\tv_cmp_le_u32_e64 %2, %9, %11\n\tv_cmp_le_u32_e64 %3, %9, %12\n\tv_cmp_le_u32_e64 %4, %9, %13\n\t"
                 "s_bcnt1_i32_b64 %5, %1\n\ts_bcnt1_i32_b64 %6, %2\n\ts_bcnt1_i32_b64 %7, %3\n\ts_bcnt1_i32_b64 %8, %4\n\t"
                 "s_add_i32 %0, %0, %5\n\ts_add_i32 %0, %0, %6\n\ts_add_i32 %0, %0, %7\n\ts_add_i32 %0, %0, %8"
                 : "+s"(cnt), "=&s"(m0), "=&s"(m1), "=&s"(m2), "=&s"(m3), "=&s"(t0), "=&s"(t1), "=&s"(t2), "=&s"(t3)
                 : "s"(mid), "v"(a), "v"(b), "v"(c), "v"(d) : "scc");
}
__device__ __forceinline__ void cnt4_gt(int& cnt, unsigned mid, unsigned a, unsigned b, unsigned c, unsigned d) {
    unsigned long long m0, m1, m2, m3; int t0, t1, t2, t3;
    asm volatile("v_cmp_lt_u32_e64 %1, %9, %10\n\tv_cmp_lt_u32_e64 %2, %9, %11\n\tv_cmp_lt_u32_e64 %3, %9, %12\n\tv_cmp_lt_u32_e64 %4, %9, %13\n\t"
                 "s_bcnt1_i32_b64 %5, %1\n\ts_bcnt1_i32_b64 %6, %2\n\ts_bcnt1_i32_b64 %7, %3\n\ts_bcnt1_i32_b64 %8, %4\n\t"
                 "s_add_i32 %0, %0, %5\n\ts_add_i32 %0, %0, %6\n\ts_add_i32 %0, %0, %7\n\ts_add_i32 %0, %0, %8"
                 : "+s"(cnt), "=&s"(m0), "=&s"(m1), "=&s"(m2), "=&s"(m3), "=&s"(t0), "=&s"(t1), "=&s"(t2), "=&s"(t3)
                 : "s"(mid), "v"(a), "v"(b), "v"(c), "v"(d) : "scc");
}
__device__ __forceinline__ void idx_item(Frame& F, int b, int qblk) {
    const int lane = F.lane, w = F.wave;
#ifdef TS_A0
    unsigned long long* tsx = (unsigned long long*)(F.ws + WS_CTL + 65536); const bool tsl = blockIdx.x == 0 && F.tid == 0;
    const unsigned long long t0_ = __builtin_amdgcn_s_memrealtime();
#endif
    const bf16_t* proj = WSP(bf16_t, WS_PROJ); const bf16_t* ikn = WSP(bf16_t, WS_IKN);
    LAS unsigned* sc = (LAS unsigned*)F.lds;
    const int r0 = 8 * qblk, ntile = (r0 + 8 + 31) >> 5;
    const int r = lane & 31, hh = lane >> 5;
    {
        LAS float* wl = (LAS float*)(F.lds + WL_OFF);
        LAS bf16_t* iql = (LAS bf16_t*)(wl + 128);
        if (F.tid < 128) wl[F.tid] = bf2f(proj[(size_t)(b * SEQ + r0 + (F.tid >> 4)) * PW + PC_IW + (F.tid & 15)]) * (1.f / 32.f);
        {
            const int q = F.tid >> 6, d = F.tid & 63; const bf16_t* pw = proj + (size_t)(b * SEQ + r0 + q) * PW;
            unsigned short wr_[16], qr_[16];
#pragma unroll
            for (int hd = 0; hd < 16; ++hd) { wr_[hd] = pw[PC_IW + hd]; qr_[hd] = pw[PC_IQ + hd * 64 + d]; }
            float acc_ = 0.f;
#pragma unroll
            for (int hd = 0; hd < 16; ++hd) acc_ += bf2f(wr_[hd]) * bf2f(qr_[hd]);
            iql[q * 64 + d] = (bf16_t)f2bf(acc_ * (1.f / 32.f));
        }
        bf16x8 a[4][4];
#pragma unroll
        for (int p = 0; p < 4; ++p) {
            const size_t rowq = (size_t)(b * SEQ + r0 + 2 * p + (r >> 4));
#pragma unroll
            for (int ks = 0; ks < 4; ++ks) a[p][ks] = *(const bf16x8*)(proj + rowq * PW + PC_IQ + (r & 15) * 64 + 16 * ks + 8 * hh);
        }
        __syncthreads();
        bf16x8 al[4];
#pragma unroll
        for (int ks = 0; ks < 4; ++ks) { bf16x8 z = {0, 0, 0, 0, 0, 0, 0, 0}; if (r < 8) z = *(const LAS bf16x8*)(iql + (2 * (r & 3) + (r >> 2)) * 64 + 16 * ks + 8 * hh); al[ks] = z; }
        bf16x8 bc[4], bn[4];
#define IDX_LOAD(dst, kt) do { int kt_ = (kt); if (kt_ >= ntile) kt_ = w < ntile ? w : 0; const bf16_t* kp_ = ikn + (size_t)(b * SEQ + 32 * kt_ + r) * 64 + 8 * hh; \
    _Pragma("unroll") for (int ks = 0; ks < 4; ++ks) dst[ks] = *(const bf16x8*)(kp_ + 16 * ks); } while (0)
        IDX_LOAD(bc, w);
        for (int kt = w; kt < ntile; kt += 8) {
            IDX_LOAD(bn, kt + 8);
            const int key = 32 * kt + r;
            f32x16 xl;
#pragma unroll
            for (int i = 0; i < 16; ++i) xl[i] = 0.f;
#pragma unroll
            for (int ks = 0; ks < 4; ++ks) xl = MFMA32(al[ks], bc[ks], xl);
#pragma unroll
            for (int p = 0; p < 4; ++p) {
                f32x16 x;
#pragma unroll
                for (int i = 0; i < 16; ++i) x[i] = 0.f;
#pragma unroll
                for (int ks = 0; ks < 4; ++ks) x = MFMA32(a[p][ks], bc[ks], x);
                const LAS f32x4* wq = (const LAS f32x4*)(wl + (2 * p) * 16 + 4 * hh);
                const f32x4 w0 = wq[0], w1 = wq[2], w2 = wq[4], w3 = wq[6];
                float p0 = 0.f, p1 = 0.f;
#pragma unroll
                for (int i = 0; i < 4; ++i) { p0 += w0[i] * fabsf(x[i]); p0 += w1[i] * fabsf(x[4 + i]); p1 += w2[i] * fabsf(x[8 + i]); p1 += w3[i] * fabsf(x[12 + i]); }
                const auto sw = __builtin_amdgcn_permlane32_swap(__float_as_uint(p0), __float_as_uint(p1), false, false);
                const float tot = 0.5f * ((__uint_as_float(sw[0]) + __uint_as_float(sw[1])) + xl[p]);
                unsigned u = __float_as_uint(tot); u = (u & 0x80000000u) ? ~u : (u | 0x80000000u); if (key > r0 + 2 * p + hh) u = 0u;
                sc[(2 * p + hh) * 4096 + key] = u;
            }
#pragma unroll
            for (int ks = 0; ks < 4; ++ks) bc[ks] = bn[ks];
        }
#undef IDX_LOAD
    }
    __syncthreads();
#ifdef TS_A0
    const unsigned long long t1_ = __builtin_amdgcn_s_memrealtime(); if (tsl) tsx[21] += t1_ - t0_;
#endif
    {
        const int rq = r0 + w, nvalid = rq + 1, nk = ntile * 32;
        unsigned k[64];
#pragma unroll
        for (int i = 0; i < 64; ++i) { const int idx = lane + 64 * i; k[i] = idx < nk ? sc[w * 4096 + idx] : 0u; }
        unsigned thr = 0u; bool exact = false;
        if (nvalid > 256) {
            unsigned lo = 1u, hi = 0xFFFFFFFFu;
            while (hi - lo > 1u) { const unsigned mid = lo + ((hi - lo) >> 1); int cnt = 0;
#pragma unroll
                for (int i = 0; i < 64; i += 4) cnt4_ge(cnt, mid, k[i], k[i + 1], k[i + 2], k[i + 3]);
                if (cnt == 256) { lo = mid; exact = true; break; }
                if (cnt > 256) lo = mid; else hi = mid; }
            thr = lo;
        }
        int quota = 0;
        if (thr != 0u && !exact) { int ngt = 0;
#pragma unroll
            for (int i = 0; i < 64; i += 4) cnt4_gt(ngt, thr, k[i], k[i + 1], k[i + 2], k[i + 3]);
            quota = 256 - ngt; }
        int eqrun = 0; unsigned long long myword = 0ull;
#pragma unroll
        for (int i = 0; i < 64; ++i) { const bool gt = exact ? (k[i] >= thr) : (k[i] > thr), eq = (k[i] == thr) && (thr != 0u) && !exact;
            const unsigned long long meq = __ballot(eq); const int eqb = eqrun + (int)__builtin_amdgcn_mbcnt_hi((unsigned)(meq >> 32), __builtin_amdgcn_mbcnt_lo((unsigned)meq, 0u));
            const bool take = gt || (eq && eqb < quota);
            const unsigned long long m = __ballot(take);
            if (lane == i) myword = m;
            eqrun += __popcll(meq); }
        WSP(unsigned long long, WS_SEL)[(size_t)(b * SEQ + rq) * 64 + lane] = myword;
    }
    __syncthreads();
#ifdef TS_A0
    if (tsl) tsx[23] += __builtin_amdgcn_s_memrealtime() - t1_;
#endif
}
constexpr int AKP = 136, AVP = 72;
constexpr int AK_BYTES = 64 * AKP * 2, AV_BYTES = 128 * AVP * 2;
__device__ __forceinline__ void att_unit(Frame& F, int b, int kv, int qb, int t_lo, int t_hi, int mode, int uidx) {
    const int lane = F.lane, w = F.wave, tid = F.tid;
    const bf16_t* proj = WSP(bf16_t, WS_PROJ); const unsigned long long* mask = WSP(unsigned long long, WS_SEL);
    LAS bf16_t* Kl0 = (LAS bf16_t*)F.lds; LAS bf16_t* Vl0 = (LAS bf16_t*)(F.lds + 2 * AK_BYTES); LAS bf16_t* Ql = (LAS bf16_t*)(F.lds + 2 * AK_BYTES + 2 * AV_BYTES) + w * 4096 + lane * 8;
    const int col = lane & 31, hh = lane >> 5, ql = col >> 2, h = col & 3;
    const int q = 64 * qb + 8 * w + ql; const size_t rowq = (size_t)(b * SEQ + q);
    __syncthreads();
#pragma unroll
    for (int ks = 0; ks < 8; ++ks) { const v4u raw = *(const v4u*)(proj + rowq * PW + PC_AQ + (kv * 4 + h) * 128 + 16 * ks + 8 * hh); const float sc = 0.08838834764831845f;
        v4u o; o.x = pk2(bflo(raw.x) * sc, bfhi(raw.x) * sc); o.y = pk2(bflo(raw.y) * sc, bfhi(raw.y) * sc); o.z = pk2(bflo(raw.z) * sc, bfhi(raw.z) * sc); o.w = pk2(bflo(raw.w) * sc, bfhi(raw.w) * sc);
        *(LAS v4u*)(Ql + ks * 512) = o; }
    bf16x8 qe;
    { const float slope = exp2f(-(float)(kv * 4 + h + 1)); v4u o = (v4u){0u, 0u, 0u, 0u}; if (hh == 0) o.x = pk2(64.f * slope, slope); qe = __builtin_bit_cast(bf16x8, o); }
    const int pi_ = (col & 16) | ((col & 4) << 1) | ((col & 8) >> 1) | (col & 3);
    f32x16 o0, o1, o2, o3;
#pragma unroll
    for (int i = 0; i < 16; ++i) { o0[i] = 0.f; o1[i] = 0.f; o2[i] = 0.f; o3[i] = 0.f; }
    float m_run = -1e30f, l_run = 0.f;
    const int skey = tid & 63, sch = tid >> 6;
    v4u sk0, sk1, sv0, sv1; unsigned long long mw = 0ull;
#define ATT_ROW(t_) ((t_) == 0 ? proj + (size_t)(METAROW + (skey & 15)) * PW + kv * 128 : proj + (size_t)(b * SEQ + 64 * (qb + 1 - (t_)) + skey) * PW + kv * 128)
#define ATT_LOADK(t) do { const int t_ = (t); const bool ok_ = t_ != 0 || skey < NMETA; const bf16_t* p_ = ATT_ROW(t_); const v4u z_ = (v4u){0u, 0u, 0u, 0u}; \
        sk0 = ok_ ? *(const v4u*)(p_ + PC_AK + 8 * sch) : z_; sk1 = ok_ ? *(const v4u*)(p_ + PC_AK + 8 * (sch + 8)) : z_; } while (0)
#define ATT_LOADV(t) do { const int t_ = (t); const bool ok_ = t_ != 0 || skey < NMETA; const bf16_t* p_ = ATT_ROW(t_); const v4u z_ = (v4u){0u, 0u, 0u, 0u}; \
        sv0 = ok_ ? *(const v4u*)(p_ + PC_AV + 8 * sch) : z_; sv1 = ok_ ? *(const v4u*)(p_ + PC_AV + 8 * (sch + 8)) : z_; mw = t_ == 0 ? 0ull : mask[rowq * 64 + (qb + 1 - t_)]; } while (0)
#define ATT_VT(dst, v, c) do { LAS bf16_t* d_ = (dst) + (8 * (c)) * AVP + skey; \
        d_[0 * AVP] = (bf16_t)(v.x & 0xffffu); d_[1 * AVP] = (bf16_t)(v.x >> 16); d_[2 * AVP] = (bf16_t)(v.y & 0xffffu); d_[3 * AVP] = (bf16_t)(v.y >> 16); \
        d_[4 * AVP] = (bf16_t)(v.z & 0xffffu); d_[5 * AVP] = (bf16_t)(v.z >> 16); d_[6 * AVP] = (bf16_t)(v.w & 0xffffu); d_[7 * AVP] = (bf16_t)(v.w >> 16); } while (0)
#define ATT_STOREK(buf) do { LAS bf16_t* kd_ = Kl0 + (buf) * (64 * AKP) + skey * AKP; *(LAS v4u*)(kd_ + 8 * sch) = sk0; *(LAS v4u*)(kd_ + 8 * (sch + 8)) = sk1; } while (0)
#define ATT_STOREV(buf) do { LAS bf16_t* vd_ = Vl0 + (buf) * (128 * AVP); ATT_VT(vd_, sv0, sch); ATT_VT(vd_, sv1, sch + 8); } while (0)
#define ATT_S(xa, xb, t) do { const int t_ = (t); const LAS bf16_t* Kb_ = Kl0 + (t_ & 1) * (64 * AKP); const int pos0_ = t_ == 0 ? 0 : NMETA + 64 * (qb + 1 - t_); \
        _Pragma("unroll") for (int i = 0; i < 16; ++i) { xa[i] = 0.f; xb[i] = 0.f; } \
        _Pragma("unroll") for (int ks = 0; ks < 8; ++ks) { const bf16x8 a0 = *(const LAS bf16x8*)(Kb_ + pi_ * AKP + 16 * ks + 8 * hh); const bf16x8 a1 = *(const LAS bf16x8*)(Kb_ + (32 + pi_) * AKP + 16 * ks + 8 * hh); \
            const bf16x8 qf_ = *(const LAS bf16x8*)(Ql + ks * 512); xa = MFMA32(a0, qf_, xa); xb = MFMA32(a1, qf_, xb); } \
        { const int p0_ = pos0_ + pi_, p1_ = pos0_ + 32 + pi_; v4u e0 = (v4u){0u, 0u, 0u, 0u}, e1 = e0; \
          if (hh == 0) { e0.x = pk2((float)(p0_ >> 6), (float)(p0_ & 63)); e1.x = pk2((float)(p1_ >> 6), (float)(p1_ & 63)); } \
          xa = MFMA32(__builtin_bit_cast(bf16x8, e0), qe, xa); xb = MFMA32(__builtin_bit_cast(bf16x8, e1), qe, xb); } } while (0)
    const int ntiles = t_hi;
    ATT_LOADK(t_lo); ATT_LOADV(t_lo); ATT_STOREK(t_lo & 1); ATT_STOREV(t_lo & 1);
    ATT_LOADK(t_lo + 1); ATT_STOREK((t_lo + 1) & 1);
    unsigned long long mcur = mw;
    __syncthreads();
    f32x16 x0, x1, y0, y1;
    ATT_S(x0, x1, t_lo);
    __syncthreads();
    for (int t = t_lo; t < ntiles; ++t) {
        if (t + 2 < ntiles) ATT_LOADK(t + 2);
        if (t + 1 < ntiles) ATT_LOADV(t + 1);
        if (t + 1 < ntiles) ATT_S(y0, y1, t + 1);
        const LAS bf16_t* Vb = Vl0 + (t & 1) * (128 * AVP);
        const unsigned mk0 = t == 0 ? 0x000000ffu : (unsigned)(mcur >> (8 * hh)), mk1 = t == 0 ? 0u : (unsigned)(mcur >> (32 + 8 * hh));
        float mt = -INFINITY;
#pragma unroll
        for (int i = 0; i < 16; ++i) { const int bit = (i & 7) + 16 * (i >> 3);
            const unsigned s0 = (unsigned)(((int)(mk0 << (31 - bit))) >> 31), s1 = (unsigned)(((int)(mk1 << (31 - bit))) >> 31);
            x0[i] = __uint_as_float((__float_as_uint(x0[i]) & s0) | (~s0 & 0xff800000u)); x1[i] = __uint_as_float((__float_as_uint(x1[i]) & s1) | (~s1 & 0xff800000u));
            mt = fmaxf(mt, fmaxf(x0[i], x1[i])); }
        { const auto sw = __builtin_amdgcn_permlane32_swap(__float_as_uint(mt), __float_as_uint(mt), false, false); mt = fmaxf(__uint_as_float(sw[0]), __uint_as_float(sw[1])); }
        const float m_new = (mt > m_run + 8.f) ? mt : m_run;
        const float LOG2E = 1.4426950408889634f;
        const float alpha = __builtin_amdgcn_exp2f((m_run - m_new) * LOG2E);
        m_run = m_new;
        const float mneg = -m_new * LOG2E;
        float ls = 0.f;
#pragma unroll
        for (int i = 0; i < 16; ++i) { x0[i] = __builtin_amdgcn_exp2f(fmaf(x0[i], LOG2E, mneg)); x1[i] = __builtin_amdgcn_exp2f(fmaf(x1[i], LOG2E, mneg)); ls += x0[i] + x1[i]; }
        l_run = l_run * alpha + ls;
        if (__any(alpha != 1.f)) {
#pragma unroll
            for (int i = 0; i < 16; ++i) { o0[i] *= alpha; o1[i] *= alpha; o2[i] *= alpha; o3[i] *= alpha; } }
#pragma unroll
        for (int cb = 0; cb < 2; ++cb)
#pragma unroll
            for (int s2 = 0; s2 < 2; ++s2) {
                u32x4 pw;
#pragma unroll
                for (int j = 0; j < 4; ++j) pw[j] = cb == 0 ? cvt_pk_bf16(x0[8 * s2 + 2 * j], x0[8 * s2 + 2 * j + 1]) : cvt_pk_bf16(x1[8 * s2 + 2 * j], x1[8 * s2 + 2 * j + 1]);
                const bf16x8 pb = __builtin_bit_cast(bf16x8, pw);
                const LAS bf16_t* vp = Vb + col * AVP + 32 * cb + 16 * s2 + 8 * hh;
                o0 = MFMA32(*(const LAS bf16x8*)(vp), pb, o0); o1 = MFMA32(*(const LAS bf16x8*)(vp + 32 * AVP), pb, o1);
                o2 = MFMA32(*(const LAS bf16x8*)(vp + 64 * AVP), pb, o2); o3 = MFMA32(*(const LAS bf16x8*)(vp + 96 * AVP), pb, o3);
            }
        if (t + 2 < ntiles) ATT_STOREK(t & 1);
        if (t + 1 < ntiles) { ATT_STOREV((t + 1) & 1); mcur = mw; }
#pragma unroll
        for (int i = 0; i < 16; ++i) { x0[i] = y0[i]; x1[i] = y1[i]; }
        __syncthreads();
    }
#undef ATT_S
#undef ATT_ROW
#undef ATT_LOADK
#undef ATT_LOADV
#undef ATT_VT
#undef ATT_STOREK
#undef ATT_STOREV
    { const auto sw = __builtin_amdgcn_permlane32_swap(__float_as_uint(l_run), __float_as_uint(l_run), false, false); l_run = __uint_as_float(sw[0]) + __uint_as_float(sw[1]); }
    bf16_t* pO = WSP(bf16_t, WS_APART) + (size_t)uidx * (256 * 128) + (size_t)(32 * w + col) * 128 + 4 * hh; float* pML = WSP(float, WS_APML) + (size_t)uidx * 512 + (32 * w + col) * 2;
    unsigned* flag = (unsigned*)(F.ws + WS_CTL) + CW_AFLAG + 64 * uidx;
    if (mode == 1) {
#pragma unroll
        for (int g4 = 0; g4 < 4; ++g4) {
            u32x2 w0, w1, w2, w3;
            w0.x = pk2(o0[4 * g4], o0[4 * g4 + 1]); w0.y = pk2(o0[4 * g4 + 2], o0[4 * g4 + 3]); w1.x = pk2(o1[4 * g4], o1[4 * g4 + 1]); w1.y = pk2(o1[4 * g4 + 2], o1[4 * g4 + 3]);
            w2.x = pk2(o2[4 * g4], o2[4 * g4 + 1]); w2.y = pk2(o2[4 * g4 + 2], o2[4 * g4 + 3]); w3.x = pk2(o3[4 * g4], o3[4 * g4 + 1]); w3.y = pk2(o3[4 * g4 + 2], o3[4 * g4 + 3]);
            *(u32x2*)(pO + 8 * g4) = w0; *(u32x2*)(pO + 32 + 8 * g4) = w1; *(u32x2*)(pO + 64 + 8 * g4) = w2; *(u32x2*)(pO + 96 + 8 * g4) = w3; }
        if (hh == 0) { pML[0] = m_run; pML[1] = l_run; }
        asm volatile("s_waitcnt vmcnt(0)" ::: "memory");
        __syncthreads();
        if (tid == 0) { __builtin_amdgcn_fence(__ATOMIC_RELEASE, "agent"); asm volatile("s_waitcnt vmcnt(0)" ::: "memory"); __hip_atomic_store(flag, 1u, __ATOMIC_RELAXED, __HIP_MEMORY_SCOPE_AGENT); }
        return;
    }
    float sc_own = 1.f, sc_oth = 0.f, l_tot = l_run;
    if (mode == 2) {
        if (tid == 0) { unsigned spins = 0; while (__hip_atomic_load(flag, __ATOMIC_RELAXED, __HIP_MEMORY_SCOPE_AGENT) == 0u && ++spins < (1u << 22)) __builtin_amdgcn_s_sleep(8);
            __builtin_amdgcn_fence(__ATOMIC_ACQUIRE, "agent"); asm volatile("s_waitcnt vmcnt(0)" ::: "memory"); }
        __syncthreads();
        const float m2 = pML[0], l2 = pML[1]; const float mm = fmaxf(m_run, m2);
        sc_own = __expf(m_run - mm); sc_oth = __expf(m2 - mm); l_tot = l_run * sc_own + l2 * sc_oth;
    }
    const float inv = 1.f / l_tot; const float ko = sc_own * inv, kp = sc_oth * inv;
    bf16_t* yp = WSP(bf16_t, WS_YATT) + rowq * 1024 + (kv * 4 + h) * 128 + 4 * hh;
#pragma unroll
    for (int g4 = 0; g4 < 4; ++g4) {
        u32x2 q0 = (u32x2){0u, 0u}, q1 = q0, q2 = q0, q3 = q0;
        if (mode == 2) { q0 = *(const u32x2*)(pO + 8 * g4); q1 = *(const u32x2*)(pO + 32 + 8 * g4); q2 = *(const u32x2*)(pO + 64 + 8 * g4); q3 = *(const u32x2*)(pO + 96 + 8 * g4); }
        u32x2 w0, w1, w2, w3;
        w0.x = pk2(o0[4 * g4] * ko + bflo(q0.x) * kp, o0[4 * g4 + 1] * ko + bfhi(q0.x) * kp); w0.y = pk2(o0[4 * g4 + 2] * ko + bflo(q0.y) * kp, o0[4 * g4 + 3] * ko + bfhi(q0.y) * kp);
        w1.x = pk2(o1[4 * g4] * ko + bflo(q1.x) * kp, o1[4 * g4 + 1] * ko + bfhi(q1.x) * kp); w1.y = pk2(o1[4 * g4 + 2] * ko + bflo(q1.y) * kp, o1[4 * g4 + 3] * ko + bfhi(q1.y) * kp);
        w2.x = pk2(o2[4 * g4] * ko + bflo(q2.x) * kp, o2[4 * g4 + 1] * ko + bfhi(q2.x) * kp); w2.y = pk2(o2[4 * g4 + 2] * ko + bflo(q2.y) * kp, o2[4 * g4 + 3] * ko + bfhi(q2.y) * kp);
        w3.x = pk2(o3[4 * g4] * ko + bflo(q3.x) * kp, o3[4 * g4 + 1] * ko + bfhi(q3.x) * kp); w3.y = pk2(o3[4 * g4 + 2] * ko + bflo(q3.y) * kp, o3[4 * g4 + 3] * ko + bfhi(q3.y) * kp);
        *(u32x2*)(yp + 8 * g4) = w0; *(u32x2*)(yp + 32 + 8 * g4) = w1; *(u32x2*)(yp + 64 + 8 * g4) = w2; *(u32x2*)(yp + 96 + 8 * g4) = w3;
    }
}
__device__ __forceinline__ void p11_final_ln(Frame& F) {
    const float* st = WSP(float, WS_ST3); const float* g = F.in[20]; const float* b = F.in[21];
    for (int row = F.gw; row < MR; row += F.NGW) { float mu, rs; row_stats(st, row, mu, rs);
        f32x4* o = (f32x4*)(F.out + (size_t)row * DM);
#pragma unroll
        for (int j = 0; j < 8; ++j) { const int i = F.lane + 64 * j; const f32x4 z = o[i]; o[i] = (z - mu) * rs * ((const f32x4*)g)[i] + ((const f32x4*)b)[i]; } }
}
struct Args { const float* in[22]; float* out; unsigned char* ws; int ph_lo, ph_hi, li, pad; };
constexpr int NPH = 12;
__global__ void __launch_bounds__(512, 2) mk_fwd(Args args) {
    extern __shared__ __attribute__((aligned(16))) unsigned char lds_raw[];
    Frame F;
    F.lds = (LAS unsigned char*)lds_raw;
    F.tid = threadIdx.x; F.lane = F.tid & 63; F.wave = __builtin_amdgcn_readfirstlane(F.tid >> 6);
    F.G = gridDim.x; F.gw = blockIdx.x * 8 + F.wave; F.NGW = F.G * 8;
#pragma unroll
    for (int i = 0; i < 22; ++i) F.in[i] = args.in[i];
    F.out = args.out; F.ws = args.ws;
    volatile LAS unsigned* MISC = (volatile LAS unsigned*)(F.lds + MISC_OFF);
    if (F.tid < 64) MISC[F.tid] = 0u;
    __syncthreads();
    XcdBarrier bar = xcd_barrier_post((unsigned*)(F.ws + WS_CTL) + CW_BAR + args.li * XCD_BAR_WORDS, MISC + 8);
    const int lo = args.ph_lo, hi = args.ph_hi;
#define IN(k) (lo <= (k) && (k) < hi)
#ifdef TS_A0
    unsigned long long* ts = (unsigned long long*)(F.ws + WS_CTL + 65536);
#define MARK(i) do { if (blockIdx.x == 0 && F.tid == 0) ts[i] = __builtin_amdgcn_s_memrealtime(); } while (0)
#else
#define MARK(i) do { } while (0)
#endif
    MARK(0);
#define SEAM(k) do { if (IN(k) && IN((k) + 1)) xcd_barrier(bar); MARK((k) + 1); } while (0)
    const int bid = blockIdx.x;
#ifndef REP_MASK
#define REP_MASK 0
#endif
#define PBEG(k) if (IN(k)) { const int nrep_ = ((REP_MASK >> (k)) & 1) ? 2 : 1; for (int rep = 0; rep < nrep_; ++rep) { if (rep) xcd_barrier(bar);
#define PEND(k) } } SEAM(k);

    PBEG(0) p0_prologue(F); PEND(0)
    PBEG(1)
        p1_colsums(F); MARK(16);
        Gemm g{WSP(bf16_t, WS_H0B), WSP(bf16_t, WS_WGU1), MPAD, NGU, DM}; StaticOrder S; S.init(MPAD, NGU, F.G, bid);
        EpiSwiGLU<false> E{WSP(bf16_t, WS_G), DFF, StatTbl{nullptr, nullptr}, nullptr, nullptr};
        gemm_phase<EpiSwiGLU<false>, StaticOrder, true, true>(F.lds, g, S, E);
    PEND(1)
    PBEG(2)
        p2_meta_down(F); MARK(17);
        Gemm g{WSP(bf16_t, WS_G), WSP(bf16_t, WS_WD1), MR, DM, DFF}; StaticOrder S; S.init(MR, DM, F.G, bid);
        EpiResid<0> E{F.in[0], nullptr, StatTbl{nullptr, nullptr}, nullptr, nullptr, WSP(bf16_t, WS_Z1B), nullptr, WSP(float, WS_ST1), 0.5f};
        gemm_phase<EpiResid<0>, StaticOrder, false, true>(F.lds, g, S, E);
    PEND(2)
    PBEG(3)
        Gemm g{WSP(bf16_t, WS_Z1B), WSP(bf16_t, WS_WIN), MPAD, PW, DM}; StaticOrder S; S.init(MPAD, PW, F.G, bid);
        const StatTbl st = fill_stats(F, S, WSP(float, WS_ST1), WSP(float, WS_Z1M)); MARK(18);
        EpiProj E{WSP(bf16_t, WS_PROJ), PW, st, WSP(float, WS_CSV), WSP(float, WS_BWV)};
        gemm_phase<EpiProj, StaticOrder, true, true>(F.lds, g, S, E);
    PEND(3)
    PBEG(4)
        p4_ikn(F); MARK(13);
        for (int it = bid; it < 16 * 65; it += F.G) h1_item(F, it / 65, it % 65);
    PEND(4)
    PBEG(5)
        if (rep == 0) for (int it = bid; it < 256; it += F.G) h2_item(F, it);
        MARK(14);
        for (int it = bid; it < 1024; it += F.G) { const int j = it >> 8, x = it & 255; idx_item(F, j >> 1, (j & 1) ? 511 - x : x); }
    PEND(5)
    PBEG(6)
#ifndef REP_H3
#define REP_H3 1
#endif
#ifndef REP_ATT
#define REP_ATT 1
#endif
        {
            const int pr = bid >> 1, ab = pr >> 6, akv = (pr >> 5) & 1, j = pr & 31, qbl = 32 + j, split = j + 2;
            if (F.G == 256) {
                if (bid & 1) att_unit(F, ab, akv, qbl, split, qbl + 2, 1, pr);
                else { att_unit(F, ab, akv, 31 - j, 0, 33 - j, 0, 0); att_unit(F, ab, akv, qbl, 0, split, 2, pr); }
            } else for (int it = bid; it < 256; it += F.G) att_unit(F, it >> 7, (it >> 6) & 1, it & 63, 0, (it & 63) + 2, 0, 0);
        }
        MARK(15);
        {
            unsigned* qctr = (unsigned*)(F.ws + WS_CTL) + CW_Q6 + 64 * rep; volatile LAS int* qslot = (volatile LAS int*)(F.lds + MISC_OFF + 128);
            for (;;) {
                __syncthreads();
                if (F.tid == 0) qslot[0] = (int)__hip_atomic_fetch_add(qctr, 1u, __ATOMIC_RELAXED, __HIP_MEMORY_SCOPE_AGENT);
                __syncthreads();
                const int it = qslot[0];
                if (it >= 16 * 64) break;
                h3_item(F, it >> 6, (it & 63) + 1);
            }
        }
    PEND(6)
    PBEG(7)
        { Gemm g{WSP(bf16_t, WS_YATT), WSP(bf16_t, WS_WBA), MR, DM, 1024}; StaticOrder S; S.init(MR, DM, F.G, bid);
          EpiBranch<0> E{WSP(bf16_t, WS_PROJ), PW, PC_GA, WSP(bf16_t, WS_T1), nullptr};
          gemm_phase<EpiBranch<0>, StaticOrder, false, true>(F.lds, g, S, E); }
        __syncthreads(); MARK(19);
        { Gemm g{WSP(bf16_t, WS_YHG), WSP(bf16_t, WS_WBH), MR, DM, 1024}; StaticOrder S; S.init(MR, DM, F.G, bid);
          EpiBranch<1> E{WSP(bf16_t, WS_PROJ), PW, PC_GH, WSP(bf16_t, WS_T1), WSP(bf16_t, WS_MRG)};
          gemm_phase<EpiBranch<1>, StaticOrder, false, true>(F.lds, g, S, E); }
    PEND(7)
    PBEG(8)
        Gemm g{WSP(bf16_t, WS_MRG), WSP(bf16_t, WS_WOUT), MR, DM, DM}; StaticOrder S; S.init(MR, DM, F.G, bid);
        const StatTbl st = fill_stats(F, S, WSP(float, WS_ST1), nullptr);
        EpiResid<1> E{nullptr, WSP(bf16_t, WS_Z1B), st, F.in[5], F.in[6], WSP(bf16_t, WS_Z2B), nullptr, WSP(float, WS_ST2), 1.0f};
        gemm_phase<EpiResid<1>, StaticOrder, false, true>(F.lds, g, S, E);
    PEND(8)
    PBEG(9)
        Gemm g{WSP(bf16_t, WS_Z2B), WSP(bf16_t, WS_WGU2), MR, NGU, DM}; StaticOrder S; S.init(MR, NGU, F.G, bid);
        const StatTbl st = fill_stats(F, S, WSP(float, WS_ST2), nullptr);
        EpiSwiGLU<true> E{WSP(bf16_t, WS_G2), DFF, st, WSP(float, WS_CSV) + PW, WSP(float, WS_BWV) + PW};
        gemm_phase<EpiSwiGLU<true>, StaticOrder, true, true>(F.lds, g, S, E);
    PEND(9)
    PBEG(10)
        Gemm g{WSP(bf16_t, WS_G2), WSP(bf16_t, WS_WD2), MR, DM, DFF}; StaticOrder S; S.init(MR, DM, F.G, bid);
        const StatTbl st = fill_stats(F, S, WSP(float, WS_ST2), nullptr);
        EpiResid<2> E{nullptr, WSP(bf16_t, WS_Z2B), st, F.in[15], F.in[16], nullptr, F.out, WSP(float, WS_ST3), 0.5f};
        gemm_phase<EpiResid<2>, StaticOrder, false, true>(F.lds, g, S, E);
    PEND(10)
    if (IN(11)) { p11_final_ln(F); }
#ifdef TS_A0
    if (blockIdx.x == 0 && F.tid == 0) {
        const unsigned long long now = __builtin_amdgcn_s_memrealtime(); ts[12] = now;
        unsigned long long qa = (ts[TS_A1] - ts[TS_A0]) / TS_UNIT, qb = (ts[TS_B1] - ts[TS_B0]) / TS_UNIT; if (qa > 99) qa = 99; if (qb > 99) qb = 99;
        const unsigned long long target = now + 2000ull * (100ull * qa + qb);
        while (__builtin_amdgcn_s_memrealtime() < target) __builtin_amdgcn_s_sleep(32);
    }
#endif
#undef IN
#undef SEAM
}

#ifndef MK_CUTS
#define MK_CUTS {0, NPH}
#endif
extern "C" void kernel_launch(void* const* d_in, const int* in_sizes, int n_in, void* d_out, int out_size, void* d_ws, size_t ws_size, hipStream_t stream) {
    static int grid = 0;
    if (grid == 0) {
        if (n_in != 22 || out_size != MR * DM || ws_size < WS_END) { fprintf(stderr, "kernel_launch: unexpected shapes (n_in %d, out %d, ws %zu < %zu)\n", n_in, out_size, ws_size, (size_t)WS_END); grid = -1; return; }
        int dev = 0, cus = 0, per_cu = 0;
        if (hipGetDevice(&dev) != hipSuccess || hipDeviceGetAttribute(&cus, hipDeviceAttributeMultiprocessorCount, dev) != hipSuccess) { grid = -1; return; }
        if (hipFuncSetAttribute((const void*)mk_fwd, hipFuncAttributeMaxDynamicSharedMemorySize, LDS_BYTES) != hipSuccess) { fprintf(stderr, "kernel_launch: hipFuncSetAttribute failed\n"); grid = -1; return; }
        if (hipOccupancyMaxActiveBlocksPerMultiprocessor(&per_cu, (const void*)mk_fwd, 512, LDS_BYTES) != hipSuccess || per_cu < 1) { fprintf(stderr, "kernel_launch: occupancy query says %d blocks per CU\n", per_cu); grid = -1; (void)hipGetLastError(); return; }
        grid = cus;
        if (grid != 256) fprintf(stderr, "kernel_launch: %d CUs; the one-unit-per-workgroup GEMM phases assume 256\n", grid);
    }
    if (grid < 0) return;
    (void)hipMemsetAsync((char*)d_ws + WS_CTL, 0, CTL_BYTES, stream);
    Args a{};
    for (int i = 0; i < 22; ++i) a.in[i] = (const float*)d_in[i];
    a.out = (float*)d_out; a.ws = (unsigned char*)d_ws;
    const int cuts[] = MK_CUTS; const int nl = (int)(sizeof(cuts) / sizeof(int)) - 1;
    for (int li = 0; li < nl; ++li) {
        a.ph_lo = cuts[li]; a.ph_hi = cuts[li + 1]; a.li = li; a.pad = 0;
        void* kargs[] = {&a};
        const hipError_t e = hipLaunchCooperativeKernel((const void*)mk_fwd, dim3(grid), dim3(512), kargs, LDS_BYTES, stream);
        if (e != hipSuccess) { fprintf(stderr, "kernel_launch: cooperative launch %d failed: %s\n", li, hipGetErrorString(e)); break; }
    }
}
```

```cpp
#include <hip/hip_runtime.h>
#include <cstdio>
#include <cstdint>
namespace pg8 {
#define PG8_LAS __attribute__((address_space(3)))
typedef unsigned short bf16_t;
typedef short bf16x8 __attribute__((ext_vector_type(8)));
typedef float f32x4 __attribute__((ext_vector_type(4)));
typedef unsigned u32x4 __attribute__((ext_vector_type(4)));
constexpr int BM = 256, BK = 64, HALF = 128, HTB = HALF * BK * 2  , STAGE_BYTES = 8 * HTB, NXCD = 8, WGM = 8;

__host__ __device__ __forceinline__ int lds_byte(int r, int c) { const int st = (r >> 4) * 2 + (c >> 5), rr = r & 15, cc = c & 31, ob = rr * 64 + cc * 2; return st * 1024 + (ob ^ (((ob >> 9) & 1) << 5)); }
__host__ __device__ __forceinline__ void stage_rc(int b, int& R, int& C) { const int st = b / 1024, sb = b % 1024, swz = sb ^ (((sb >> 9) & 1) << 5); R = (st >> 1) * 16 + swz / 64; C = (st & 1) * 32 + (swz % 64) / 2; }
__host__ __device__ __forceinline__ int perm32(int rho) { const int n = rho >> 4, i = rho & 15; return 8 * (i >> 2) + 4 * n + (i & 3); }

struct Unit { int pm, pn; };
struct Gemm { const bf16_t* A; const bf16_t* Bt; int M, N, K; };

struct StaticOrder {
    int nM, nN, nwg, G, c;
    __host__ __device__ void init(int M, int N, int G_, int c_) { nM = M / BM; nN = N / BM; nwg = nM * nN; G = G_; c = c_; }
    __host__ __device__ bool next(int i, Unit& u) const {
        const long L = (long)i * G + c; if (L >= nwg) return false;
        int wgid = (int)L; { const int q = nwg / NXCD, r = nwg % NXCD, xcd = wgid % NXCD, off = wgid / NXCD; wgid = (xcd < r ? xcd * (q + 1) : r * (q + 1) + (xcd - r) * q) + off; }
        const int nig = WGM * nN, gid = wgid / nig, fm = gid * WGM, gsz = (nM - fm) < WGM ? (nM - fm) : WGM;
        u.pm = fm + ((wgid % nig) % gsz); u.pn = (wgid % nig) / gsz; return true;
    }
    __device__ __forceinline__ void a_ready(const Unit&) const {}
    __device__ __forceinline__ void done(const Unit&) const {}
};

__device__ __forceinline__ unsigned cvt_pk_bf16(float lo, float hi) { unsigned r; asm volatile("v_cvt_pk_bf16_f32 %0, %1, %2" : "=v"(r) : "v"(lo), "v"(hi)); return r; }
typedef float f32x2 __attribute__((ext_vector_type(2)));
typedef unsigned u32x2 __attribute__((ext_vector_type(2)));
__device__ __forceinline__ float bflo(unsigned w) { return __uint_as_float(w << 16); }
__device__ __forceinline__ float bfhi(unsigned w) { return __uint_as_float(w & 0xffff0000u); }
__device__ __forceinline__ float sigm(float x) { return __builtin_amdgcn_rcpf(1.f + __expf(-x)); }
__device__ __forceinline__ float silu(float x) { return x * sigm(x); }
__device__ __forceinline__ void row_stats(const float* slab, int row, float& mu, float& rstd) {
    const f32x4* p = (const f32x4*)(slab + (size_t)row * 16);
    const f32x4 a = p[0], b = p[1], c = p[2], d = p[3];
    const float s = ((a[0] + a[2]) + (b[0] + b[2])) + ((c[0] + c[2]) + (d[0] + d[2]));
    const float q = ((a[1] + a[3]) + (b[1] + b[3])) + ((c[1] + c[3]) + (d[1] + d[3]));
    mu = s * (1.0f / 2048.0f);
    const float var = fmaxf(q * (1.0f / 2048.0f) - mu * mu, 0.f);
    rstd = __builtin_amdgcn_rsqf(var + 1e-5f);
}
struct StatTbl { const PG8_LAS int* slot; const PG8_LAS float* tbl;
    __device__ __forceinline__ void get(int pm, int lr, float& mu, float& rs) const { const int sl = slot[pm]; const PG8_LAS float* p = tbl + (sl * 256 + lr) * 2; mu = p[0]; rs = p[1]; } };
template <bool LNF> struct EpiSwiGLU {
    static constexpr bool PERM = true, AFTER_DRAIN = false;
    bf16_t* O; int ldc; StatTbl st; const float* cs; const float* bw;
    __device__ __forceinline__ void operator()(const f32x4 (&acc)[2][2][4][2], const Unit& u, int wr, int wc, int fr, int fq) const {
        const int row0 = u.pm * BM + wr * 64 + fr;
        const int ocol = u.pn * 128 + wc * 32 + 8 * fq;
        const int brow = u.pn * BM + wc * 32 + 8 * fq;
        f32x4 csg[2], csu[2], bwg[2], bwu[2];
        float mu[8], rs[8];
#pragma unroll
        for (int n = 0; n < 2; ++n) {
            if (LNF) { csg[n] = *(const f32x4*)(cs + brow + 4 * n); csu[n] = *(const f32x4*)(cs + brow + 128 + 4 * n); bwg[n] = *(const f32x4*)(bw + brow + 4 * n); bwu[n] = *(const f32x4*)(bw + brow + 128 + 4 * n); }
            else { csg[n] = csu[n] = bwg[n] = bwu[n] = (f32x4){0.f, 0.f, 0.f, 0.f}; }
        }
#pragma unroll
        for (int g = 0; g < 8; ++g) { mu[g] = 0.f; rs[g] = 1.f; if (LNF) st.get(u.pm, (g >> 2) * HALF + wr * 64 + (g & 3) * 16 + fr, mu[g], rs[g]); }
#pragma unroll
        for (int ai = 0; ai < 2; ++ai)
#pragma unroll
            for (int m = 0; m < 4; ++m) {
                const int row = row0 + ai * HALF + m * 16; const float mu_ = mu[ai * 4 + m], rs_ = rs[ai * 4 + m];
                u32x4 w;
#pragma unroll
                for (int n = 0; n < 2; ++n) {
                    f32x4 g = acc[ai][0][m][n], up = acc[ai][1][m][n];
                    if (LNF) { g = (g - mu_ * csg[n]) * rs_ + bwg[n]; up = (up - mu_ * csu[n]) * rs_ + bwu[n]; }
                    const float o0 = silu(g[0]) * up[0], o1 = silu(g[1]) * up[1], o2 = silu(g[2]) * up[2], o3 = silu(g[3]) * up[3];
                    w[2 * n] = cvt_pk_bf16(o0, o1); w[2 * n + 1] = cvt_pk_bf16(o2, o3);
                }
                *(u32x4*)(O + (size_t)row * ldc + ocol) = w;
            }
    }
};
struct EpiProj {
    static constexpr bool PERM = true, AFTER_DRAIN = false;
    bf16_t* O; int ldc; StatTbl st; const float* cs; const float* bw;
    __device__ __forceinline__ void operator()(const f32x4 (&acc)[2][2][4][2], const Unit& u, int wr, int wc, int fr, int fq) const {
        const int col0 = u.pn * BM + wc * 32 + 8 * fq;
        f32x4 cv[2][2], bv[2][2];
        float mu[8], rs[8];
#pragma unroll
        for (int bj = 0; bj < 2; ++bj)
#pragma unroll
            for (int n = 0; n < 2; ++n) { cv[bj][n] = *(const f32x4*)(cs + col0 + bj * HALF + 4 * n); bv[bj][n] = *(const f32x4*)(bw + col0 + bj * HALF + 4 * n); }
#pragma unroll
        for (int g = 0; g < 8; ++g) st.get(u.pm, (g >> 2) * HALF + wr * 64 + (g & 3) * 16 + fr, mu[g], rs[g]);
#pragma unroll
        for (int ai = 0; ai < 2; ++ai)
#pragma unroll
            for (int m = 0; m < 4; ++m) {
                const int lr = ai * HALF + wr * 64 + m * 16 + fr, row = u.pm * BM + lr; const float mu_ = mu[ai * 4 + m], rs_ = rs[ai * 4 + m];
#pragma unroll
                for (int bj = 0; bj < 2; ++bj) {
                    const f32x4 v0 = (acc[ai][bj][m][0] - mu_ * cv[bj][0]) * rs_ + bv[bj][0], v1 = (acc[ai][bj][m][1] - mu_ * cv[bj][1]) * rs_ + bv[bj][1];
                    u32x4 w; w.x = cvt_pk_bf16(v0[0], v0[1]); w.y = cvt_pk_bf16(v0[2], v0[3]); w.z = cvt_pk_bf16(v1[0], v1[1]); w.w = cvt_pk_bf16(v1[2], v1[3]);
                    *(u32x4*)(O + (size_t)row * ldc + col0 + bj * HALF) = w;
                }
            }
    }
};
template <int MODE> struct EpiResid {
    static constexpr bool PERM = false, AFTER_DRAIN = true;
    const float* xres; const bf16_t* zprev; StatTbl st; const float* lg; const float* lb; bf16_t* zb; float* zf; float* oslab; float sc;
    struct Pre { f32x4 x[4]; u32x2 z[4]; };
    __device__ __forceinline__ void load(Pre& P, int row, int col0) const {
#pragma unroll
        for (int q = 0; q < 4; ++q) { const size_t off = (size_t)row * 2048 + col0 + (q >> 1) * HALF + (q & 1) * 16;
            if (MODE == 0) P.x[q] = *(const f32x4*)(xres + off); else P.z[q] = *(const u32x2*)(zprev + off); }
    }
    __device__ __forceinline__ void fused(f32x4 (&acc)[2][2][4][2], const Unit& u, int wr, int wc, int fr, int fq, PG8_LAS unsigned char* lds, int wid, int lane) const {
        const float alpha = 1.18920711500272f;
        const int col0 = u.pn * BM + wc * 32 + 4 * fq;
        PG8_LAS float* P = (PG8_LAS float*)lds;
        f32x4 gv[4], bv[4]; float mu[8], rs[8];
#pragma unroll
        for (int q = 0; q < 4; ++q) { if (MODE != 0) { gv[q] = *(const f32x4*)(lg + col0 + (q >> 1) * HALF + (q & 1) * 16); bv[q] = *(const f32x4*)(lb + col0 + (q >> 1) * HALF + (q & 1) * 16); } else { gv[q] = bv[q] = (f32x4){0.f, 0.f, 0.f, 0.f}; } }
#pragma unroll
        for (int g = 0; g < 8; ++g) { mu[g] = 0.f; rs[g] = 1.f; if (MODE != 0) st.get(u.pm, (g >> 2) * HALF + wr * 64 + (g & 3) * 16 + fr, mu[g], rs[g]); }
        Pre cur, nxt;
        load(cur, u.pm * BM + wr * 64 + fr, col0);
#pragma unroll
        for (int g = 0; g < 8; ++g) {
            const int ai = g >> 2, m = g & 3;
            const int lr = ai * HALF + wr * 64 + m * 16 + fr, row = u.pm * BM + lr;
            if (g < 7) load(nxt, u.pm * BM + ((g + 1) >> 2) * HALF + wr * 64 + ((g + 1) & 3) * 16 + fr, col0);
            float s1 = 0.f, s2 = 0.f;
#pragma unroll
            for (int q = 0; q < 4; ++q) {
                const int bj = q >> 1, n = q & 1; const size_t off = (size_t)row * 2048 + col0 + bj * HALF + n * 16;
                f32x4 res;
                if (MODE == 0) res = cur.x[q];
                else { const u32x2 zz = cur.z[q]; const f32x4 zv = (f32x4){bflo(zz.x), bfhi(zz.x), bflo(zz.y), bfhi(zz.y)}; res = (zv - mu[g]) * rs[g] * gv[q] + bv[q]; }
                const f32x4 z = alpha * res + sc * acc[ai][bj][m][n];
                s1 += (z[0] + z[1]) + (z[2] + z[3]); s2 += (z[0] * z[0] + z[1] * z[1]) + (z[2] * z[2] + z[3] * z[3]);
                if (MODE == 2) *(f32x4*)(zf + off) = z;
                else { u32x2 w; w.x = cvt_pk_bf16(z[0], z[1]); w.y = cvt_pk_bf16(z[2], z[3]); *(u32x2*)(zb + off) = w; }
            }
            s1 += __shfl_xor(s1, 16); s1 += __shfl_xor(s1, 32); s2 += __shfl_xor(s2, 16); s2 += __shfl_xor(s2, 32);
            if (fq == 0) { P[(lr * 4 + wc) * 2] = s1; P[(lr * 4 + wc) * 2 + 1] = s2; }
            cur = nxt;
        }
        __syncthreads();
        const int tid = wid * 64 + lane;
        if (tid < 256) {
            const PG8_LAS float* p = P + tid * 8;
            const float a = (p[0] + p[2]) + (p[4] + p[6]), b = (p[1] + p[3]) + (p[5] + p[7]);
            float* o = oslab + ((size_t)(u.pm * BM + tid) * 8 + u.pn) * 2; o[0] = a; o[1] = b;
        }
    }
};
template <int SECOND> struct EpiBranch {
    static constexpr bool PERM = true, AFTER_DRAIN = false;
    const bf16_t* proj; int ldp, gcol; bf16_t* t1; bf16_t* out;
    struct Pre { u32x4 g[2], t[2]; };
    __device__ __forceinline__ void load(Pre& P, int row, int col0) const {
#pragma unroll
        for (int bj = 0; bj < 2; ++bj) { P.g[bj] = *(const u32x4*)(proj + (size_t)row * ldp + gcol + col0 + bj * HALF); if (SECOND) P.t[bj] = *(const u32x4*)(t1 + (size_t)row * 2048 + col0 + bj * HALF); else P.t[bj] = (u32x4){0u, 0u, 0u, 0u}; }
    }
    __device__ __forceinline__ void operator()(const f32x4 (&acc)[2][2][4][2], const Unit& u, int wr, int wc, int fr, int fq) const {
        const int col0 = u.pn * BM + wc * 32 + 8 * fq, row0 = u.pm * BM + wr * 64 + fr;
        Pre cur, nxt;
        load(cur, row0, col0);
#pragma unroll
        for (int g = 0; g < 8; ++g) {
            const int ai = g >> 2, m = g & 3, row = row0 + ai * HALF + m * 16;
            if (g < 7) load(nxt, row0 + ((g + 1) >> 2) * HALF + ((g + 1) & 3) * 16, col0);
#pragma unroll
            for (int bj = 0; bj < 2; ++bj) {
                const u32x4 gz = cur.g[bj], tz = cur.t[bj];
                const f32x4 a0 = acc[ai][bj][m][0], a1 = acc[ai][bj][m][1];
                const float v0 = bflo(tz.x) + sigm(bflo(gz.x)) * a0[0], v1 = bfhi(tz.x) + sigm(bfhi(gz.x)) * a0[1], v2 = bflo(tz.y) + sigm(bflo(gz.y)) * a0[2], v3 = bfhi(tz.y) + sigm(bfhi(gz.y)) * a0[3];
                const float v4 = bflo(tz.z) + sigm(bflo(gz.z)) * a1[0], v5 = bfhi(tz.z) + sigm(bfhi(gz.z)) * a1[1], v6 = bflo(tz.w) + sigm(bflo(gz.w)) * a1[2], v7 = bfhi(tz.w) + sigm(bfhi(gz.w)) * a1[3];
                u32x4 w; w.x = cvt_pk_bf16(v0, v1); w.y = cvt_pk_bf16(v2, v3); w.z = cvt_pk_bf16(v4, v5); w.w = cvt_pk_bf16(v6, v7);
                *(u32x4*)((SECOND ? out : t1) + (size_t)row * 2048 + col0 + bj * HALF) = w;
            }
            cur = nxt;
        }
    }
};

template <class Epi, class Sched, bool ALIGN_EPI = false, bool SP2 = false>
__device__ __forceinline__ void gemm_phase(PG8_LAS unsigned char* lds, const Gemm g, const Sched& S, const Epi& E) {
    const int tid = threadIdx.x, wid = __builtin_amdgcn_readfirstlane(tid >> 6), lane = tid & 63, wr = wid >> 2, wc = wid & 3, fr = lane & 15, fq = lane >> 4;
    const int K = g.K, nt = K / BK;
    unsigned voffA[2], voffB[2];
#pragma unroll
    for (int i = 0; i < 2; ++i) { int R, C; stage_rc(tid * 16 + i * 8192, R, C); const int Rb = Epi::PERM ? ((R & ~31) + perm32(R & 31)) : R;
        voffA[i] = (unsigned)(R * K + C) * 2u; voffB[i] = (unsigned)(Rb * K + C) * 2u; }
    const size_t kstep = (size_t)(BK * 2);
    const size_t hstep = (size_t)HALF * K * 2;
    const size_t tstep = 2 * hstep;
    const unsigned ldsw = (unsigned)wid * 1024u;
    const int aoff = lds_byte(wr * 64 + fr, fq * 8), boff = lds_byte(wc * 32 + fr, fq * 8);
#define PG8_SA(b, h) (((b) * 2 + (h)) * HTB)
#define PG8_SB(b, h) ((4 + (b) * 2 + (h)) * HTB)
#define PG8_STAGE(bufoff, gbase, voff) do { _Pragma("unroll") for (int _i = 0; _i < 2; ++_i) \
        __builtin_amdgcn_global_load_lds((const unsigned*)((const char*)(gbase) + (voff)[_i]), (PG8_LAS unsigned*)(lds + (bufoff) + ldsw + _i * 8192), 16, 0, 0); } while (0)
#define PG8_LDA(dst, b, h) do { _Pragma("unroll") for (int m = 0; m < 4; ++m) _Pragma("unroll") for (int k = 0; k < 2; ++k) dst[m][k] = *(const PG8_LAS bf16x8*)(lds + PG8_SA(b, h) + aoff + m * 2048 + k * 1024); } while (0)
#define PG8_LDB(dst, b, h) do { _Pragma("unroll") for (int n = 0; n < 2; ++n) _Pragma("unroll") for (int k = 0; k < 2; ++k) dst[n][k] = *(const PG8_LAS bf16x8*)(lds + PG8_SB(b, h) + boff + n * 2048 + k * 1024); } while (0)
#define PG8_MMA(ai, bj, At, Bt) do { __builtin_amdgcn_s_setprio(1); _Pragma("unroll") for (int m = 0; m < 4; ++m) _Pragma("unroll") for (int n = 0; n < 2; ++n) _Pragma("unroll") for (int k = 0; k < 2; ++k) \
        acc[ai][bj][m][n] = __builtin_amdgcn_mfma_f32_16x16x32_bf16(Bt[n][k], At[m][k], acc[ai][bj][m][n], 0, 0, 0); __builtin_amdgcn_s_setprio(0); } while (0)
#define PG8_WAIT_V(n) asm volatile("s_waitcnt vmcnt(" #n ")" ::: "memory")
#define PG8_WAIT_L(n) asm volatile("s_waitcnt lgkmcnt(" #n ")" ::: "memory")
#define PG8_BAR __builtin_amdgcn_s_barrier()
#define PG8_SCHED __builtin_amdgcn_sched_barrier(0)
    Unit cur, nxt; int ui = 0;
    if (!S.next(0, cur)) return;
    f32x4 acc[2][2][4][2];
#pragma unroll
    for (int a = 0; a < 2; ++a)
#pragma unroll
        for (int b = 0; b < 2; ++b)
#pragma unroll
            for (int m = 0; m < 4; ++m)
#pragma unroll
                for (int n = 0; n < 2; ++n) acc[a][b][m][n] = (f32x4){0.f, 0.f, 0.f, 0.f};
    bf16x8 At[4][2], B0[2][2], B1[2][2];
    const char* cA = (const char*)g.A + (size_t)cur.pm * tstep; const char* cB = (const char*)g.Bt + (size_t)cur.pn * tstep;
    S.a_ready(cur);
    if constexpr (SP2) {
        PG8_STAGE(PG8_SB(0, 0), cB, voffB); PG8_STAGE(PG8_SB(0, 1), cB + hstep, voffB); PG8_STAGE(PG8_SA(0, 0), cA, voffA); PG8_STAGE(PG8_SA(0, 1), cA + hstep, voffA);
        if (wr == 1) PG8_BAR;
        PG8_WAIT_V(2); PG8_BAR;
        PG8_STAGE(PG8_SB(1, 0), cB + kstep, voffB); PG8_STAGE(PG8_SA(1, 0), cA + kstep, voffA); PG8_STAGE(PG8_SB(1, 1), cB + hstep + kstep, voffB);
        PG8_WAIT_V(6); PG8_BAR;
    } else {
        PG8_STAGE(PG8_SB(0, 0), cB, voffB); PG8_STAGE(PG8_SA(0, 0), cA, voffA); PG8_STAGE(PG8_SB(0, 1), cB + hstep, voffB); PG8_STAGE(PG8_SA(0, 1), cA + hstep, voffA);
        if (wr == 1) PG8_BAR;
        PG8_WAIT_V(4); PG8_BAR;
        PG8_STAGE(PG8_SB(1, 0), cB + kstep, voffB); PG8_STAGE(PG8_SA(1, 0), cA + kstep, voffA); PG8_STAGE(PG8_SB(1, 1), cB + hstep + kstep, voffB);
        PG8_WAIT_V(6); PG8_BAR;
    }
    for (;;) {
        const bool has_next = S.next(ui + 1, nxt);
        const char* nA = has_next ? (const char*)g.A + (size_t)nxt.pm * tstep : cA; const char* nB = has_next ? (const char*)g.Bt + (size_t)nxt.pn * tstep : cB;
        for (int t = 0; t < nt; t += 2) {
            const bool last = (t == nt - 2);
            const char* a1 = cA + (size_t)(t + 1) * kstep;
            const char* a2 = last ? nA : cA + (size_t)(t + 2) * kstep; const char* b2 = last ? nB : cB + (size_t)(t + 2) * kstep;
            const char* a3 = a2 + kstep; const char* b3 = b2 + kstep;
            if (last && has_next) S.a_ready(nxt);
            if constexpr (SP2) {
            PG8_LDB(B0, 0, 0); PG8_LDB(B1, 0, 1); PG8_SCHED; PG8_LDA(At, 0, 0); PG8_STAGE(PG8_SA(1, 1), a1 + hstep, voffA);
            PG8_WAIT_V(8); PG8_WAIT_L(0); PG8_BAR; PG8_MMA(0, 0, At, B0); PG8_MMA(0, 1, At, B1); PG8_BAR; PG8_SCHED;
            PG8_LDA(At, 0, 1); PG8_STAGE(PG8_SB(0, 0), b2, voffB); PG8_STAGE(PG8_SB(0, 1), b2 + hstep, voffB); PG8_STAGE(PG8_SA(0, 0), a2, voffA);
            PG8_WAIT_V(8); PG8_WAIT_L(0); PG8_BAR; PG8_MMA(1, 0, At, B0); PG8_MMA(1, 1, At, B1); PG8_BAR; PG8_SCHED;
            PG8_LDB(B0, 1, 0); PG8_LDB(B1, 1, 1); PG8_SCHED; PG8_LDA(At, 1, 0); PG8_STAGE(PG8_SA(0, 1), a2 + hstep, voffA);
            PG8_WAIT_V(8); PG8_WAIT_L(0); PG8_BAR; PG8_MMA(0, 0, At, B0); PG8_MMA(0, 1, At, B1); PG8_BAR; PG8_SCHED;
            PG8_LDA(At, 1, 1); PG8_STAGE(PG8_SB(1, 0), b3, voffB); PG8_STAGE(PG8_SB(1, 1), b3 + hstep, voffB); PG8_STAGE(PG8_SA(1, 0), a3, voffA);
            PG8_WAIT_V(8); PG8_WAIT_L(0); PG8_BAR; PG8_MMA(1, 0, At, B0); PG8_MMA(1, 1, At, B1); PG8_BAR; PG8_SCHED;
            } else {
            PG8_LDB(B0, 0, 0); PG8_SCHED; PG8_LDA(At, 0, 0); PG8_STAGE(PG8_SA(1, 1), a1 + hstep, voffA);
            PG8_WAIT_L(8); PG8_BAR; PG8_WAIT_L(0); PG8_MMA(0, 0, At, B0); PG8_BAR; PG8_SCHED;
            PG8_LDB(B1, 0, 1); PG8_STAGE(PG8_SB(0, 0), b2, voffB);
            PG8_BAR; PG8_WAIT_L(0); PG8_MMA(0, 1, At, B1); PG8_BAR;
            PG8_LDA(At, 0, 1); PG8_STAGE(PG8_SA(0, 0), a2, voffA);
            PG8_BAR; PG8_WAIT_L(0); PG8_MMA(1, 0, At, B0); PG8_BAR; PG8_SCHED;
            PG8_STAGE(PG8_SB(0, 1), b2 + hstep, voffB);
            PG8_WAIT_V(6); PG8_BAR; PG8_MMA(1, 1, At, B1); PG8_BAR;
            PG8_LDB(B0, 1, 0); PG8_SCHED; PG8_LDA(At, 1, 0); PG8_STAGE(PG8_SA(0, 1), a2 + hstep, voffA);
            PG8_WAIT_L(8); PG8_BAR; PG8_WAIT_L(0); PG8_MMA(0, 0, At, B0); PG8_BAR; PG8_SCHED;
            PG8_LDB(B1, 1, 1); PG8_STAGE(PG8_SB(1, 0), b3, voffB);
            PG8_BAR; PG8_WAIT_L(0); PG8_MMA(0, 1, At, B1); PG8_BAR;
            PG8_LDA(At, 1, 1); PG8_STAGE(PG8_SA(1, 0), a3, voffA);
            PG8_BAR; PG8_WAIT_L(0); PG8_MMA(1, 0, At, B0); PG8_BAR; PG8_SCHED;
            PG8_STAGE(PG8_SB(1, 1), b3 + hstep, voffB);
            PG8_WAIT_V(6); PG8_BAR; PG8_MMA(1, 1, At, B1); PG8_BAR;
            }
        }
        if constexpr (ALIGN_EPI) { if (wr == 0) PG8_BAR; }
        if constexpr (!Epi::AFTER_DRAIN) { E(acc, cur, wr, wc, fr, fq); S.done(cur); }
        if (!has_next) break;
#pragma unroll
        for (int a = 0; a < 2; ++a)
#pragma unroll
            for (int b = 0; b < 2; ++b)
#pragma unroll
                for (int m = 0; m < 4; ++m)
#pragma unroll
                    for (int n = 0; n < 2; ++n) acc[a][b][m][n] = (f32x4){0.f, 0.f, 0.f, 0.f};
        cur = nxt; cA = nA; cB = nB; ++ui;
        if constexpr (ALIGN_EPI) { if (wr == 1) PG8_BAR; }
    }
    PG8_WAIT_V(0);
    if constexpr (!ALIGN_EPI) { if (wr == 0) PG8_BAR; }
    PG8_BAR;
    if constexpr (Epi::AFTER_DRAIN) { E.fused(acc, cur, wr, wc, fr, fq, lds, wid, lane); S.done(cur); }
#undef PG8_SA
#undef PG8_SB
#undef PG8_STAGE
#undef PG8_LDA
#undef PG8_LDB
#undef PG8_MMA
#undef PG8_WAIT_V
#undef PG8_WAIT_L
#undef PG8_BAR
#undef PG8_SCHED
}
}
using namespace pg8;
#define LAS __attribute__((address_space(3)))
typedef short s16x4 __attribute__((ext_vector_type(4)));
typedef float f32x16 __attribute__((ext_vector_type(16)));
typedef float f32x2 __attribute__((ext_vector_type(2)));
#define MFMA32(a, b, c) __builtin_amdgcn_mfma_f32_32x32x16_bf16((a), (b), (c), 0, 0, 0)
#define MFMA16(a, b, c) __builtin_amdgcn_mfma_f32_16x16x32_bf16((a), (b), (c), 0, 0, 0)
#define LDS_WAIT() asm volatile("s_waitcnt lgkmcnt(0)" ::: "memory")

constexpr int NBATCH = 2, SEQ = 4096, DM = 2048, NMETA = 16, MR = NBATCH * SEQ  , MPAD = 8448  , METAROW = 8192;
constexpr int DFF = 5632, NGU = 2 * DFF, PW = 11008  , NPROJ = 10832;
constexpr int PC_AQ = 0, PC_AK = 1024, PC_AV = 1280, PC_IQ = 1536, PC_HQ = 2560, PC_HF = 3584, PC_HI = 4608, PC_HG = 5632, PC_GA = 6656, PC_GH = 8704, PC_IK = 10752, PC_IW = 10816;
constexpr int NCS = PW + NGU;
constexpr size_t MiB = 1u << 20;
constexpr size_t WS_CTL = 0, CTL_BYTES = 1 * MiB;
constexpr size_t WS_PCS = 1 * MiB, WS_PBW = 4 * MiB, WS_CSV = 7 * MiB, WS_BWV = 7 * MiB + 131072, WS_Z1M = 7 * MiB + 262144, WS_ST1 = 8 * MiB, WS_ST2 = 9 * MiB, WS_ST3 = 10 * MiB;
constexpr size_t WS_WGU1 = 11 * MiB, WS_WD1 = 55 * MiB, WS_H0B = 77 * MiB, WS_G = 110 * MiB, WS_PROJ = 11 * MiB, WS_G2 = 11 * MiB;
constexpr size_t WS_WIN = 201 * MiB, WS_IKN = 201 * MiB, WS_SEL = 202 * MiB, WS_GCH = 206 * MiB, WS_YATT = 207 * MiB, WS_YHG = 223 * MiB;
constexpr size_t WS_WBA = 244 * MiB, WS_WBH = 248 * MiB, WS_WOUT = 252 * MiB, WS_WGU2 = 260 * MiB, WS_WD2 = 304 * MiB, WS_Z1B = 326 * MiB;
constexpr size_t WS_APART = 189 * MiB  , WS_APML = 198 * MiB;
static_assert(WS_PROJ + (size_t)MPAD * PW * 2 <= WS_APART && WS_APML + 128 * 512 * 4 <= WS_WIN, "attention partials gap");
constexpr size_t WS_QT = 359 * MiB, WS_OI = 375 * MiB, WS_LST = 407 * MiB, WS_T1 = 359 * MiB, WS_MRG = 391 * MiB, WS_Z2B = 359 * MiB, WS_END = 440 * MiB;
static_assert(WS_G + (size_t)MPAD * DFF * 2 <= WS_WIN && WS_PROJ + (size_t)MPAD * PW * 2 <= WS_WIN && WS_LST + (size_t)16 * 65 * 32768 <= WS_END && WS_ST1 + (size_t)MPAD * 64 <= WS_ST2, "ws map");
constexpr int CW_AFLAG = 8192;
constexpr int CW_Q1 = 1024, CW_Q3 = 1536;
constexpr int TR_I1 = 2 * 32 * 176, TR_I2 = 3 * 32 * 176 + 32 * 339, TR_I3 = 6 * 32 * 176 + 32 * 339 + 2 * 16 * 64 + 32 * 64;
constexpr int CW_Q6 = 2048;
constexpr int CW_BAR = 4096;
constexpr int RING_BYTES = 131072, MISC_OFF = 163840 - 256, WL_OFF = RING_BYTES + 512, STT_OFF = RING_BYTES + 1024, STT_TBL = STT_OFF + 256, LDS_BYTES = 163840;

typedef unsigned v4u __attribute__((ext_vector_type(4)));
__device__ __forceinline__ unsigned f2bf(float f) { unsigned u = __builtin_bit_cast(unsigned, f); return (u + 0x7fffu + ((u >> 16) & 1u)) >> 16; }
__device__ __forceinline__ unsigned pk2(float lo, float hi) { return f2bf(lo) | (f2bf(hi) << 16); }
__device__ __forceinline__ float bf2f(unsigned short h) { return __uint_as_float(((unsigned)h) << 16); }
__device__ __forceinline__ float bfround(float x) { return __uint_as_float(f2bf(x) << 16); }
__device__ __forceinline__ float wave_sum(float v) {
#pragma unroll
    for (int o = 1; o < 64; o <<= 1) v += __shfl_xor(v, o);
    return v;
}
__device__ __forceinline__ int crow(int reg, int h) { return (reg & 3) + 8 * (reg >> 2) + 4 * h; }

#define XB_TMO      128
#define XB_XCNT(j)  (256  + 64 * (j))
#define XB_XSUB(j)  (1280 + 64 * (j))
#define XB_XGEN(j)  (2304 + 64 * (j))
#define XB_TOP      3328
#define XB_TOPGEN   3392
#define XCD_BAR_WORDS 3456
#define XB_SPIN_CAP (1u << 18)

__device__ __forceinline__ unsigned xb_ld(unsigned* p)              { return __hip_atomic_load(p, __ATOMIC_RELAXED, __HIP_MEMORY_SCOPE_AGENT); }
__device__ __forceinline__ unsigned xb_add(unsigned* p, unsigned v) { return __hip_atomic_fetch_add(p, v, __ATOMIC_RELAXED, __HIP_MEMORY_SCOPE_AGENT); }
__device__ __forceinline__ unsigned xb_xcc_id() { return (unsigned)__builtin_amdgcn_s_getreg((3 << 11) | 20) & 0xFu; }
#define XB_SPIN(cond, bar) do { unsigned _sp = 0; while (cond) { __builtin_amdgcn_s_sleep(1); \
    if ((++_sp & 255u) == 0u) { if (xb_ld(&(bar)[XB_TMO])) break; if (_sp > XB_SPIN_CAP) { atomicAdd(&(bar)[XB_TMO], 1u); break; } } } } while (0)

struct XcdBarrier {
    unsigned* bar; unsigned x;
    volatile LAS unsigned* st;
};

__device__ __forceinline__ XcdBarrier xcd_barrier_post(unsigned* bar, volatile LAS unsigned* st) {
    XcdBarrier b; b.bar = bar; b.x = xb_xcc_id(); b.st = st;
    if (threadIdx.x == 0) (void)xb_add(&bar[XB_XCNT(b.x)], 1u);
    return b;
}
__device__ __forceinline__ void xcd_barrier_complete(unsigned* bar, unsigned x, unsigned& nloc, unsigned& nx) {
    const unsigned G = gridDim.x * gridDim.y * gridDim.z;
    unsigned sum, cnt, mine, sp = 0u;
    for (;;) {
        sum = 0u; cnt = 0u; mine = 0u;
#pragma unroll
        for (unsigned j = 0; j < 16; ++j) { const unsigned c = xb_ld(&bar[XB_XCNT(j)]); sum += c; cnt += (c > 0u) ? 1u : 0u; mine = (j == x) ? c : mine; }
        if (sum == G) break;
        __builtin_amdgcn_s_sleep(1);
        if ((++sp & 255u) == 0u) { if (xb_ld(&bar[XB_TMO])) break; if (sp > XB_SPIN_CAP) { atomicAdd(&bar[XB_TMO], 1u); break; } }
    }
    nloc = mine > 0u ? mine : 1u; nx = cnt > 0u ? cnt : 1u;
}

__device__ __forceinline__ void xcd_barrier(const XcdBarrier& b) {
    asm volatile("s_waitcnt vmcnt(0)" ::: "memory");
    __syncthreads();
    if (threadIdx.x == 0) {
        unsigned* bar = b.bar;
        __builtin_amdgcn_s_waitcnt(0);
        unsigned nloc = b.st[0], nx = b.st[1];
        if (nloc == 0u) { xcd_barrier_complete(bar, b.x, nloc, nx); b.st[0] = nloc; b.st[1] = nx; }
        const unsigned old = xb_add(&bar[XB_XSUB(b.x)], 1u);
        const unsigned gen = old / nloc;
        if (old + 1u == (gen + 1u) * nloc) {
            __builtin_amdgcn_fence(__ATOMIC_RELEASE, "agent");
            asm volatile("s_waitcnt vmcnt(0)" ::: "memory");
            const unsigned og = xb_add(&bar[XB_TOP], 1u);
            const unsigned tg = og / nx;
            if (og + 1u == (tg + 1u) * nx) xb_add(&bar[XB_TOPGEN], 1u);
            else XB_SPIN(xb_ld(&bar[XB_TOPGEN]) == tg, bar);
            __builtin_amdgcn_fence(__ATOMIC_ACQUIRE, "agent");
            xb_add(&bar[XB_XGEN(b.x)], 1u);
            asm volatile("s_waitcnt vmcnt(0)" ::: "memory");
        } else {
            XB_SPIN(xb_ld(&bar[XB_XGEN(b.x)]) == gen, bar);
            __builtin_amdgcn_fence(__ATOMIC_ACQUIRE, "agent");
            asm volatile("s_waitcnt vmcnt(0)" ::: "memory");
        }
    }
    __syncthreads();
}
struct Frame {
    LAS unsigned char* lds;
    int tid, lane, wave, G, gw, NGW;
    const float* in[22]; float* out; unsigned char* ws;
};
#define WSP(T, off) ((T*)(F.ws + (off)))

__device__ __forceinline__ int dst_row(int map, int n) {
    if (map == 1) return ((n >> 7) << 8) + (n & 127);
    if (map == 2) return ((n >> 7) << 8) + 128 + (n & 127);
    if (map == 3) return n < 2560 ? n : (n < 2640 ? n + 8192 : n - 80);
    return n;
}
struct TrJob { const float* W; bf16_t* WT; const float* g; const float* b; int K, N, map, pcol0, item; };
__device__ __forceinline__ bool tr_decode(Frame& F, int it, TrJob& J) {
    constexpr int I_GU = 32 * 176, I_DN = 88 * 64, I_IN = 32 * 339, I_BR = 16 * 64, I_OUT = 32 * 64;
    constexpr int NITEMS = 6 * I_GU + I_IN + 2 * I_BR + I_OUT;
    static_assert(I_DN == I_GU, "items");
    if (it >= NITEMS) return false;
    int r = it; J.g = nullptr; J.b = nullptr; J.pcol0 = 0; J.map = 0;
    if (r < I_GU) { J.W = F.in[2]; J.K = DM; J.N = DFF; J.WT = WSP(bf16_t, WS_WGU1); J.map = 1; J.item = r; return true; } r -= I_GU;
    if (r < I_GU) { J.W = F.in[3]; J.K = DM; J.N = DFF; J.WT = WSP(bf16_t, WS_WGU1); J.map = 2; J.item = r; return true; } r -= I_GU;
    if (r < I_DN) { J.W = F.in[4]; J.K = DFF; J.N = DM; J.WT = WSP(bf16_t, WS_WD1); J.item = r; return true; } r -= I_DN;
    if (r < I_IN) { J.W = F.in[7]; J.K = DM; J.N = NPROJ; J.WT = WSP(bf16_t, WS_WIN); J.map = 3; J.g = F.in[5]; J.b = F.in[6]; J.item = r; return true; } r -= I_IN;
    if (r < I_BR) { J.W = F.in[12]; J.K = 1024; J.N = DM; J.WT = WSP(bf16_t, WS_WBA); J.item = r; return true; } r -= I_BR;
    if (r < I_BR) { J.W = F.in[13]; J.K = 1024; J.N = DM; J.WT = WSP(bf16_t, WS_WBH); J.item = r; return true; } r -= I_BR;
    if (r < I_OUT) { J.W = F.in[14]; J.K = DM; J.N = DM; J.WT = WSP(bf16_t, WS_WOUT); J.item = r; return true; } r -= I_OUT;
    if (r < I_GU) { J.W = F.in[17]; J.K = DM; J.N = DFF; J.WT = WSP(bf16_t, WS_WGU2); J.map = 1; J.g = F.in[15]; J.b = F.in[16]; J.pcol0 = PW; J.item = r; return true; } r -= I_GU;
    if (r < I_GU) { J.W = F.in[18]; J.K = DM; J.N = DFF; J.WT = WSP(bf16_t, WS_WGU2); J.map = 2; J.g = F.in[15]; J.b = F.in[16]; J.pcol0 = PW; J.item = r; return true; } r -= I_GU;
    J.W = F.in[19]; J.K = DFF; J.N = DM; J.WT = WSP(bf16_t, WS_WD2); J.item = r; return true;
}
__device__ __forceinline__ void tr_load(const TrJob& J, int lane, f32x4 (&v)[8]) {
    const int nblk = (J.N + 31) >> 5, kb = J.item / nblk, nb = J.item - kb * nblk, k0 = 64 * kb, nn = 32 * nb + 4 * (lane & 7);
    const float* p = J.W + (size_t)(k0 + (lane >> 3)) * J.N + nn; const bool ok = nn < J.N;
#pragma unroll
    for (int i = 0; i < 8; ++i) v[i] = ok ? *(const f32x4*)(p + (size_t)(8 * i) * J.N) : (f32x4){0.f, 0.f, 0.f, 0.f};
}
__device__ __forceinline__ void tr_process(const TrJob& J, f32x4 (&v)[8], float* pcs, float* pbw, LAS float* scr, int lane) {
    const int nblk = (J.N + 31) >> 5, kb = J.item / nblk, nb = J.item - kb * nblk, k0 = 64 * kb, n0 = 32 * nb, nn = n0 + 4 * (lane & 7);
    if (J.g) {
        float cs[4] = {0.f, 0.f, 0.f, 0.f}, bw[4] = {0.f, 0.f, 0.f, 0.f};
#pragma unroll
        for (int i = 0; i < 8; ++i) { const int k = k0 + (lane >> 3) + 8 * i; const float gk = J.g[k], bk = J.b[k];
#pragma unroll
            for (int e = 0; e < 4; ++e) { bw[e] += bk * v[i][e]; v[i][e] *= gk; cs[e] += bfround(v[i][e]); } }
#pragma unroll
        for (int e = 0; e < 4; ++e) { cs[e] += __shfl_xor(cs[e], 8); cs[e] += __shfl_xor(cs[e], 16); cs[e] += __shfl_xor(cs[e], 32); bw[e] += __shfl_xor(bw[e], 8); bw[e] += __shfl_xor(bw[e], 16); bw[e] += __shfl_xor(bw[e], 32); }
        if (lane < 8 && nn < J.N) {
#pragma unroll
            for (int e = 0; e < 4; ++e) { const int d = J.pcol0 + dst_row(J.map, nn + e); pcs[(size_t)kb * NCS + d] = cs[e]; pbw[(size_t)kb * NCS + d] = bw[e]; } }
    }
#pragma unroll
    for (int i = 0; i < 8; ++i) { LAS float* q = scr + ((lane >> 3) + 8 * i) * 33 + 4 * (lane & 7); q[0] = v[i][0]; q[1] = v[i][1]; q[2] = v[i][2]; q[3] = v[i][3]; }
    LDS_WAIT(); asm volatile("" ::: "memory");
    const int c = lane & 7;
#pragma unroll
    for (int j = 0; j < 4; ++j) { const int n = (lane >> 3) + 8 * j; const LAS float* s = scr + (8 * c) * 33 + n;
        if (n0 + n < J.N) { v4u o; o.x = pk2(s[0 * 33], s[1 * 33]); o.y = pk2(s[2 * 33], s[3 * 33]); o.z = pk2(s[4 * 33], s[5 * 33]); o.w = pk2(s[6 * 33], s[7 * 33]);
            *(v4u*)(J.WT + (size_t)dst_row(J.map, n0 + n) * J.K + k0 + 8 * c) = o; } }
    LDS_WAIT(); asm volatile("" ::: "memory");
}
__device__ __forceinline__ void tr_run(Frame& F, int it0, int stride, int end, LAS float* scr, float* pcs, float* pbw) {
    TrJob j0, j1, j2; f32x4 v0[8], v1[8], v2[8];
    bool h0 = it0 < end && tr_decode(F, it0, j0);
    if (h0) tr_load(j0, F.lane, v0);
    bool h1 = it0 + stride < end && tr_decode(F, it0 + stride, j1);
    if (h1) tr_load(j1, F.lane, v1);
    for (int it = it0; h0; it += stride) {
        const bool h2 = it + 2 * stride < end && tr_decode(F, it + 2 * stride, j2);
        if (h2) tr_load(j2, F.lane, v2);
        tr_process(j0, v0, pcs, pbw, scr, F.lane);
        j0 = j1; h0 = h1; j1 = j2; h1 = h2;
#pragma unroll
        for (int i = 0; i < 8; ++i) { v0[i] = v1[i]; v1[i] = v2[i]; }
    }
}
__device__ __forceinline__ void tr_queue(Frame& F, unsigned* ctr, int lo, int hi) {
    LAS float* scr = (LAS float*)(F.lds + F.wave * 16384);
    volatile LAS int* qslot = (volatile LAS int*)(F.lds + MISC_OFF + 128);
    for (;;) {
        __syncthreads();
        if (F.tid == 0) qslot[0] = (int)__hip_atomic_fetch_add(ctr, 1u, __ATOMIC_RELAXED, __HIP_MEMORY_SCOPE_AGENT);
        __syncthreads();
        const int base = lo + 64 * qslot[0];
        if (base >= hi) break;
        const int end = base + 64 < hi ? base + 64 : hi;
        tr_run(F, base + F.wave, 8, end, scr, WSP(float, WS_PCS), WSP(float, WS_PBW));
    }
}
__device__ __forceinline__ void p0_prologue(Frame& F) {
    LAS float* scr = (LAS float*)(F.lds + F.wave * 16384);
    float* pcs = WSP(float, WS_PCS); float* pbw = WSP(float, WS_PBW);
    {
        tr_run(F, F.gw, F.NGW, 2 * 32 * 176, scr, pcs, pbw);
    }
    bf16_t* h0b = WSP(bf16_t, WS_H0B); bf16_t* z1b = WSP(bf16_t, WS_Z1B); bf16_t* wint = WSP(bf16_t, WS_WIN);
    for (int m = F.gw; m < MPAD + (PW - NPROJ); m += F.NGW) {
        if (m >= MPAD) { u32x2* o = (u32x2*)(wint + (size_t)(NPROJ + m - MPAD) * DM) + F.lane;
#pragma unroll
            for (int j = 0; j < 8; ++j) o[64 * j] = (u32x2){0u, 0u};
            continue; }
        const float* src = m < MR ? F.in[0] + (size_t)m * DM : (m < MR + NMETA ? F.in[1] + (size_t)(m - MR) * DM : nullptr);
        u32x2* o = (u32x2*)(h0b + (size_t)m * DM) + F.lane;
        f32x4 xv[8];
#pragma unroll
        for (int j = 0; j < 8; ++j) xv[j] = src ? ((const f32x4*)src)[F.lane + 64 * j] : (f32x4){0.f, 0.f, 0.f, 0.f};
#pragma unroll
        for (int j = 0; j < 8; ++j) { u32x2 w; w.x = pk2(xv[j][0], xv[j][1]); w.y = pk2(xv[j][2], xv[j][3]); o[64 * j] = w; }
        if (m >= MR + NMETA) { u32x2* oz = (u32x2*)(z1b + (size_t)m * DM) + F.lane;
#pragma unroll
            for (int j = 0; j < 8; ++j) oz[64 * j] = (u32x2){0u, 0u}; }
    }
}
__device__ __forceinline__ void p1_colsums(Frame& F, int c0, int c1) {
    const float* pcs = WSP(float, WS_PCS); const float* pbw = WSP(float, WS_PBW); float* csv = WSP(float, WS_CSV); float* bwv = WSP(float, WS_BWV);
    for (int i = c0 + blockIdx.x * 512 + F.tid; i < c1; i += F.G * 512) {
        float cs = 0.f, bw = 0.f;
        if (!(i >= NPROJ && i < PW)) {
#pragma unroll 8
            for (int kb = 0; kb < 32; ++kb) { cs += pcs[(size_t)kb * NCS + i]; bw += pbw[(size_t)kb * NCS + i]; } }
        csv[i] = cs; bwv[i] = bw;
    }
}
__device__ __forceinline__ void p2_meta_down(Frame& F) {
    const bf16_t* G = WSP(bf16_t, WS_G); const bf16_t* wd = WSP(bf16_t, WS_WD1); float* z1m = WSP(float, WS_Z1M); bf16_t* z1b = WSP(bf16_t, WS_Z1B);
    const int lane = F.lane;
    for (int c = F.gw; c < DM; c += F.NGW) {
        const bf16_t* wrow = wd + (size_t)c * DFF;
        float acc[16];
#pragma unroll
        for (int r = 0; r < 16; ++r) acc[r] = 0.f;
        for (int i = 0; i < 11; ++i) {
            const int k = 8 * lane + 512 * i;
            const v4u wv = *(const v4u*)(wrow + k);
            const float w0 = bflo(wv.x), w1 = bfhi(wv.x), w2 = bflo(wv.y), w3 = bfhi(wv.y), w4 = bflo(wv.z), w5 = bfhi(wv.z), w6 = bflo(wv.w), w7 = bfhi(wv.w);
#pragma unroll
            for (int r = 0; r < 16; ++r) { const v4u gv = *(const v4u*)(G + (size_t)(METAROW + r) * DFF + k);
                acc[r] += (bflo(gv.x) * w0 + bfhi(gv.x) * w1) + (bflo(gv.y) * w2 + bfhi(gv.y) * w3) + (bflo(gv.z) * w4 + bfhi(gv.z) * w5) + (bflo(gv.w) * w6 + bfhi(gv.w) * w7); }
        }
        float v8[8], v4[4], v2[2], v1;
#pragma unroll
        for (int i = 0; i < 8; ++i) { const bool hi = (lane & 32) != 0; const float send = hi ? acc[i] : acc[8 + i], keep = hi ? acc[8 + i] : acc[i]; v8[i] = keep + __shfl_xor(send, 32); }
#pragma unroll
        for (int i = 0; i < 4; ++i) { const bool hi = (lane & 16) != 0; const float send = hi ? v8[i] : v8[4 + i], keep = hi ? v8[4 + i] : v8[i]; v4[i] = keep + __shfl_xor(send, 16); }
#pragma unroll
        for (int i = 0; i < 2; ++i) { const bool hi = (lane & 8) != 0; const float send = hi ? v4[i] : v4[2 + i], keep = hi ? v4[2 + i] : v4[i]; v2[i] = keep + __shfl_xor(send, 8); }
        { const bool hi = (lane & 4) != 0; const float send = hi ? v2[0] : v2[1], keep = hi ? v2[1] : v2[0]; v1 = keep + __shfl_xor(send, 4); }
        v1 += __shfl_xor(v1, 1); v1 += __shfl_xor(v1, 2);
        const int r = ((lane >> 5) & 1) * 8 + ((lane >> 4) & 1) * 4 + ((lane >> 3) & 1) * 2 + ((lane >> 2) & 1);
        if ((lane & 3) == 0) { const float z = 1.18920711500272f * F.in[1][(size_t)r * DM + c] + 0.5f * v1; z1m[(size_t)r * DM + c] = z; z1b[(size_t)(METAROW + r) * DM + c] = (bf16_t)f2bf(z); }
    }
}
__device__ __forceinline__ StatTbl fill_stats(Frame& F, const StaticOrder& S, const float* slab, const float* z1m) {
    LAS int* slot = (LAS int*)(F.lds + STT_OFF); LAS float* tbl = (LAS float*)(F.lds + STT_TBL);
    if (F.tid < 64) slot[F.tid] = -1;
    __syncthreads();
    int ns = 0; Unit u;
    for (int i = 0; S.next(i, u); ++i) {
        const int have = slot[u.pm];
        __syncthreads();
        if (have < 0) {
            if (F.tid == 0) slot[u.pm] = ns;
            if (u.pm == 32) {
                if (F.tid < 256) { tbl[(ns * 256 + F.tid) * 2] = 0.f; tbl[(ns * 256 + F.tid) * 2 + 1] = 0.f; }
                __syncthreads();
#pragma unroll
                for (int q = 0; q < 2; ++q) { const int r = 2 * F.wave + q; float s1 = 0.f, s2 = 0.f;
#pragma unroll
                    for (int j = 0; j < 8; ++j) { const f32x4 v = ((const f32x4*)(z1m + (size_t)r * DM))[F.lane + 64 * j]; s1 += (v[0] + v[1]) + (v[2] + v[3]); s2 += (v[0] * v[0] + v[1] * v[1]) + (v[2] * v[2] + v[3] * v[3]); }
                    s1 = wave_sum(s1); s2 = wave_sum(s2);
                    const float mu = s1 * (1.f / DM), var = fmaxf(s2 * (1.f / DM) - mu * mu, 0.f);
                    if (F.lane == 0) { tbl[(ns * 256 + r) * 2] = mu; tbl[(ns * 256 + r) * 2 + 1] = __builtin_amdgcn_rsqf(var + 1e-5f); } }
            } else if (F.tid < 256) { float mu, rs; row_stats(slab, u.pm * 256 + F.tid, mu, rs); tbl[(ns * 256 + F.tid) * 2] = mu; tbl[(ns * 256 + F.tid) * 2 + 1] = rs; }
            ++ns;
            __syncthreads();
        }
    }
    StatTbl t; t.slot = slot; t.tbl = tbl; return t;
}
__device__ __forceinline__ void p4_ikn(Frame& F) {
    const bf16_t* proj = WSP(bf16_t, WS_PROJ); bf16_t* ikn = WSP(bf16_t, WS_IKN);
    const float g = F.in[8][F.lane], b = F.in[9][F.lane];
    for (int row = F.gw; row < MR; row += F.NGW) {
        const float v = bf2f(proj[(size_t)row * PW + PC_IK + F.lane]);
        const float mu = wave_sum(v) * (1.f / 64.f); const float d = v - mu; const float var = wave_sum(d * d) * (1.f / 64.f);
        ikn[(size_t)row * 64 + F.lane] = (bf16_t)f2bf(d * __builtin_amdgcn_rsqf(var + 1e-5f) * g + b);
    }
}
constexpr int QP = 136, TP = 72;
__device__ __forceinline__ void h1_item(Frame& F, int bh, int c) {
    const int b = bh >> 3, h = bh & 7, tid = F.tid, lane = F.lane, w = F.wave;
    const bf16_t* proj = WSP(bf16_t, WS_PROJ);
    LAS bf16_t* Qs = (LAS bf16_t*)F.lds; LAS bf16_t* Ks = Qs + 64 * QP; LAS bf16_t* KhT = Ks + 64 * QP; LAS bf16_t* VT = KhT + 128 * TP; LAS float* tot = (LAS float*)(VT + 128 * TP);
    const int ch = tid & 127, part = tid >> 7;
    const float l0 = F.in[10][h * 128 + ch], l1 = F.in[10][1024 + h * 128 + ch];
    const float lb = 1.f / (1.f + __expf(l1 - l0));
    float fgv[16], cum[16]; float run = 0.f;
    const size_t prow0 = c == 0 ? (size_t)METAROW : (size_t)(b * SEQ + (c - 1) * 64 + 16 * part);
    const bf16_t* pf = proj + prow0 * PW + PC_HF + h * 128 + ch; const bf16_t* pq = proj + prow0 * PW + PC_HQ + h * 128 + ch; const bf16_t* pv = proj + prow0 * PW + PC_HI + h * 128 + ch;
    unsigned short fraw[16], qraw[16], vraw[16];
#pragma unroll
    for (int i = 0; i < 16; ++i) fraw[i] = pf[(size_t)i * PW];
#pragma unroll
    for (int i = 0; i < 16; ++i) { qraw[i] = pq[(size_t)i * PW]; vraw[i] = pv[(size_t)i * PW]; }
#pragma unroll
    for (int i = 0; i < 16; ++i) { const int tt = 16 * part + i; const bool valid = (c > 0) || (tt < NMETA);
        const float f = bf2f(fraw[i]);
        const float fg = valid ? lb + (1.f - lb) * sigm(f) : 1.f; run += __logf(fg); fgv[i] = fg; cum[i] = run; }
    tot[part * 128 + ch] = run;
    __syncthreads();
    float off = 0.f, blast = 0.f;
#pragma unroll
    for (int p = 0; p < 4; ++p) { const float t = tot[p * 128 + ch]; if (p < part) off += t; blast += t; }
    if (part == 0) WSP(float, WS_GCH)[(size_t)(bh * 65 + c) * 128 + ch] = __expf(blast);
    bf16_t* qtg = WSP(bf16_t, WS_QT);
#pragma unroll
    for (int i = 0; i < 16; ++i) { const int tt = 16 * part + i; const bool valid = (c > 0) || (tt < NMETA);
        const float bq = off + cum[i], fg = fgv[i];
        const float q = valid ? bf2f(qraw[i]) : 0.f, v = valid ? bf2f(vraw[i]) : 0.f;
        const float qt = silu(q) * __expf(bq), kk = 1.f - fg, kt = kk * __expf(-bq), kh = kk * __expf(blast - bq);
        const bf16_t qb = (bf16_t)f2bf(qt);
        Qs[tt * QP + ch] = qb; Ks[tt * QP + ch] = (bf16_t)f2bf(kt); KhT[ch * TP + tt] = (bf16_t)f2bf(kh); VT[ch * TP + tt] = (bf16_t)f2bf(v);
        if (c > 0) qtg[((size_t)(bh * 64 + (c - 1)) * 64 + tt) * 128 + ch] = qb; }
    __syncthreads();
    const int tb = w >> 2, dvb = w & 3, r = lane & 31, hh = lane >> 5;
    if (c > 0) {
        f32x16 o;
#pragma unroll
        for (int i = 0; i < 16; ++i) o[i] = 0.f;
        for (int sb = 0; sb <= tb; ++sb) {
            f32x16 x;
#pragma unroll
            for (int i = 0; i < 16; ++i) x[i] = 0.f;
#pragma unroll
            for (int ks = 0; ks < 8; ++ks) { const bf16x8 a = *(const LAS bf16x8*)(Ks + (32 * sb + r) * QP + 16 * ks + 8 * hh); const bf16x8 bq = *(const LAS bf16x8*)(Qs + (32 * tb + r) * QP + 16 * ks + 8 * hh); x = MFMA32(a, bq, x); }
            if (sb == tb) {
#pragma unroll
                for (int i = 0; i < 16; ++i) if (crow(i, hh) > r) x[i] = 0.f; }
#pragma unroll
            for (int s2 = 0; s2 < 2; ++s2) {
                bf16x8 xb;
#pragma unroll
                for (int j = 0; j < 8; ++j) xb[j] = (short)f2bf(x[8 * s2 + j]);
                const LAS bf16_t* vp = VT + (32 * dvb + r) * TP + 32 * sb + 16 * s2 + 4 * hh;
                const s16x4 lo = *(const LAS s16x4*)vp, hi = *(const LAS s16x4*)(vp + 8);
                const bf16x8 a2 = __builtin_shufflevector(lo, hi, 0, 1, 2, 3, 4, 5, 6, 7);
                o = MFMA32(a2, xb, o);
            }
        }
        float* oi = WSP(float, WS_OI) + ((size_t)(bh * 64 + (c - 1)) * 8 + w) * 1024 + lane;
#pragma unroll
        for (int i = 0; i < 16; ++i) oi[i * 64] = o[i];
    }
    if (c < 64) {
        bf16_t* lst = WSP(bf16_t, WS_LST) + (size_t)(bh * 65 + c) * 16384;
#pragma unroll
        for (int q2 = 0; q2 < 2; ++q2) { const int db = (w >> 2) * 2 + q2;
            f32x16 l;
#pragma unroll
            for (int i = 0; i < 16; ++i) l[i] = 0.f;
#pragma unroll
            for (int ks = 0; ks < 4; ++ks) { const bf16x8 a = *(const LAS bf16x8*)(VT + (32 * dvb + r) * TP + 16 * ks + 8 * hh); const bf16x8 bb = *(const LAS bf16x8*)(KhT + (32 * db + r) * TP + 16 * ks + 8 * hh); l = MFMA32(a, bb, l); }
#pragma unroll
            for (int i = 0; i < 16; ++i) lst[(size_t)(32 * dvb + crow(i, hh)) * 128 + 32 * db + r] = (bf16_t)f2bf(l[i]); }
    }
    __syncthreads();
}
__device__ __forceinline__ void h2_item(Frame& F, int it) {
    const int bh = it >> 4, part = it & 15, dv = 8 * part + (F.tid >> 6), d0 = 2 * (F.tid & 63);
    bf16_t* p = WSP(bf16_t, WS_LST) + ((size_t)bh * 65 * 128 + dv) * 128 + d0; const float* g = WSP(float, WS_GCH) + (size_t)bh * 65 * 128 + d0;
    float s0 = 0.f, s1 = 0.f;
#pragma unroll 8
    for (int c = 0; c < 64; ++c) { const unsigned l = *(const unsigned*)(p + (size_t)c * 16384); const f32x2 gg = *(const f32x2*)(g + c * 128);
        s0 = gg.x * s0 + bflo(l); s1 = gg.y * s1 + bfhi(l); *(unsigned*)(p + (size_t)c * 16384) = pk2(s0, s1); }
}
__device__ __forceinline__ void h3_item(Frame& F, int bh, int c) {
    const int b = bh >> 3, h = bh & 7, lane = F.lane, w = F.wave, tid = F.tid;
    const bf16_t* st = WSP(bf16_t, WS_LST) + (size_t)(bh * 65 + (c - 1)) * 16384; const bf16_t* qg = WSP(bf16_t, WS_QT) + (size_t)(bh * 64 + (c - 1)) * 8192;
    const float* oi = WSP(float, WS_OI) + ((size_t)(bh * 64 + (c - 1)) * 8 + w) * 1024 + lane;
    LAS float* Ot = (LAS float*)F.lds; LAS float* ssq = Ot + 64 * 129;
    const int tb = w >> 2, dvb = w & 3, r = lane & 31, hh = lane >> 5;
    f32x16 o;
#pragma unroll
    for (int i = 0; i < 16; ++i) o[i] = oi[i * 64];
#pragma unroll
    for (int ks = 0; ks < 8; ++ks) { const bf16x8 a = *(const bf16x8*)(st + (size_t)(32 * dvb + r) * 128 + 16 * ks + 8 * hh); const bf16x8 bq = *(const bf16x8*)(qg + (size_t)(32 * tb + r) * 128 + 16 * ks + 8 * hh); o = MFMA32(a, bq, o); }
    float ss = 0.f;
#pragma unroll
    for (int i = 0; i < 16; ++i) { ss += o[i] * o[i]; Ot[(32 * tb + r) * 129 + 32 * dvb + crow(i, hh)] = o[i]; }
    ssq[(dvb * 2 + hh) * 64 + 32 * tb + r] = ss;
    __syncthreads();
    const int t = tid >> 3, d0 = (tid & 7) * 16;
    float sq = 0.f;
#pragma unroll
    for (int k = 0; k < 8; ++k) sq += ssq[k * 64 + t];
    const float rstd = __builtin_amdgcn_rsqf(sq * (1.f / 128.f) + 1e-6f);
    const size_t row = (size_t)(b * SEQ + (c - 1) * 64 + t);
    const bf16_t* gp = WSP(bf16_t, WS_PROJ) + row * PW + PC_HG + h * 128 + d0; const float* ng = F.in[11] + h * 128 + d0;
    bf16_t* yp = WSP(bf16_t, WS_YHG) + row * 1024 + h * 128 + d0;
#pragma unroll
    for (int q = 0; q < 2; ++q) { const v4u gz = *(const v4u*)(gp + 8 * q); const f32x4 n0 = *(const f32x4*)(ng + 8 * q), n1 = *(const f32x4*)(ng + 8 * q + 4);
        const LAS float* op = Ot + t * 129 + d0 + 8 * q;
        v4u wv; wv.x = pk2(op[0] * rstd * n0[0] * silu(bflo(gz.x)), op[1] * rstd * n0[1] * silu(bfhi(gz.x))); wv.y = pk2(op[2] * rstd * n0[2] * silu(bflo(gz.y)), op[3] * rstd * n0[3] * silu(bfhi(gz.y)));
        wv.z = pk2(op[4] * rstd * n1[0] * silu(bflo(gz.z)), op[5] * rstd * n1[1] * silu(bfhi(gz.z))); wv.w = pk2(op[6] * rstd * n1[2] * silu(bflo(gz.w)), op[7] * rstd * n1[3] * silu(bfhi(gz.w)));
        *(v4u*)(yp + 8 * q) = wv; }
    __syncthreads();
}
__device__ __forceinline__ int wave_total(int v) {
    v += __builtin_amdgcn_update_dpp(0, v, 0xB1, 0xF, 0xF, true);
    v += __builtin_amdgcn_update_dpp(0, v, 0x4E, 0xF, 0xF, true);
    v += __builtin_amdgcn_update_dpp(0, v, 0x141, 0xF, 0xF, true);
    v += __builtin_amdgcn_update_dpp(0, v, 0x140, 0xF, 0xF, true);
    v += __builtin_amdgcn_update_dpp(0, v, 0x142, 0xA, 0xF, true);
    v += __builtin_amdgcn_update_dpp(0, v, 0x143, 0xC, 0xF, true);
    return __builtin_amdgcn_readlane(v, 63);
}
__device__ __forceinline__ void cnt4_ge(int& cnt, unsigned mid, unsigned a, unsigned b, unsigned c, unsigned d) {
    unsigned long long m0, m1, m2, m3; int t0, t1, t2, t3;
    asm volatile("v_cmp_le_u32_e64 %1, %9, %10\n\tv_cmp_le_u32_e64 %2, %9, %11\n\tv_cmp_le_u32_e64 %3, %9, %12\n\tv_cmp_le_u32_e64 %4, %9, %13\n\t"
                 "s_bcnt1_i32_b64 %5, %1\n\ts_bcnt1_i32_b64 %6, %2\n\ts_bcnt1_i32_b64 %7, %3\n\ts_bcnt1_i32_b64 %8, %4\n\t"
                 "s_add_i32 %0, %0, %5\n\ts_add_i32 %0, %0, %6\n\ts_add_i32 %0, %0, %7\n\ts_add_i32 %0, %0, %8"
                 : "+s"(cnt), "=&s"(m0), "=&s"(m1), "=&s"(m2), "=&s"(m3), "=&s"(t0), "=&s"(t1), "=&s"(t2), "=&s"(t3)
                 : "s"(mid), "v"(a), "v"(b), "v"(c), "v"(d) : "scc");
}
__device__ __forceinline__ void cnt4_gt(int& cnt, unsigned mid, unsigned a, unsigned b, unsigned c, unsigned d) {
    unsigned long long m0, m1, m2, m3; int t0, t1, t2, t3;
    asm volatile("v_cmp_lt_u32_e64 %1, %9, %10\n\tv_cmp_lt_u32_e64 %2, %9, %11\n\tv_cmp_lt_u32_e64 %3, %9, %12\n\tv_cmp_lt_u32_e64 %4, %9, %13\n\t"
                 "s_bcnt1_i32_b64 %5, %1\n\ts_bcnt1_i32_b64 %6, %2\n\ts_bcnt1_i32_b64 %7, %3\n\ts_bcnt1_i32_b64 %8, %4\n\t"
                 "s_add_i32 %0, %0, %5\n\ts_add_i32 %0, %0, %6\n\ts_add_i32 %0, %0, %7\n\ts_add_i32 %0, %0, %8"
                 : "+s"(cnt), "=&s"(m0), "=&s"(m1), "=&s"(m2), "=&s"(m3), "=&s"(t0), "=&s"(t1), "=&s"(t2), "=&s"(t3)
                 : "s"(mid), "v"(a), "v"(b), "v"(c), "v"(d) : "scc");
}
__device__ __forceinline__ void idx_item(Frame& F, int b, int qblk) {
    const int lane = F.lane, w = F.wave;
#ifdef TS_A0
    unsigned long long* tsx = (unsigned long long*)(F.ws + WS_CTL + 65536); const bool tsl = blockIdx.x == 0 && F.tid == 0;
    const unsigned long long t0_ = __builtin_amdgcn_s_memrealtime();
#endif
    const bf16_t* proj = WSP(bf16_t, WS_PROJ); const bf16_t* ikn = WSP(bf16_t, WS_IKN);
    LAS unsigned* sc = (LAS unsigned*)F.lds;
    const int r0 = 8 * qblk, ntile = (r0 + 8 + 31) >> 5;
    const int r = lane & 31, hh = lane >> 5;
    {
        LAS float* wl = (LAS float*)(F.lds + WL_OFF);
        LAS bf16_t* iql = (LAS bf16_t*)(wl + 128);
        if (F.tid < 128) wl[F.tid] = bf2f(proj[(size_t)(b * SEQ + r0 + (F.tid >> 4)) * PW + PC_IW + (F.tid & 15)]) * (1.f / 32.f);
        {
            const int q = F.tid >> 6, d = F.tid & 63; const bf16_t* pw = proj + (size_t)(b * SEQ + r0 + q) * PW;
            unsigned short wr_[16], qr_[16];
#pragma unroll
            for (int hd = 0; hd < 16; ++hd) { wr_[hd] = pw[PC_IW + hd]; qr_[hd] = pw[PC_IQ + hd * 64 + d]; }
            float acc_ = 0.f;
#pragma unroll
            for (int hd = 0; hd < 16; ++hd) acc_ += bf2f(wr_[hd]) * bf2f(qr_[hd]);
            iql[q * 64 + d] = (bf16_t)f2bf(acc_ * (1.f / 32.f));
        }
        bf16x8 a[4][4];
#pragma unroll
        for (int p = 0; p < 4; ++p) {
            const size_t rowq = (size_t)(b * SEQ + r0 + 2 * p + (r >> 4));
#pragma unroll
            for (int ks = 0; ks < 4; ++ks) a[p][ks] = *(const bf16x8*)(proj + rowq * PW + PC_IQ + (r & 15) * 64 + 16 * ks + 8 * hh);
        }
        __syncthreads();
        bf16x8 al[4];
#pragma unroll
        for (int ks = 0; ks < 4; ++ks) { bf16x8 z = {0, 0, 0, 0, 0, 0, 0, 0}; if (r < 8) z = *(const LAS bf16x8*)(iql + (2 * (r & 3) + (r >> 2)) * 64 + 16 * ks + 8 * hh); al[ks] = z; }
        bf16x8 bc[4], bn[4];
#define IDX_LOAD(dst, kt) do { int kt_ = (kt); if (kt_ >= ntile) kt_ = w < ntile ? w : 0; const bf16_t* kp_ = ikn + (size_t)(b * SEQ + 32 * kt_ + r) * 64 + 8 * hh; \
    _Pragma("unroll") for (int ks = 0; ks < 4; ++ks) dst[ks] = *(const bf16x8*)(kp_ + 16 * ks); } while (0)
        IDX_LOAD(bc, w);
        for (int kt = w; kt < ntile; kt += 8) {
            IDX_LOAD(bn, kt + 8);
            const int key = 32 * kt + r;
            f32x16 xl;
#pragma unroll
            for (int i = 0; i < 16; ++i) xl[i] = 0.f;
#pragma unroll
            for (int ks = 0; ks < 4; ++ks) xl = MFMA32(al[ks], bc[ks], xl);
#pragma unroll
            for (int p = 0; p < 4; ++p) {
                f32x16 x;
#pragma unroll
                for (int i = 0; i < 16; ++i) x[i] = 0.f;
#pragma unroll
                for (int ks = 0; ks < 4; ++ks) x = MFMA32(a[p][ks], bc[ks], x);
                const LAS f32x4* wq = (const LAS f32x4*)(wl + (2 * p) * 16 + 4 * hh);
                const f32x4 w0 = wq[0], w1 = wq[2], w2 = wq[4], w3 = wq[6];
                float p0 = 0.f, p1 = 0.f;
#pragma unroll
                for (int i = 0; i < 4; ++i) { p0 += w0[i] * fabsf(x[i]); p0 += w1[i] * fabsf(x[4 + i]); p1 += w2[i] * fabsf(x[8 + i]); p1 += w3[i] * fabsf(x[12 + i]); }
                const auto sw = __builtin_amdgcn_permlane32_swap(__float_as_uint(p0), __float_as_uint(p1), false, false);
                const float tot = 0.5f * ((__uint_as_float(sw[0]) + __uint_as_float(sw[1])) + xl[p]);
                unsigned u = __float_as_uint(tot); u = (u & 0x80000000u) ? ~u : (u | 0x80000000u); if (key > r0 + 2 * p + hh) u = 0u;
                sc[(2 * p + hh) * 4096 + key] = u;
            }
#pragma unroll
            for (int ks = 0; ks < 4; ++ks) bc[ks] = bn[ks];
        }
#undef IDX_LOAD
    }
    __syncthreads();
#ifdef TS_A0
    const unsigned long long t1_ = __builtin_amdgcn_s_memrealtime(); if (tsl) tsx[21] += t1_ - t0_;
#endif
    {
        const int rq = r0 + w, nvalid = rq + 1, nk = ntile * 32;
        unsigned k[64];
#pragma unroll
        for (int i = 0; i < 64; ++i) { const int idx = lane + 64 * i; k[i] = idx < nk ? sc[w * 4096 + idx] : 0u; }
        unsigned thr = 0u; bool exact = false;
        if (nvalid > 256) {
            unsigned lo = 1u, hi = 0xFFFFFFFFu;
            while (hi - lo > 1u) { const unsigned mid = lo + ((hi - lo) >> 1); int cnt = 0;
#pragma unroll
                for (int i = 0; i < 64; i += 4) cnt4_ge(cnt, mid, k[i], k[i + 1], k[i + 2], k[i + 3]);
                if (cnt == 256) { lo = mid; exact = true; break; }
                if (cnt > 256) lo = mid; else hi = mid; }
            thr = lo;
        }
        int quota = 0;
        if (thr != 0u && !exact) { int ngt = 0;
#pragma unroll
            for (int i = 0; i < 64; i += 4) cnt4_gt(ngt, thr, k[i], k[i + 1], k[i + 2], k[i + 3]);
            quota = 256 - ngt; }
        int eqrun = 0; unsigned long long myword = 0ull;
#pragma unroll
        for (int i = 0; i < 64; ++i) { const bool gt = exact ? (k[i] >= thr) : (k[i] > thr), eq = (k[i] == thr) && (thr != 0u) && !exact;
            const unsigned long long meq = __ballot(eq); const int eqb = eqrun + (int)__builtin_amdgcn_mbcnt_hi((unsigned)(meq >> 32), __builtin_amdgcn_mbcnt_lo((unsigned)meq, 0u));
            const bool take = gt || (eq && eqb < quota);
            const unsigned long long m = __ballot(take);
            if (lane == i) myword = m;
            eqrun += __popcll(meq); }
        WSP(unsigned long long, WS_SEL)[(size_t)(b * SEQ + rq) * 64 + lane] = myword;
    }
    __syncthreads();
#ifdef TS_A0
    if (tsl) tsx[23] += __builtin_amdgcn_s_memrealtime() - t1_;
#endif
}
constexpr int AKP = 136, AVP = 72;
constexpr int AK_BYTES = 64 * AKP * 2, AV_BYTES = 128 * AVP * 2;
__device__ __forceinline__ void att_unit(Frame& F, int b, int kv, int qb, int t_lo, int t_hi, int mode, int uidx) {
    const int lane = F.lane, w = F.wave, tid = F.tid;
    const bf16_t* proj = WSP(bf16_t, WS_PROJ); const unsigned long long* mask = WSP(unsigned long long, WS_SEL);
    LAS bf16_t* Kl0 = (LAS bf16_t*)F.lds; LAS bf16_t* Vl0 = (LAS bf16_t*)(F.lds + 2 * AK_BYTES); LAS bf16_t* Ql = (LAS bf16_t*)(F.lds + 2 * AK_BYTES + 2 * AV_BYTES) + w * 4096 + lane * 8;
    const int col = lane & 31, hh = lane >> 5, ql = col >> 2, h = col & 3;
    const int q = 64 * qb + 8 * w + ql; const size_t rowq = (size_t)(b * SEQ + q);
    __syncthreads();
#pragma unroll
    for (int ks = 0; ks < 8; ++ks) { const v4u raw = *(const v4u*)(proj + rowq * PW + PC_AQ + (kv * 4 + h) * 128 + 16 * ks + 8 * hh); const float sc = 0.08838834764831845f;
        v4u o; o.x = pk2(bflo(raw.x) * sc, bfhi(raw.x) * sc); o.y = pk2(bflo(raw.y) * sc, bfhi(raw.y) * sc); o.z = pk2(bflo(raw.z) * sc, bfhi(raw.z) * sc); o.w = pk2(bflo(raw.w) * sc, bfhi(raw.w) * sc);
        *(LAS v4u*)(Ql + ks * 512) = o; }
    bf16x8 qe;
    { const float slope = exp2f(-(float)(kv * 4 + h + 1)); v4u o = (v4u){0u, 0u, 0u, 0u}; if (hh == 0) o.x = pk2(64.f * slope, slope); qe = __builtin_bit_cast(bf16x8, o); }
    const int pi_ = (col & 16) | ((col & 4) << 1) | ((col & 8) >> 1) | (col & 3);
    f32x16 o0, o1, o2, o3;
#pragma unroll
    for (int i = 0; i < 16; ++i) { o0[i] = 0.f; o1[i] = 0.f; o2[i] = 0.f; o3[i] = 0.f; }
    float m_run = -1e30f, l_run = 0.f;
    const int skey = tid & 63, sch = tid >> 6;
    v4u sk0, sk1, sv0, sv1; unsigned long long mw = 0ull;
#define ATT_ROW(t_) ((t_) == 0 ? proj + (size_t)(METAROW + (skey & 15)) * PW + kv * 128 : proj + (size_t)(b * SEQ + 64 * (qb + 1 - (t_)) + skey) * PW + kv * 128)
#define ATT_LOADK(t) do { const int t_ = (t); const bool ok_ = t_ != 0 || skey < NMETA; const bf16_t* p_ = ATT_ROW(t_); const v4u z_ = (v4u){0u, 0u, 0u, 0u}; \
        sk0 = ok_ ? *(const v4u*)(p_ + PC_AK + 8 * sch) : z_; sk1 = ok_ ? *(const v4u*)(p_ + PC_AK + 8 * (sch + 8)) : z_; } while (0)
#define ATT_LOADV(t) do { const int t_ = (t); const bool ok_ = t_ != 0 || skey < NMETA; const bf16_t* p_ = ATT_ROW(t_); const v4u z_ = (v4u){0u, 0u, 0u, 0u}; \
        sv0 = ok_ ? *(const v4u*)(p_ + PC_AV + 8 * sch) : z_; sv1 = ok_ ? *(const v4u*)(p_ + PC_AV + 8 * (sch + 8)) : z_; mw = t_ == 0 ? 0ull : mask[rowq * 64 + (qb + 1 - t_)]; } while (0)
#define ATT_VT(dst, v, c) do { LAS bf16_t* d_ = (dst) + (8 * (c)) * AVP + skey; \
        d_[0 * AVP] = (bf16_t)(v.x & 0xffffu); d_[1 * AVP] = (bf16_t)(v.x >> 16); d_[2 * AVP] = (bf16_t)(v.y & 0xffffu); d_[3 * AVP] = (bf16_t)(v.y >> 16); \
        d_[4 * AVP] = (bf16_t)(v.z & 0xffffu); d_[5 * AVP] = (bf16_t)(v.z >> 16); d_[6 * AVP] = (bf16_t)(v.w & 0xffffu); d_[7 * AVP] = (bf16_t)(v.w >> 16); } while (0)
#define ATT_STOREK(buf) do { LAS bf16_t* kd_ = Kl0 + (buf) * (64 * AKP) + skey * AKP; *(LAS v4u*)(kd_ + 8 * sch) = sk0; *(LAS v4u*)(kd_ + 8 * (sch + 8)) = sk1; } while (0)
#define ATT_STOREV(buf) do { LAS bf16_t* vd_ = Vl0 + (buf) * (128 * AVP); ATT_VT(vd_, sv0, sch); ATT_VT(vd_, sv1, sch + 8); } while (0)
#define ATT_S(xa, xb, t) do { const int t_ = (t); const LAS bf16_t* Kb_ = Kl0 + (t_ & 1) * (64 * AKP); const int pos0_ = t_ == 0 ? 0 : NMETA + 64 * (qb + 1 - t_); \
        _Pragma("unroll") for (int i = 0; i < 16; ++i) { xa[i] = 0.f; xb[i] = 0.f; } \
        _Pragma("unroll") for (int ks = 0; ks < 8; ++ks) { const bf16x8 a0 = *(const LAS bf16x8*)(Kb_ + pi_ * AKP + 16 * ks + 8 * hh); const bf16x8 a1 = *(const LAS bf16x8*)(Kb_ + (32 + pi_) * AKP + 16 * ks + 8 * hh); \
            const bf16x8 qf_ = *(const LAS bf16x8*)(Ql + ks * 512); xa = MFMA32(a0, qf_, xa); xb = MFMA32(a1, qf_, xb); } \
        { const int p0_ = pos0_ + pi_, p1_ = pos0_ + 32 + pi_; v4u e0 = (v4u){0u, 0u, 0u, 0u}, e1 = e0; \
          if (hh == 0) { e0.x = pk2((float)(p0_ >> 6), (float)(p0_ & 63)); e1.x = pk2((float)(p1_ >> 6), (float)(p1_ & 63)); } \
          xa = MFMA32(__builtin_bit_cast(bf16x8, e0), qe, xa); xb = MFMA32(__builtin_bit_cast(bf16x8, e1), qe, xb); } } while (0)
    const int ntiles = t_hi;
    ATT_LOADK(t_lo); ATT_LOADV(t_lo); ATT_STOREK(t_lo & 1); ATT_STOREV(t_lo & 1);
    ATT_LOADK(t_lo + 1); ATT_STOREK((t_lo + 1) & 1);
    unsigned long long mcur = mw;
    __syncthreads();
    f32x16 x0, x1, y0, y1;
    ATT_S(x0, x1, t_lo);
    __syncthreads();
    for (int t = t_lo; t < ntiles; ++t) {
        if (t + 2 < ntiles) ATT_LOADK(t + 2);
        if (t + 1 < ntiles) ATT_LOADV(t + 1);
        if (t + 1 < ntiles) ATT_S(y0, y1, t + 1);
        const LAS bf16_t* Vb = Vl0 + (t & 1) * (128 * AVP);
        const unsigned mk0 = t == 0 ? 0x000000ffu : (unsigned)(mcur >> (8 * hh)), mk1 = t == 0 ? 0u : (unsigned)(mcur >> (32 + 8 * hh));
        float mt = -INFINITY;
#pragma unroll
        for (int i = 0; i < 16; ++i) { const int bit = (i & 7) + 16 * (i >> 3);
            const unsigned s0 = (unsigned)(((int)(mk0 << (31 - bit))) >> 31), s1 = (unsigned)(((int)(mk1 << (31 - bit))) >> 31);
            x0[i] = __uint_as_float((__float_as_uint(x0[i]) & s0) | (~s0 & 0xff800000u)); x1[i] = __uint_as_float((__float_as_uint(x1[i]) & s1) | (~s1 & 0xff800000u));
            mt = fmaxf(mt, fmaxf(x0[i], x1[i])); }
        { const auto sw = __builtin_amdgcn_permlane32_swap(__float_as_uint(mt), __float_as_uint(mt), false, false); mt = fmaxf(__uint_as_float(sw[0]), __uint_as_float(sw[1])); }
        const float m_new = (mt > m_run + 8.f) ? mt : m_run;
        const float LOG2E = 1.4426950408889634f;
        const float alpha = __builtin_amdgcn_exp2f((m_run - m_new) * LOG2E);
        m_run = m_new;
        const float mneg = -m_new * LOG2E;
        float ls = 0.f;
#pragma unroll
        for (int i = 0; i < 16; ++i) { x0[i] = __builtin_amdgcn_exp2f(fmaf(x0[i], LOG2E, mneg)); x1[i] = __builtin_amdgcn_exp2f(fmaf(x1[i], LOG2E, mneg)); ls += x0[i] + x1[i]; }
        l_run = l_run * alpha + ls;
        if (__any(alpha != 1.f)) {
#pragma unroll
            for (int i = 0; i < 16; ++i) { o0[i] *= alpha; o1[i] *= alpha; o2[i] *= alpha; o3[i] *= alpha; } }
#pragma unroll
        for (int cb = 0; cb < 2; ++cb)
#pragma unroll
            for (int s2 = 0; s2 < 2; ++s2) {
                u32x4 pw;
#pragma unroll
                for (int j = 0; j < 4; ++j) pw[j] = cb == 0 ? cvt_pk_bf16(x0[8 * s2 + 2 * j], x0[8 * s2 + 2 * j + 1]) : cvt_pk_bf16(x1[8 * s2 + 2 * j], x1[8 * s2 + 2 * j + 1]);
                const bf16x8 pb = __builtin_bit_cast(bf16x8, pw);
                const LAS bf16_t* vp = Vb + col * AVP + 32 * cb + 16 * s2 + 8 * hh;
                o0 = MFMA32(*(const LAS bf16x8*)(vp), pb, o0); o1 = MFMA32(*(const LAS bf16x8*)(vp + 32 * AVP), pb, o1);
                o2 = MFMA32(*(const LAS bf16x8*)(vp + 64 * AVP), pb, o2); o3 = MFMA32(*(const LAS bf16x8*)(vp + 96 * AVP), pb, o3);
            }
        if (t + 2 < ntiles) ATT_STOREK(t & 1);
        if (t + 1 < ntiles) { ATT_STOREV((t + 1) & 1); mcur = mw; }
#pragma unroll
        for (int i = 0; i < 16; ++i) { x0[i] = y0[i]; x1[i] = y1[i]; }
        __syncthreads();
    }
#undef ATT_S
#undef ATT_ROW
#undef ATT_LOADK
#undef ATT_LOADV
#undef ATT_VT
#undef ATT_STOREK
#undef ATT_STOREV
    { const auto sw = __builtin_amdgcn_permlane32_swap(__float_as_uint(l_run), __float_as_uint(l_run), false, false); l_run = __uint_as_float(sw[0]) + __uint_as_float(sw[1]); }
    bf16_t* pO = WSP(bf16_t, WS_APART) + (size_t)uidx * (256 * 128) + (size_t)(32 * w + col) * 128 + 4 * hh; float* pML = WSP(float, WS_APML) + (size_t)uidx * 512 + (32 * w + col) * 2;
    unsigned* flag = (unsigned*)(F.ws + WS_CTL) + CW_AFLAG + 64 * uidx;
    if (mode == 1) {
#pragma unroll
        for (int g4 = 0; g4 < 4; ++g4) {
            u32x2 w0, w1, w2, w3;
            w0.x = pk2(o0[4 * g4], o0[4 * g4 + 1]); w0.y = pk2(o0[4 * g4 + 2], o0[4 * g4 + 3]); w1.x = pk2(o1[4 * g4], o1[4 * g4 + 1]); w1.y = pk2(o1[4 * g4 + 2], o1[4 * g4 + 3]);
            w2.x = pk2(o2[4 * g4], o2[4 * g4 + 1]); w2.y = pk2(o2[4 * g4 + 2], o2[4 * g4 + 3]); w3.x = pk2(o3[4 * g4], o3[4 * g4 + 1]); w3.y = pk2(o3[4 * g4 + 2], o3[4 * g4 + 3]);
            *(u32x2*)(pO + 8 * g4) = w0; *(u32x2*)(pO + 32 + 8 * g4) = w1; *(u32x2*)(pO + 64 + 8 * g4) = w2; *(u32x2*)(pO + 96 + 8 * g4) = w3; }
        if (hh == 0) { pML[0] = m_run; pML[1] = l_run; }
        asm volatile("s_waitcnt vmcnt(0)" ::: "memory");
        __syncthreads();
        if (tid == 0) { __builtin_amdgcn_fence(__ATOMIC_RELEASE, "agent"); asm volatile("s_waitcnt vmcnt(0)" ::: "memory"); __hip_atomic_store(flag, 1u, __ATOMIC_RELAXED, __HIP_MEMORY_SCOPE_AGENT); }
        return;
    }
    float sc_own = 1.f, sc_oth = 0.f, l_tot = l_run;
    if (mode == 2) {
        if (tid == 0) { unsigned spins = 0; while (__hip_atomic_load(flag, __ATOMIC_RELAXED, __HIP_MEMORY_SCOPE_AGENT) == 0u && ++spins < (1u << 22)) __builtin_amdgcn_s_sleep(8);
            __builtin_amdgcn_fence(__ATOMIC_ACQUIRE, "agent"); asm volatile("s_waitcnt vmcnt(0)" ::: "memory"); }
        __syncthreads();
        const float m2 = pML[0], l2 = pML[1]; const float mm = fmaxf(m_run, m2);
        sc_own = __expf(m_run - mm); sc_oth = __expf(m2 - mm); l_tot = l_run * sc_own + l2 * sc_oth;
    }
    const float inv = 1.f / l_tot; const float ko = sc_own * inv, kp = sc_oth * inv;
    bf16_t* yp = WSP(bf16_t, WS_YATT) + rowq * 1024 + (kv * 4 + h) * 128 + 4 * hh;
#pragma unroll
    for (int g4 = 0; g4 < 4; ++g4) {
        u32x2 q0 = (u32x2){0u, 0u}, q1 = q0, q2 = q0, q3 = q0;
        if (mode == 2) { q0 = *(const u32x2*)(pO + 8 * g4); q1 = *(const u32x2*)(pO + 32 + 8 * g4); q2 = *(const u32x2*)(pO + 64 + 8 * g4); q3 = *(const u32x2*)(pO + 96 + 8 * g4); }
        u32x2 w0, w1, w2, w3;
        w0.x = pk2(o0[4 * g4] * ko + bflo(q0.x) * kp, o0[4 * g4 + 1] * ko + bfhi(q0.x) * kp); w0.y = pk2(o0[4 * g4 + 2] * ko + bflo(q0.y) * kp, o0[4 * g4 + 3] * ko + bfhi(q0.y) * kp);
        w1.x = pk2(o1[4 * g4] * ko + bflo(q1.x) * kp, o1[4 * g4 + 1] * ko + bfhi(q1.x) * kp); w1.y = pk2(o1[4 * g4 + 2] * ko + bflo(q1.y) * kp, o1[4 * g4 + 3] * ko + bfhi(q1.y) * kp);
        w2.x = pk2(o2[4 * g4] * ko + bflo(q2.x) * kp, o2[4 * g4 + 1] * ko + bfhi(q2.x) * kp); w2.y = pk2(o2[4 * g4 + 2] * ko + bflo(q2.y) * kp, o2[4 * g4 + 3] * ko + bfhi(q2.y) * kp);
        w3.x = pk2(o3[4 * g4] * ko + bflo(q3.x) * kp, o3[4 * g4 + 1] * ko + bfhi(q3.x) * kp); w3.y = pk2(o3[4 * g4 + 2] * ko + bflo(q3.y) * kp, o3[4 * g4 + 3] * ko + bfhi(q3.y) * kp);
        *(u32x2*)(yp + 8 * g4) = w0; *(u32x2*)(yp + 32 + 8 * g4) = w1; *(u32x2*)(yp + 64 + 8 * g4) = w2; *(u32x2*)(yp + 96 + 8 * g4) = w3;
    }
}
__device__ __forceinline__ void p11_final_ln(Frame& F) {
    const float* st = WSP(float, WS_ST3); const float* g = F.in[20]; const float* b = F.in[21];
    for (int row = F.gw; row < MR; row += F.NGW) { float mu, rs; row_stats(st, row, mu, rs);
        f32x4* o = (f32x4*)(F.out + (size_t)row * DM);
#pragma unroll
        for (int j = 0; j < 8; ++j) { const int i = F.lane + 64 * j; const f32x4 z = o[i]; o[i] = (z - mu) * rs * ((const f32x4*)g)[i] + ((const f32x4*)b)[i]; } }
}
struct Args { const float* in[22]; float* out; unsigned char* ws; int ph_lo, ph_hi, li, pad; };
constexpr int NPH = 12;
__global__ void __launch_bounds__(512, 2) mk_fwd(Args args) {
    extern __shared__ __attribute__((aligned(16))) unsigned char lds_raw[];
    Frame F;
    F.lds = (LAS unsigned char*)lds_raw;
    F.tid = threadIdx.x; F.lane = F.tid & 63; F.wave = __builtin_amdgcn_readfirstlane(F.tid >> 6);
    F.G = gridDim.x; F.gw = blockIdx.x * 8 + F.wave; F.NGW = F.G * 8;
#pragma unroll
    for (int i = 0; i < 22; ++i) F.in[i] = args.in[i];
    F.out = args.out; F.ws = args.ws;
    volatile LAS unsigned* MISC = (volatile LAS unsigned*)(F.lds + MISC_OFF);
    if (F.tid < 64) MISC[F.tid] = 0u;
    __syncthreads();
    XcdBarrier bar = xcd_barrier_post((unsigned*)(F.ws + WS_CTL) + CW_BAR + args.li * XCD_BAR_WORDS, MISC + 8);
    const int lo = args.ph_lo, hi = args.ph_hi;
#define IN(k) (lo <= (k) && (k) < hi)
#ifdef TS_A0
    unsigned long long* ts = (unsigned long long*)(F.ws + WS_CTL + 65536);
#define MARK(i) do { if (blockIdx.x == 0 && F.tid == 0) ts[i] = __builtin_amdgcn_s_memrealtime(); } while (0)
#else
#define MARK(i) do { } while (0)
#endif
    MARK(0);
#define SEAM(k) do { if (IN(k) && IN((k) + 1)) xcd_barrier(bar); MARK((k) + 1); } while (0)
    const int bid = blockIdx.x;
#ifndef REP_MASK
#define REP_MASK 0
#endif
#define PBEG(k) if (IN(k)) { const int nrep_ = ((REP_MASK >> (k)) & 1) ? 2 : 1; for (int rep = 0; rep < nrep_; ++rep) { if (rep) xcd_barrier(bar);
#define PEND(k) } } SEAM(k);

    PBEG(0) p0_prologue(F); PEND(0)
    PBEG(1)
        Gemm g{WSP(bf16_t, WS_H0B), WSP(bf16_t, WS_WGU1), MPAD, NGU, DM}; StaticOrder S; S.init(MPAD, NGU, F.G, bid);
        EpiSwiGLU<false> E{WSP(bf16_t, WS_G), DFF, StatTbl{nullptr, nullptr}, nullptr, nullptr};
        gemm_phase<EpiSwiGLU<false>, StaticOrder, true, true>(F.lds, g, S, E);
        MARK(16);
        tr_queue(F, (unsigned*)(F.ws + WS_CTL) + CW_Q1 + 64 * rep, TR_I1, TR_I2);
    PEND(1)
    PBEG(2)
        p1_colsums(F, 0, PW);
        p2_meta_down(F); MARK(17);
        Gemm g{WSP(bf16_t, WS_G), WSP(bf16_t, WS_WD1), MR, DM, DFF}; StaticOrder S; S.init(MR, DM, F.G, bid);
        EpiResid<0> E{F.in[0], nullptr, StatTbl{nullptr, nullptr}, nullptr, nullptr, WSP(bf16_t, WS_Z1B), nullptr, WSP(float, WS_ST1), 0.5f};
        gemm_phase<EpiResid<0>, StaticOrder, false, true>(F.lds, g, S, E);
    PEND(2)
    PBEG(3)
        Gemm g{WSP(bf16_t, WS_Z1B), WSP(bf16_t, WS_WIN), MPAD, PW, DM}; StaticOrder S; S.init(MPAD, PW, F.G, bid);
        const StatTbl st = fill_stats(F, S, WSP(float, WS_ST1), WSP(float, WS_Z1M)); MARK(18);
        EpiProj E{WSP(bf16_t, WS_PROJ), PW, st, WSP(float, WS_CSV), WSP(float, WS_BWV)};
        gemm_phase<EpiProj, StaticOrder, true, true>(F.lds, g, S, E);
        tr_queue(F, (unsigned*)(F.ws + WS_CTL) + CW_Q3 + 64 * rep, TR_I2, TR_I3);
    PEND(3)
    PBEG(4)
        p1_colsums(F, PW, NCS);
        p4_ikn(F); MARK(13);
        for (int it = bid; it < 16 * 65; it += F.G) h1_item(F, it / 65, it % 65);
    PEND(4)
    PBEG(5)
        if (rep == 0) for (int it = bid; it < 256; it += F.G) h2_item(F, it);
        MARK(14);
        for (int it = bid; it < 1024; it += F.G) { const int j = it >> 8, x = it & 255; idx_item(F, j >> 1, (j & 1) ? 511 - x : x); }
    PEND(5)
    PBEG(6)
#ifndef REP_H3
#define REP_H3 1
#endif
#ifndef REP_ATT
#define REP_ATT 1
#endif
        {
            const int pr = bid >> 1, ab = pr >> 6, akv = (pr >> 5) & 1, j = pr & 31, qbl = 32 + j, split = j + 2;
            if (F.G == 256) {
                if (bid & 1) att_unit(F, ab, akv, qbl, split, qbl + 2, 1, pr);
                else { att_unit(F, ab, akv, 31 - j, 0, 33 - j, 0, 0); att_unit(F, ab, akv, qbl, 0, split, 2, pr); }
            } else for (int it = bid; it < 256; it += F.G) att_unit(F, it >> 7, (it >> 6) & 1, it & 63, 0, (it & 63) + 2, 0, 0);
        }
        MARK(15);
        {
            unsigned* qctr = (unsigned*)(F.ws + WS_CTL) + CW_Q6 + 64 * rep; volatile LAS int* qslot = (volatile LAS int*)(F.lds + MISC_OFF + 128);
            for (;;) {
                __syncthreads();
                if (F.tid == 0) qslot[0] = (int)__hip_atomic_fetch_add(qctr, 1u, __ATOMIC_RELAXED, __HIP_MEMORY_SCOPE_AGENT);
                __syncthreads();
                const int it = qslot[0];
                if (it >= 16 * 64) break;
                h3_item(F, it >> 6, (it & 63) + 1);
            }
        }
    PEND(6)
    PBEG(7)
        { Gemm g{WSP(bf16_t, WS_YATT), WSP(bf16_t, WS_WBA), MR, DM, 1024}; StaticOrder S; S.init(MR, DM, F.G, bid);
          EpiBranch<0> E{WSP(bf16_t, WS_PROJ), PW, PC_GA, WSP(bf16_t, WS_T1), nullptr};
          gemm_phase<EpiBranch<0>, StaticOrder, false, true>(F.lds, g, S, E); }
        __syncthreads(); MARK(19);
        { Gemm g{WSP(bf16_t, WS_YHG), WSP(bf16_t, WS_WBH), MR, DM, 1024}; StaticOrder S; S.init(MR, DM, F.G, bid);
          EpiBranch<1> E{WSP(bf16_t, WS_PROJ), PW, PC_GH, WSP(bf16_t, WS_T1), WSP(bf16_t, WS_MRG)};
          gemm_phase<EpiBranch<1>, StaticOrder, false, true>(F.lds, g, S, E); }
    PEND(7)
    PBEG(8)
        Gemm g{WSP(bf16_t, WS_MRG), WSP(bf16_t, WS_WOUT), MR, DM, DM}; StaticOrder S; S.init(MR, DM, F.G, bid);
        const StatTbl st = fill_stats(F, S, WSP(float, WS_ST1), nullptr);
        EpiResid<1> E{nullptr, WSP(bf16_t, WS_Z1B), st, F.in[5], F.in[6], WSP(bf16_t, WS_Z2B), nullptr, WSP(float, WS_ST2), 1.0f};
        gemm_phase<EpiResid<1>, StaticOrder, false, true>(F.lds, g, S, E);
    PEND(8)
    PBEG(9)
        Gemm g{WSP(bf16_t, WS_Z2B), WSP(bf16_t, WS_WGU2), MR, NGU, DM}; StaticOrder S; S.init(MR, NGU, F.G, bid);
        const StatTbl st = fill_stats(F, S, WSP(float, WS_ST2), nullptr);
        EpiSwiGLU<true> E{WSP(bf16_t, WS_G2), DFF, st, WSP(float, WS_CSV) + PW, WSP(float, WS_BWV) + PW};
        gemm_phase<EpiSwiGLU<true>, StaticOrder, true, true>(F.lds, g, S, E);
    PEND(9)
    PBEG(10)
        Gemm g{WSP(bf16_t, WS_G2), WSP(bf16_t, WS_WD2), MR, DM, DFF}; StaticOrder S; S.init(MR, DM, F.G, bid);
        const StatTbl st = fill_stats(F, S, WSP(float, WS_ST2), nullptr);
        EpiResid<2> E{nullptr, WSP(bf16_t, WS_Z2B), st, F.in[15], F.in[16], nullptr, F.out, WSP(float, WS_ST3), 0.5f};
        gemm_phase<EpiResid<2>, StaticOrder, false, true>(F.lds, g, S, E);
    PEND(10)
    if (IN(11)) { p11_final_ln(F); }
#ifdef TS_A0
    if (blockIdx.x == 0 && F.tid == 0) {
        const unsigned long long now = __builtin_amdgcn_s_memrealtime(); ts[12] = now;
        unsigned long long qa = (ts[TS_A1] - ts[TS_A0]) / TS_UNIT, qb = (ts[TS_B1] - ts[TS_B0]) / TS_UNIT; if (qa > 99) qa = 99; if (qb > 99) qb = 99;
        const unsigned long long target = now + 2000ull * (100ull * qa + qb);
        while (__builtin_amdgcn_s_memrealtime() < target) __builtin_amdgcn_s_sleep(32);
    }
#endif
#undef IN
#undef SEAM
}

#ifndef MK_CUTS
#define MK_CUTS {0, NPH}
#endif
extern "C" void kernel_launch(void* const* d_in, const int* in_sizes, int n_in, void* d_out, int out_size, void* d_ws, size_t ws_size, hipStream_t stream) {
    static int grid = 0;
    if (grid == 0) {
        if (n_in != 22 || out_size != MR * DM || ws_size < WS_END) { fprintf(stderr, "kernel_launch: unexpected shapes (n_in %d, out %d, ws %zu < %zu)\n", n_in, out_size, ws_size, (size_t)WS_END); grid = -1; return; }
        int dev = 0, cus = 0, per_cu = 0;
        if (hipGetDevice(&dev) != hipSuccess || hipDeviceGetAttribute(&cus, hipDeviceAttributeMultiprocessorCount, dev) != hipSuccess) { grid = -1; return; }
        if (hipFuncSetAttribute((const void*)mk_fwd, hipFuncAttributeMaxDynamicSharedMemorySize, LDS_BYTES) != hipSuccess) { fprintf(stderr, "kernel_launch: hipFuncSetAttribute failed\n"); grid = -1; return; }
        if (hipOccupancyMaxActiveBlocksPerMultiprocessor(&per_cu, (const void*)mk_fwd, 512, LDS_BYTES) != hipSuccess || per_cu < 1) { fprintf(stderr, "kernel_launch: occupancy query says %d blocks per CU\n", per_cu); grid = -1; (void)hipGetLastError(); return; }
        grid = cus;
        if (grid != 256) fprintf(stderr, "kernel_launch: %d CUs; the one-unit-per-workgroup GEMM phases assume 256\n", grid);
    }
    if (grid < 0) return;
    (void)hipMemsetAsync((char*)d_ws + WS_CTL, 0, CTL_BYTES, stream);
    Args a{};
    for (int i = 0; i < 22; ++i) a.in[i] = (const float*)d_in[i];
    a.out = (float*)d_out; a.ws = (unsigned char*)d_ws;
    const int cuts[] = MK_CUTS; const int nl = (int)(sizeof(cuts) / sizeof(int)) - 1;
    for (int li = 0; li < nl; ++li) {
        a.ph_lo = cuts[li]; a.ph_hi = cuts[li + 1]; a.li = li; a.pad = 0;
        void* kargs[] = {&a};
        const hipError_t e = hipLaunchCooperativeKernel((const void*)mk_fwd, dim3(grid), dim3(512), kargs, LDS_BYTES, stream);
        if (e != hipSuccess) { fprintf(stderr, "kernel_launch: cooperative launch %d failed: %s\n", li, hipGetErrorString(e)); break; }
    }
}
```

```cpp
#include <hip/hip_runtime.h>
#include <cstdio>
#include <cstdint>
namespace pg8 {
#define PG8_LAS __attribute__((address_space(3)))
typedef unsigned short bf16_t;
typedef short bf16x8 __attribute__((ext_vector_type(8)));
typedef float f32x4 __attribute__((ext_vector_type(4)));
typedef unsigned u32x4 __attribute__((ext_vector_type(4)));
constexpr int BM = 256, BK = 64, HALF = 128, HTB = HALF * BK * 2  , STAGE_BYTES = 8 * HTB, NXCD = 8, WGM = 8;

__host__ __device__ __forceinline__ int lds_byte(int r, int c) { const int st = (r >> 4) * 2 + (c >> 5), rr = r & 15, cc = c & 31, ob = rr * 64 + cc * 2; return st * 1024 + (ob ^ (((ob >> 9) & 1) << 5)); }
__host__ __device__ __forceinline__ void stage_rc(int b, int& R, int& C) { const int st = b / 1024, sb = b % 1024, swz = sb ^ (((sb >> 9) & 1) << 5); R = (st >> 1) * 16 + swz / 64; C = (st & 1) * 32 + (swz % 64) / 2; }
__host__ __device__ __forceinline__ int perm32(int rho) { const int n = rho >> 4, i = rho & 15; return 8 * (i >> 2) + 4 * n + (i & 3); }

struct Unit { int pm, pn; };
struct Gemm { const bf16_t* A; const bf16_t* Bt; int M, N, K; };

struct StaticOrder {
    int nM, nN, nwg, G, c;
    __host__ __device__ void init(int M, int N, int G_, int c_) { nM = M / BM; nN = N / BM; nwg = nM * nN; G = G_; c = c_; }
    __host__ __device__ bool next(int i, Unit& u) const {
        const long L = (long)i * G + c; if (L >= nwg) return false;
        int wgid = (int)L; { const int q = nwg / NXCD, r = nwg % NXCD, xcd = wgid % NXCD, off = wgid / NXCD; wgid = (xcd < r ? xcd * (q + 1) : r * (q + 1) + (xcd - r) * q) + off; }
        const int nig = WGM * nN, gid = wgid / nig, fm = gid * WGM, gsz = (nM - fm) < WGM ? (nM - fm) : WGM;
        u.pm = fm + ((wgid % nig) % gsz); u.pn = (wgid % nig) / gsz; return true;
    }
    __device__ __forceinline__ void a_ready(const Unit&) const {}
    __device__ __forceinline__ void done(const Unit&) const {}
};

__device__ __forceinline__ unsigned cvt_pk_bf16(float lo, float hi) { unsigned r; asm volatile("v_cvt_pk_bf16_f32 %0, %1, %2" : "=v"(r) : "v"(lo), "v"(hi)); return r; }
typedef float f32x2 __attribute__((ext_vector_type(2)));
typedef unsigned u32x2 __attribute__((ext_vector_type(2)));
__device__ __forceinline__ float bflo(unsigned w) { return __uint_as_float(w << 16); }
__device__ __forceinline__ float bfhi(unsigned w) { return __uint_as_float(w & 0xffff0000u); }
__device__ __forceinline__ float sigm(float x) { return __builtin_amdgcn_rcpf(1.f + __expf(-x)); }
__device__ __forceinline__ float silu(float x) { return x * sigm(x); }
__device__ __forceinline__ void row_stats(const float* slab, int row, float& mu, float& rstd) {
    const f32x4* p = (const f32x4*)(slab + (size_t)row * 16);
    const f32x4 a = p[0], b = p[1], c = p[2], d = p[3];
    const float s = ((a[0] + a[2]) + (b[0] + b[2])) + ((c[0] + c[2]) + (d[0] + d[2]));
    const float q = ((a[1] + a[3]) + (b[1] + b[3])) + ((c[1] + c[3]) + (d[1] + d[3]));
    mu = s * (1.0f / 2048.0f);
    const float var = fmaxf(q * (1.0f / 2048.0f) - mu * mu, 0.f);
    rstd = __builtin_amdgcn_rsqf(var + 1e-5f);
}
struct StatTbl { const PG8_LAS int* slot; const PG8_LAS float* tbl;
    __device__ __forceinline__ void get(int pm, int lr, float& mu, float& rs) const { const int sl = slot[pm]; const PG8_LAS float* p = tbl + (sl * 256 + lr) * 2; mu = p[0]; rs = p[1]; } };
template <bool LNF> struct EpiSwiGLU {
    static constexpr bool PERM = true, AFTER_DRAIN = false;
    bf16_t* O; int ldc; StatTbl st; const float* cs; const float* bw;
    __device__ __forceinline__ void operator()(const f32x4 (&acc)[2][2][4][2], const Unit& u, int wr, int wc, int fr, int fq) const {
        const int row0 = u.pm * BM + wr * 64 + fr;
        const int ocol = u.pn * 128 + wc * 32 + 8 * fq;
        const int brow = u.pn * BM + wc * 32 + 8 * fq;
        f32x4 csg[2], csu[2], bwg[2], bwu[2];
        float mu[8], rs[8];
#pragma unroll
        for (int n = 0; n < 2; ++n) {
            if (LNF) { csg[n] = *(const f32x4*)(cs + brow + 4 * n); csu[n] = *(const f32x4*)(cs + brow + 128 + 4 * n); bwg[n] = *(const f32x4*)(bw + brow + 4 * n); bwu[n] = *(const f32x4*)(bw + brow + 128 + 4 * n); }
            else { csg[n] = csu[n] = bwg[n] = bwu[n] = (f32x4){0.f, 0.f, 0.f, 0.f}; }
        }
#pragma unroll
        for (int g = 0; g < 8; ++g) { mu[g] = 0.f; rs[g] = 1.f; if (LNF) st.get(u.pm, (g >> 2) * HALF + wr * 64 + (g & 3) * 16 + fr, mu[g], rs[g]); }
#pragma unroll
        for (int ai = 0; ai < 2; ++ai)
#pragma unroll
            for (int m = 0; m < 4; ++m) {
                const int row = row0 + ai * HALF + m * 16; const float mu_ = mu[ai * 4 + m], rs_ = rs[ai * 4 + m];
                u32x4 w;
#pragma unroll
                for (int n = 0; n < 2; ++n) {
                    f32x4 g = acc[ai][0][m][n], up = acc[ai][1][m][n];
                    if (LNF) { g = (g - mu_ * csg[n]) * rs_ + bwg[n]; up = (up - mu_ * csu[n]) * rs_ + bwu[n]; }
                    const float o0 = silu(g[0]) * up[0], o1 = silu(g[1]) * up[1], o2 = silu(g[2]) * up[2], o3 = silu(g[3]) * up[3];
                    w[2 * n] = cvt_pk_bf16(o0, o1); w[2 * n + 1] = cvt_pk_bf16(o2, o3);
                }
                *(u32x4*)(O + (size_t)row * ldc + ocol) = w;
            }
    }
};
struct EpiProj {
    static constexpr bool PERM = true, AFTER_DRAIN = false;
    bf16_t* O; int ldc; StatTbl st; const float* cs; const float* bw;
    __device__ __forceinline__ void operator()(const f32x4 (&acc)[2][2][4][2], const Unit& u, int wr, int wc, int fr, int fq) const {
        const int col0 = u.pn * BM + wc * 32 + 8 * fq;
        f32x4 cv[2][2], bv[2][2];
        float mu[8], rs[8];
#pragma unroll
        for (int bj = 0; bj < 2; ++bj)
#pragma unroll
            for (int n = 0; n < 2; ++n) { cv[bj][n] = *(const f32x4*)(cs + col0 + bj * HALF + 4 * n); bv[bj][n] = *(const f32x4*)(bw + col0 + bj * HALF + 4 * n); }
#pragma unroll
        for (int g = 0; g < 8; ++g) st.get(u.pm, (g >> 2) * HALF + wr * 64 + (g & 3) * 16 + fr, mu[g], rs[g]);
#pragma unroll
        for (int ai = 0; ai < 2; ++ai)
#pragma unroll
            for (int m = 0; m < 4; ++m) {
                const int lr = ai * HALF + wr * 64 + m * 16 + fr, row = u.pm * BM + lr; const float mu_ = mu[ai * 4 + m], rs_ = rs[ai * 4 + m];
#pragma unroll
                for (int bj = 0; bj < 2; ++bj) {
                    const f32x4 v0 = (acc[ai][bj][m][0] - mu_ * cv[bj][0]) * rs_ + bv[bj][0], v1 = (acc[ai][bj][m][1] - mu_ * cv[bj][1]) * rs_ + bv[bj][1];
                    u32x4 w; w.x = cvt_pk_bf16(v0[0], v0[1]); w.y = cvt_pk_bf16(v0[2], v0[3]); w.z = cvt_pk_bf16(v1[0], v1[1]); w.w = cvt_pk_bf16(v1[2], v1[3]);
                    *(u32x4*)(O + (size_t)row * ldc + col0 + bj * HALF) = w;
                }
            }
    }
};
template <int MODE> struct EpiResid {
    static constexpr bool PERM = false, AFTER_DRAIN = true;
    const float* xres; const bf16_t* zprev; StatTbl st; const float* lg; const float* lb; bf16_t* zb; float* zf; float* oslab; float sc;
    struct Pre { f32x4 x[4]; u32x2 z[4]; };
    __device__ __forceinline__ void load(Pre& P, int row, int col0) const {
#pragma unroll
        for (int q = 0; q < 4; ++q) { const size_t off = (size_t)row * 2048 + col0 + (q >> 1) * HALF + (q & 1) * 16;
            if (MODE == 0) P.x[q] = *(const f32x4*)(xres + off); else P.z[q] = *(const u32x2*)(zprev + off); }
    }
    __device__ __forceinline__ void fused(f32x4 (&acc)[2][2][4][2], const Unit& u, int wr, int wc, int fr, int fq, PG8_LAS unsigned char* lds, int wid, int lane) const {
        const float alpha = 1.18920711500272f;
        const int col0 = u.pn * BM + wc * 32 + 4 * fq;
        PG8_LAS float* P = (PG8_LAS float*)lds;
        f32x4 gv[4], bv[4]; float mu[8], rs[8];
#pragma unroll
        for (int q = 0; q < 4; ++q) { if (MODE != 0) { gv[q] = *(const f32x4*)(lg + col0 + (q >> 1) * HALF + (q & 1) * 16); bv[q] = *(const f32x4*)(lb + col0 + (q >> 1) * HALF + (q & 1) * 16); } else { gv[q] = bv[q] = (f32x4){0.f, 0.f, 0.f, 0.f}; } }
#pragma unroll
        for (int g = 0; g < 8; ++g) { mu[g] = 0.f; rs[g] = 1.f; if (MODE != 0) st.get(u.pm, (g >> 2) * HALF + wr * 64 + (g & 3) * 16 + fr, mu[g], rs[g]); }
        Pre cur, nxt;
        load(cur, u.pm * BM + wr * 64 + fr, col0);
#pragma unroll
        for (int g = 0; g < 8; ++g) {
            const int ai = g >> 2, m = g & 3;
            const int lr = ai * HALF + wr * 64 + m * 16 + fr, row = u.pm * BM + lr;
            if (g < 7) load(nxt, u.pm * BM + ((g + 1) >> 2) * HALF + wr * 64 + ((g + 1) & 3) * 16 + fr, col0);
            float s1 = 0.f, s2 = 0.f;
#pragma unroll
            for (int q = 0; q < 4; ++q) {
                const int bj = q >> 1, n = q & 1; const size_t off = (size_t)row * 2048 + col0 + bj * HALF + n * 16;
                f32x4 res;
                if (MODE == 0) res = cur.x[q];
                else { const u32x2 zz = cur.z[q]; const f32x4 zv = (f32x4){bflo(zz.x), bfhi(zz.x), bflo(zz.y), bfhi(zz.y)}; res = (zv - mu[g]) * rs[g] * gv[q] + bv[q]; }
                const f32x4 z = alpha * res + sc * acc[ai][bj][m][n];
                s1 += (z[0] + z[1]) + (z[2] + z[3]); s2 += (z[0] * z[0] + z[1] * z[1]) + (z[2] * z[2] + z[3] * z[3]);
                if (MODE == 2) *(f32x4*)(zf + off) = z;
                else { u32x2 w; w.x = cvt_pk_bf16(z[0], z[1]); w.y = cvt_pk_bf16(z[2], z[3]); *(u32x2*)(zb + off) = w; }
            }
            s1 += __shfl_xor(s1, 16); s1 += __shfl_xor(s1, 32); s2 += __shfl_xor(s2, 16); s2 += __shfl_xor(s2, 32);
            if (fq == 0) { P[(lr * 4 + wc) * 2] = s1; P[(lr * 4 + wc) * 2 + 1] = s2; }
            cur = nxt;
        }
        __syncthreads();
        const int tid = wid * 64 + lane;
        if (tid < 256) {
            const PG8_LAS float* p = P + tid * 8;
            const float a = (p[0] + p[2]) + (p[4] + p[6]), b = (p[1] + p[3]) + (p[5] + p[7]);
            float* o = oslab + ((size_t)(u.pm * BM + tid) * 8 + u.pn) * 2; o[0] = a; o[1] = b;
        }
    }
};
template <int SECOND> struct EpiBranch {
    static constexpr bool PERM = true, AFTER_DRAIN = false;
    const bf16_t* proj; int ldp, gcol; bf16_t* t1; bf16_t* out;
    struct Pre { u32x4 g[2], t[2]; };
    __device__ __forceinline__ void load(Pre& P, int row, int col0) const {
#pragma unroll
        for (int bj = 0; bj < 2; ++bj) { P.g[bj] = *(const u32x4*)(proj + (size_t)row * ldp + gcol + col0 + bj * HALF); if (SECOND) P.t[bj] = *(const u32x4*)(t1 + (size_t)row * 2048 + col0 + bj * HALF); else P.t[bj] = (u32x4){0u, 0u, 0u, 0u}; }
    }
    __device__ __forceinline__ void operator()(const f32x4 (&acc)[2][2][4][2], const Unit& u, int wr, int wc, int fr, int fq) const {
        const int col0 = u.pn * BM + wc * 32 + 8 * fq, row0 = u.pm * BM + wr * 64 + fr;
        Pre cur, nxt;
        load(cur, row0, col0);
#pragma unroll
        for (int g = 0; g < 8; ++g) {
            const int ai = g >> 2, m = g & 3, row = row0 + ai * HALF + m * 16;
            if (g < 7) load(nxt, row0 + ((g + 1) >> 2) * HALF + ((g + 1) & 3) * 16, col0);
#pragma unroll
            for (int bj = 0; bj < 2; ++bj) {
                const u32x4 gz = cur.g[bj], tz = cur.t[bj];
                const f32x4 a0 = acc[ai][bj][m][0], a1 = acc[ai][bj][m][1];
                const float v0 = bflo(tz.x) + sigm(bflo(gz.x)) * a0[0], v1 = bfhi(tz.x) + sigm(bfhi(gz.x)) * a0[1], v2 = bflo(tz.y) + sigm(bflo(gz.y)) * a0[2], v3 = bfhi(tz.y) + sigm(bfhi(gz.y)) * a0[3];
                const float v4 = bflo(tz.z) + sigm(bflo(gz.z)) * a1[0], v5 = bfhi(tz.z) + sigm(bfhi(gz.z)) * a1[1], v6 = bflo(tz.w) + sigm(bflo(gz.w)) * a1[2], v7 = bfhi(tz.w) + sigm(bfhi(gz.w)) * a1[3];
                u32x4 w; w.x = cvt_pk_bf16(v0, v1); w.y = cvt_pk_bf16(v2, v3); w.z = cvt_pk_bf16(v4, v5); w.w = cvt_pk_bf16(v6, v7);
                *(u32x4*)((SECOND ? out : t1) + (size_t)row * 2048 + col0 + bj * HALF) = w;
            }
            cur = nxt;
        }
    }
};

template <class Epi, class Sched, bool ALIGN_EPI = false, bool SP2 = false>
__device__ __forceinline__ void gemm_phase(PG8_LAS unsigned char* lds, const Gemm g, const Sched& S, const Epi& E) {
    const int tid = threadIdx.x, wid = __builtin_amdgcn_readfirstlane(tid >> 6), lane = tid & 63, wr = wid >> 2, wc = wid & 3, fr = lane & 15, fq = lane >> 4;
    const int K = g.K, nt = K / BK;
    unsigned voffA[2], voffB[2];
#pragma unroll
    for (int i = 0; i < 2; ++i) { int R, C; stage_rc(tid * 16 + i * 8192, R, C); const int Rb = Epi::PERM ? ((R & ~31) + perm32(R & 31)) : R;
        voffA[i] = (unsigned)(R * K + C) * 2u; voffB[i] = (unsigned)(Rb * K + C) * 2u; }
    const size_t kstep = (size_t)(BK * 2);
    const size_t hstep = (size_t)HALF * K * 2;
    const size_t tstep = 2 * hstep;
    const unsigned ldsw = (unsigned)wid * 1024u;
    const int aoff = lds_byte(wr * 64 + fr, fq * 8), boff = lds_byte(wc * 32 + fr, fq * 8);
#define PG8_SA(b, h) (((b) * 2 + (h)) * HTB)
#define PG8_SB(b, h) ((4 + (b) * 2 + (h)) * HTB)
#define PG8_STAGE(bufoff, gbase, voff) do { _Pragma("unroll") for (int _i = 0; _i < 2; ++_i) \
        __builtin_amdgcn_global_load_lds((const unsigned*)((const char*)(gbase) + (voff)[_i]), (PG8_LAS unsigned*)(lds + (bufoff) + ldsw + _i * 8192), 16, 0, 0); } while (0)
#define PG8_LDA(dst, b, h) do { _Pragma("unroll") for (int m = 0; m < 4; ++m) _Pragma("unroll") for (int k = 0; k < 2; ++k) dst[m][k] = *(const PG8_LAS bf16x8*)(lds + PG8_SA(b, h) + aoff + m * 2048 + k * 1024); } while (0)
#define PG8_LDB(dst, b, h) do { _Pragma("unroll") for (int n = 0; n < 2; ++n) _Pragma("unroll") for (int k = 0; k < 2; ++k) dst[n][k] = *(const PG8_LAS bf16x8*)(lds + PG8_SB(b, h) + boff + n * 2048 + k * 1024); } while (0)
#define PG8_MMA(ai, bj, At, Bt) do { __builtin_amdgcn_s_setprio(1); _Pragma("unroll") for (int m = 0; m < 4; ++m) _Pragma("unroll") for (int n = 0; n < 2; ++n) _Pragma("unroll") for (int k = 0; k < 2; ++k) \
        acc[ai][bj][m][n] = __builtin_amdgcn_mfma_f32_16x16x32_bf16(Bt[n][k], At[m][k], acc[ai][bj][m][n], 0, 0, 0); __builtin_amdgcn_s_setprio(0); } while (0)
#define PG8_WAIT_V(n) asm volatile("s_waitcnt vmcnt(" #n ")" ::: "memory")
#define PG8_WAIT_L(n) asm volatile("s_waitcnt lgkmcnt(" #n ")" ::: "memory")
#define PG8_BAR __builtin_amdgcn_s_barrier()
#define PG8_SCHED __builtin_amdgcn_sched_barrier(0)
    Unit cur, nxt; int ui = 0;
    if (!S.next(0, cur)) return;
    f32x4 acc[2][2][4][2];
#pragma unroll
    for (int a = 0; a < 2; ++a)
#pragma unroll
        for (int b = 0; b < 2; ++b)
#pragma unroll
            for (int m = 0; m < 4; ++m)
#pragma unroll
                for (int n = 0; n < 2; ++n) acc[a][b][m][n] = (f32x4){0.f, 0.f, 0.f, 0.f};
    bf16x8 At[4][2], B0[2][2], B1[2][2];
    const char* cA = (const char*)g.A + (size_t)cur.pm * tstep; const char* cB = (const char*)g.Bt + (size_t)cur.pn * tstep;
    S.a_ready(cur);
    if constexpr (SP2) {
        PG8_STAGE(PG8_SB(0, 0), cB, voffB); PG8_STAGE(PG8_SB(0, 1), cB + hstep, voffB); PG8_STAGE(PG8_SA(0, 0), cA, voffA); PG8_STAGE(PG8_SA(0, 1), cA + hstep, voffA);
        if (wr == 1) PG8_BAR;
        PG8_WAIT_V(2); PG8_BAR;
        PG8_STAGE(PG8_SB(1, 0), cB + kstep, voffB); PG8_STAGE(PG8_SA(1, 0), cA + kstep, voffA); PG8_STAGE(PG8_SB(1, 1), cB + hstep + kstep, voffB);
        PG8_WAIT_V(6); PG8_BAR;
    } else {
        PG8_STAGE(PG8_SB(0, 0), cB, voffB); PG8_STAGE(PG8_SA(0, 0), cA, voffA); PG8_STAGE(PG8_SB(0, 1), cB + hstep, voffB); PG8_STAGE(PG8_SA(0, 1), cA + hstep, voffA);
        if (wr == 1) PG8_BAR;
        PG8_WAIT_V(4); PG8_BAR;
        PG8_STAGE(PG8_SB(1, 0), cB + kstep, voffB); PG8_STAGE(PG8_SA(1, 0), cA + kstep, voffA); PG8_STAGE(PG8_SB(1, 1), cB + hstep + kstep, voffB);
        PG8_WAIT_V(6); PG8_BAR;
    }
    for (;;) {
        const bool has_next = S.next(ui + 1, nxt);
        const char* nA = has_next ? (const char*)g.A + (size_t)nxt.pm * tstep : cA; const char* nB = has_next ? (const char*)g.Bt + (size_t)nxt.pn * tstep : cB;
        for (int t = 0; t < nt; t += 2) {
            const bool last = (t == nt - 2);
            const char* a1 = cA + (size_t)(t + 1) * kstep;
            const char* a2 = last ? nA : cA + (size_t)(t + 2) * kstep; const char* b2 = last ? nB : cB + (size_t)(t + 2) * kstep;
            const char* a3 = a2 + kstep; const char* b3 = b2 + kstep;
            if (last && has_next) S.a_ready(nxt);
            if constexpr (SP2) {
            PG8_LDB(B0, 0, 0); PG8_LDB(B1, 0, 1); PG8_SCHED; PG8_LDA(At, 0, 0); PG8_STAGE(PG8_SA(1, 1), a1 + hstep, voffA);
            PG8_WAIT_V(8); PG8_WAIT_L(0); PG8_BAR; PG8_MMA(0, 0, At, B0); PG8_MMA(0, 1, At, B1); PG8_BAR; PG8_SCHED;
            PG8_LDA(At, 0, 1); PG8_STAGE(PG8_SB(0, 0), b2, voffB); PG8_STAGE(PG8_SB(0, 1), b2 + hstep, voffB); PG8_STAGE(PG8_SA(0, 0), a2, voffA);
            PG8_WAIT_V(8); PG8_WAIT_L(0); PG8_BAR; PG8_MMA(1, 0, At, B0); PG8_MMA(1, 1, At, B1); PG8_BAR; PG8_SCHED;
            PG8_LDB(B0, 1, 0); PG8_LDB(B1, 1, 1); PG8_SCHED; PG8_LDA(At, 1, 0); PG8_STAGE(PG8_SA(0, 1), a2 + hstep, voffA);
            PG8_WAIT_V(8); PG8_WAIT_L(0); PG8_BAR; PG8_MMA(0, 0, At, B0); PG8_MMA(0, 1, At, B1); PG8_BAR; PG8_SCHED;
            PG8_LDA(At, 1, 1); PG8_STAGE(PG8_SB(1, 0), b3, voffB); PG8_STAGE(PG8_SB(1, 1), b3 + hstep, voffB); PG8_STAGE(PG8_SA(1, 0), a3, voffA);
            PG8_WAIT_V(8); PG8_WAIT_L(0); PG8_BAR; PG8_MMA(1, 0, At, B0); PG8_MMA(1, 1, At, B1); PG8_BAR; PG8_SCHED;
            } else {
            PG8_LDB(B0, 0, 0); PG8_SCHED; PG8_LDA(At, 0, 0); PG8_STAGE(PG8_SA(1, 1), a1 + hstep, voffA);
            PG8_WAIT_L(8); PG8_BAR; PG8_WAIT_L(0); PG8_MMA(0, 0, At, B0); PG8_BAR; PG8_SCHED;
            PG8_LDB(B1, 0, 1); PG8_STAGE(PG8_SB(0, 0), b2, voffB);
            PG8_BAR; PG8_WAIT_L(0); PG8_MMA(0, 1, At, B1); PG8_BAR;
            PG8_LDA(At, 0, 1); PG8_STAGE(PG8_SA(0, 0), a2, voffA);
            PG8_BAR; PG8_WAIT_L(0); PG8_MMA(1, 0, At, B0); PG8_BAR; PG8_SCHED;
            PG8_STAGE(PG8_SB(0, 1), b2 + hstep, voffB);
            PG8_WAIT_V(6); PG8_BAR; PG8_MMA(1, 1, At, B1); PG8_BAR;
            PG8_LDB(B0, 1, 0); PG8_SCHED; PG8_LDA(At, 1, 0); PG8_STAGE(PG8_SA(0, 1), a2 + hstep, voffA);
            PG8_WAIT_L(8); PG8_BAR; PG8_WAIT_L(0); PG8_MMA(0, 0, At, B0); PG8_BAR; PG8_SCHED;
            PG8_LDB(B1, 1, 1); PG8_STAGE(PG8_SB(1, 0), b3, voffB);
            PG8_BAR; PG8_WAIT_L(0); PG8_MMA(0, 1, At, B1); PG8_BAR;
            PG8_LDA(At, 1, 1); PG8_STAGE(PG8_SA(1, 0), a3, voffA);
            PG8_BAR; PG8_WAIT_L(0); PG8_MMA(1, 0, At, B0); PG8_BAR; PG8_SCHED;
            PG8_STAGE(PG8_SB(1, 1), b3 + hstep, voffB);
            PG8_WAIT_V(6); PG8_BAR; PG8_MMA(1, 1, At, B1); PG8_BAR;
            }
        }
        if constexpr (ALIGN_EPI) { if (wr == 0) PG8_BAR; }
        if constexpr (!Epi::AFTER_DRAIN) { E(acc, cur, wr, wc, fr, fq); S.done(cur); }
        if (!has_next) break;
#pragma unroll
        for (int a = 0; a < 2; ++a)
#pragma unroll
            for (int b = 0; b < 2; ++b)
#pragma unroll
                for (int m = 0; m < 4; ++m)
#pragma unroll
                    for (int n = 0; n < 2; ++n) acc[a][b][m][n] = (f32x4){0.f, 0.f, 0.f, 0.f};
        cur = nxt; cA = nA; cB = nB; ++ui;
        if constexpr (ALIGN_EPI) { if (wr == 1) PG8_BAR; }
    }
    PG8_WAIT_V(0);
    if constexpr (!ALIGN_EPI) { if (wr == 0) PG8_BAR; }
    PG8_BAR;
    if constexpr (Epi::AFTER_DRAIN) { E.fused(acc, cur, wr, wc, fr, fq, lds, wid, lane); S.done(cur); }
#undef PG8_SA
#undef PG8_SB
#undef PG8_STAGE
#undef PG8_LDA
#undef PG8_LDB
#undef PG8_MMA
#undef PG8_WAIT_V
#undef PG8_WAIT_L
#undef PG8_BAR
#undef PG8_SCHED
}
}
using namespace pg8;
#define LAS __attribute__((address_space(3)))
typedef short s16x4 __attribute__((ext_vector_type(4)));
typedef float f32x16 __attribute__((ext_vector_type(16)));
typedef float f32x2 __attribute__((ext_vector_type(2)));
#define MFMA32(a, b, c) __builtin_amdgcn_mfma_f32_32x32x16_bf16((a), (b), (c), 0, 0, 0)
#define MFMA16(a, b, c) __builtin_amdgcn_mfma_f32_16x16x32_bf16((a), (b), (c), 0, 0, 0)
#define LDS_WAIT() asm volatile("s_waitcnt lgkmcnt(0)" ::: "memory")

constexpr int NBATCH = 2, SEQ = 4096, DM = 2048, NMETA = 16, MR = NBATCH * SEQ  , MPAD = 8448  , METAROW = 8192;
constexpr int DFF = 5632, NGU = 2 * DFF, PW = 11008  , NPROJ = 10832;
constexpr int PC_AQ = 0, PC_AK = 1024, PC_AV = 1280, PC_IQ = 1536, PC_HQ = 2560, PC_HF = 3584, PC_HI = 4608, PC_HG = 5632, PC_GA = 6656, PC_GH = 8704, PC_IK = 10752, PC_IW = 10816;
constexpr int NCS = PW + NGU;
constexpr size_t MiB = 1u << 20;
constexpr size_t WS_CTL = 0, CTL_BYTES = 1 * MiB;
constexpr size_t WS_PCS = 1 * MiB, WS_PBW = 4 * MiB, WS_CSV = 7 * MiB, WS_BWV = 7 * MiB + 131072, WS_Z1M = 7 * MiB + 262144, WS_ST1 = 8 * MiB, WS_ST2 = 9 * MiB, WS_ST3 = 10 * MiB;
constexpr size_t WS_WGU1 = 11 * MiB, WS_WD1 = 55 * MiB, WS_H0B = 77 * MiB, WS_G = 110 * MiB, WS_PROJ = 11 * MiB, WS_G2 = 11 * MiB;
constexpr size_t WS_WIN = 201 * MiB, WS_IKN = 201 * MiB, WS_SEL = 202 * MiB, WS_GCH = 206 * MiB, WS_YATT = 207 * MiB, WS_YHG = 223 * MiB;
constexpr size_t WS_WBA = 244 * MiB, WS_WBH = 248 * MiB, WS_WOUT = 252 * MiB, WS_WGU2 = 260 * MiB, WS_WD2 = 304 * MiB, WS_Z1B = 326 * MiB;
constexpr size_t WS_APART = 189 * MiB  , WS_APML = 198 * MiB;
static_assert(WS_PROJ + (size_t)MPAD * PW * 2 <= WS_APART && WS_APML + 128 * 512 * 4 <= WS_WIN, "attention partials gap");
constexpr size_t WS_QT = 359 * MiB, WS_OI = 375 * MiB, WS_LST = 407 * MiB, WS_T1 = 359 * MiB, WS_MRG = 391 * MiB, WS_Z2B = 359 * MiB, WS_END = 440 * MiB;
static_assert(WS_G + (size_t)MPAD * DFF * 2 <= WS_WIN && WS_PROJ + (size_t)MPAD * PW * 2 <= WS_WIN && WS_LST + (size_t)16 * 65 * 32768 <= WS_END && WS_ST1 + (size_t)MPAD * 64 <= WS_ST2, "ws map");
constexpr int CW_AFLAG = 8192;
constexpr int CW_Q1 = 1024, CW_Q3 = 1536, CW_Q9 = 1792;
constexpr int TR_I1 = 2 * 32 * 176 + 32 * 339, TR_I2 = TR_I1 + 32 * 176, TR_I3 = TR_I2 + 2 * 16 * 64 + 32 * 64 + 2 * 32 * 176, TR_I4 = TR_I3 + 32 * 176;
constexpr int CW_Q6 = 2048;
constexpr int CW_BAR = 4096;
constexpr int RING_BYTES = 131072, MISC_OFF = 163840 - 256, WL_OFF = RING_BYTES + 512, STT_OFF = RING_BYTES + 1024, STT_TBL = STT_OFF + 256, LDS_BYTES = 163840;

typedef unsigned v4u __attribute__((ext_vector_type(4)));
__device__ __forceinline__ unsigned f2bf(float f) { unsigned u = __builtin_bit_cast(unsigned, f); return (u + 0x7fffu + ((u >> 16) & 1u)) >> 16; }
__device__ __forceinline__ unsigned pk2(float lo, float hi) { return f2bf(lo) | (f2bf(hi) << 16); }
__device__ __forceinline__ float bf2f(unsigned short h) { return __uint_as_float(((unsigned)h) << 16); }
__device__ __forceinline__ float bfround(float x) { return __uint_as_float(f2bf(x) << 16); }
__device__ __forceinline__ float wave_sum(float v) {
#pragma unroll
    for (int o = 1; o < 64; o <<= 1) v += __shfl_xor(v, o);
    return v;
}
__device__ __forceinline__ int crow(int reg, int h) { return (reg & 3) + 8 * (reg >> 2) + 4 * h; }

#define XB_TMO      128
#define XB_XCNT(j)  (256  + 64 * (j))
#define XB_XSUB(j)  (1280 + 64 * (j))
#define XB_XGEN(j)  (2304 + 64 * (j))
#define XB_TOP      3328
#define XB_TOPGEN   3392
#define XCD_BAR_WORDS 3456
#define XB_SPIN_CAP (1u << 18)

__device__ __forceinline__ unsigned xb_ld(unsigned* p)              { return __hip_atomic_load(p, __ATOMIC_RELAXED, __HIP_MEMORY_SCOPE_AGENT); }
__device__ __forceinline__ unsigned xb_add(unsigned* p, unsigned v) { return __hip_atomic_fetch_add(p, v, __ATOMIC_RELAXED, __HIP_MEMORY_SCOPE_AGENT); }
__device__ __forceinline__ unsigned xb_xcc_id() { return (unsigned)__builtin_amdgcn_s_getreg((3 << 11) | 20) & 0xFu; }
#define XB_SPIN(cond, bar) do { unsigned _sp = 0; while (cond) { __builtin_amdgcn_s_sleep(1); \
    if ((++_sp & 255u) == 0u) { if (xb_ld(&(bar)[XB_TMO])) break; if (_sp > XB_SPIN_CAP) { atomicAdd(&(bar)[XB_TMO], 1u); break; } } } } while (0)

struct XcdBarrier {
    unsigned* bar; unsigned x;
    volatile LAS unsigned* st;
};

__device__ __forceinline__ XcdBarrier xcd_barrier_post(unsigned* bar, volatile LAS unsigned* st) {
    XcdBarrier b; b.bar = bar; b.x = xb_xcc_id(); b.st = st;
    if (threadIdx.x == 0) (void)xb_add(&bar[XB_XCNT(b.x)], 1u);
    return b;
}
__device__ __forceinline__ void xcd_barrier_complete(unsigned* bar, unsigned x, unsigned& nloc, unsigned& nx) {
    const unsigned G = gridDim.x * gridDim.y * gridDim.z;
    unsigned sum, cnt, mine, sp = 0u;
    for (;;) {
        sum = 0u; cnt = 0u; mine = 0u;
#pragma unroll
        for (unsigned j = 0; j < 16; ++j) { const unsigned c = xb_ld(&bar[XB_XCNT(j)]); sum += c; cnt += (c > 0u) ? 1u : 0u; mine = (j == x) ? c : mine; }
        if (sum == G) break;
        __builtin_amdgcn_s_sleep(1);
        if ((++sp & 255u) == 0u) { if (xb_ld(&bar[XB_TMO])) break; if (sp > XB_SPIN_CAP) { atomicAdd(&bar[XB_TMO], 1u); break; } }
    }
    nloc = mine > 0u ? mine : 1u; nx = cnt > 0u ? cnt : 1u;
}

__device__ __forceinline__ void xcd_barrier(const XcdBarrier& b) {
    asm volatile("s_waitcnt vmcnt(0)" ::: "memory");
    __syncthreads();
    if (threadIdx.x == 0) {
        unsigned* bar = b.bar;
        __builtin_amdgcn_s_waitcnt(0);
        unsigned nloc = b.st[0], nx = b.st[1];
        if (nloc == 0u) { xcd_barrier_complete(bar, b.x, nloc, nx); b.st[0] = nloc; b.st[1] = nx; }
        const unsigned old = xb_add(&bar[XB_XSUB(b.x)], 1u);
        const unsigned gen = old / nloc;
        if (old + 1u == (gen + 1u) * nloc) {
            __builtin_amdgcn_fence(__ATOMIC_RELEASE, "agent");
            asm volatile("s_waitcnt vmcnt(0)" ::: "memory");
            const unsigned og = xb_add(&bar[XB_TOP], 1u);
            const unsigned tg = og / nx;
            if (og + 1u == (tg + 1u) * nx) xb_add(&bar[XB_TOPGEN], 1u);
            else XB_SPIN(xb_ld(&bar[XB_TOPGEN]) == tg, bar);
            __builtin_amdgcn_fence(__ATOMIC_ACQUIRE, "agent");
            xb_add(&bar[XB_XGEN(b.x)], 1u);
            asm volatile("s_waitcnt vmcnt(0)" ::: "memory");
        } else {
            XB_SPIN(xb_ld(&bar[XB_XGEN(b.x)]) == gen, bar);
            __builtin_amdgcn_fence(__ATOMIC_ACQUIRE, "agent");
            asm volatile("s_waitcnt vmcnt(0)" ::: "memory");
        }
    }
    __syncthreads();
}
struct Args { const float* in[22]; float* out; unsigned char* ws; int ph_lo, ph_hi, li, pad; };
typedef const __attribute__((address_space(4))) Args* KArgs;
struct Frame {
    LAS unsigned char* lds;
    int tid, lane, wave, G, gw, NGW;
    KArgs ka;
    float* out; unsigned char* ws;
};
#define WSP(T, off) ((T*)(F.ws + (off)))

__device__ __forceinline__ int dst_row(int map, int n) {
    if (map == 1) return ((n >> 7) << 8) + (n & 127);
    if (map == 2) return ((n >> 7) << 8) + 128 + (n & 127);
    if (map == 3) return n < 2560 ? n : (n < 2640 ? n + 8192 : n - 80);
    return n;
}
struct TrJob { const float* W; bf16_t* WT; const float* g; const float* b; int K, N, map, pcol0, item; };
__device__ __forceinline__ bool tr_decode(Frame& F, int it, TrJob& J) {
    constexpr int I_GU = 32 * 176, I_DN = 88 * 64, I_IN = 32 * 339, I_BR = 16 * 64, I_OUT = 32 * 64;
    constexpr int NITEMS = 6 * I_GU + I_IN + 2 * I_BR + I_OUT;
    static_assert(I_DN == I_GU, "items");
    if (it >= NITEMS) return false;
    int r = it; J.g = nullptr; J.b = nullptr; J.pcol0 = 0; J.map = 0;
    if (r < I_GU) { J.W = F.ka->in[2]; J.K = DM; J.N = DFF; J.WT = WSP(bf16_t, WS_WGU1); J.map = 1; J.item = r; return true; } r -= I_GU;
    if (r < I_GU) { J.W = F.ka->in[3]; J.K = DM; J.N = DFF; J.WT = WSP(bf16_t, WS_WGU1); J.map = 2; J.item = r; return true; } r -= I_GU;
    if (r < I_IN) { J.W = F.ka->in[7]; J.K = DM; J.N = NPROJ; J.WT = WSP(bf16_t, WS_WIN); J.map = 3; J.g = F.ka->in[5]; J.b = F.ka->in[6]; J.item = r; return true; } r -= I_IN;
    if (r < I_DN) { J.W = F.ka->in[4]; J.K = DFF; J.N = DM; J.WT = WSP(bf16_t, WS_WD1); J.item = r; return true; } r -= I_DN;
    if (r < I_BR) { J.W = F.ka->in[12]; J.K = 1024; J.N = DM; J.WT = WSP(bf16_t, WS_WBA); J.item = r; return true; } r -= I_BR;
    if (r < I_BR) { J.W = F.ka->in[13]; J.K = 1024; J.N = DM; J.WT = WSP(bf16_t, WS_WBH); J.item = r; return true; } r -= I_BR;
    if (r < I_OUT) { J.W = F.ka->in[14]; J.K = DM; J.N = DM; J.WT = WSP(bf16_t, WS_WOUT); J.item = r; return true; } r -= I_OUT;
    if (r < I_GU) { J.W = F.ka->in[17]; J.K = DM; J.N = DFF; J.WT = WSP(bf16_t, WS_WGU2); J.map = 1; J.g = F.ka->in[15]; J.b = F.ka->in[16]; J.pcol0 = PW; J.item = r; return true; } r -= I_GU;
    if (r < I_GU) { J.W = F.ka->in[18]; J.K = DM; J.N = DFF; J.WT = WSP(bf16_t, WS_WGU2); J.map = 2; J.g = F.ka->in[15]; J.b = F.ka->in[16]; J.pcol0 = PW; J.item = r; return true; } r -= I_GU;
    J.W = F.ka->in[19]; J.K = DFF; J.N = DM; J.WT = WSP(bf16_t, WS_WD2); J.item = r; return true;
}
__device__ __forceinline__ void tr_load(const TrJob& J, int lane, f32x4 (&v)[8]) {
    const int nblk = (J.N + 31) >> 5, kb = J.item / nblk, nb = J.item - kb * nblk, k0 = 64 * kb, nn = 32 * nb + 4 * (lane & 7);
    const float* p = J.W + (size_t)(k0 + (lane >> 3)) * J.N + nn; const bool ok = nn < J.N;
#pragma unroll
    for (int i = 0; i < 8; ++i) v[i] = ok ? *(const f32x4*)(p + (size_t)(8 * i) * J.N) : (f32x4){0.f, 0.f, 0.f, 0.f};
}
__device__ __forceinline__ void tr_process(const TrJob& J, f32x4 (&v)[8], float* pcs, float* pbw, LAS float* scr, int lane) {
    const int nblk = (J.N + 31) >> 5, kb = J.item / nblk, nb = J.item - kb * nblk, k0 = 64 * kb, n0 = 32 * nb, nn = n0 + 4 * (lane & 7);
    if (J.g) {
        float cs[4] = {0.f, 0.f, 0.f, 0.f}, bw[4] = {0.f, 0.f, 0.f, 0.f};
#pragma unroll
        for (int i = 0; i < 8; ++i) { const int k = k0 + (lane >> 3) + 8 * i; const float gk = J.g[k], bk = J.b[k];
#pragma unroll
            for (int e = 0; e < 4; ++e) { bw[e] += bk * v[i][e]; v[i][e] *= gk; cs[e] += bfround(v[i][e]); } }
#pragma unroll
        for (int e = 0; e < 4; ++e) { cs[e] += __shfl_xor(cs[e], 8); cs[e] += __shfl_xor(cs[e], 16); cs[e] += __shfl_xor(cs[e], 32); bw[e] += __shfl_xor(bw[e], 8); bw[e] += __shfl_xor(bw[e], 16); bw[e] += __shfl_xor(bw[e], 32); }
        if (lane < 8 && nn < J.N) {
#pragma unroll
            for (int e = 0; e < 4; ++e) { const int d = J.pcol0 + dst_row(J.map, nn + e); pcs[(size_t)kb * NCS + d] = cs[e]; pbw[(size_t)kb * NCS + d] = bw[e]; } }
    }
#pragma unroll
    for (int i = 0; i < 8; ++i) { LAS float* q = scr + ((lane >> 3) + 8 * i) * 33 + 4 * (lane & 7); q[0] = v[i][0]; q[1] = v[i][1]; q[2] = v[i][2]; q[3] = v[i][3]; }
    LDS_WAIT(); asm volatile("" ::: "memory");
    const int c = lane & 7;
#pragma unroll
    for (int j = 0; j < 4; ++j) { const int n = (lane >> 3) + 8 * j; const LAS float* s = scr + (8 * c) * 33 + n;
        if (n0 + n < J.N) { v4u o; o.x = pk2(s[0 * 33], s[1 * 33]); o.y = pk2(s[2 * 33], s[3 * 33]); o.z = pk2(s[4 * 33], s[5 * 33]); o.w = pk2(s[6 * 33], s[7 * 33]);
            *(v4u*)(J.WT + (size_t)dst_row(J.map, n0 + n) * J.K + k0 + 8 * c) = o; } }
    LDS_WAIT(); asm volatile("" ::: "memory");
}
__device__ __forceinline__ void tr_run(Frame& F, int it0, int stride, int end, LAS float* scr, float* pcs, float* pbw) {
    TrJob j0, j1, j2; f32x4 v0[8], v1[8], v2[8];
    bool h0 = it0 < end && tr_decode(F, it0, j0);
    if (h0) tr_load(j0, F.lane, v0);
    bool h1 = it0 + stride < end && tr_decode(F, it0 + stride, j1);
    if (h1) tr_load(j1, F.lane, v1);
    for (int it = it0; h0; it += stride) {
        const bool h2 = it + 2 * stride < end && tr_decode(F, it + 2 * stride, j2);
        if (h2) tr_load(j2, F.lane, v2);
        tr_process(j0, v0, pcs, pbw, scr, F.lane);
        j0 = j1; h0 = h1; j1 = j2; h1 = h2;
#pragma unroll
        for (int i = 0; i < 8; ++i) { v0[i] = v1[i]; v1[i] = v2[i]; }
    }
}
__device__ __forceinline__ void tr_queue(Frame& F, unsigned* ctr, int lo, int hi) {
    LAS float* scr = (LAS float*)(F.lds + F.wave * 16384);
    volatile LAS int* qslot = (volatile LAS int*)(F.lds + MISC_OFF + 128);
    for (;;) {
        __syncthreads();
        if (F.tid == 0) qslot[0] = (int)__hip_atomic_fetch_add(ctr, 1u, __ATOMIC_RELAXED, __HIP_MEMORY_SCOPE_AGENT);
        __syncthreads();
        const int base = lo + 64 * qslot[0];
        if (base >= hi) break;
        const int end = base + 64 < hi ? base + 64 : hi;
        tr_run(F, base + F.wave, 8, end, scr, WSP(float, WS_PCS), WSP(float, WS_PBW));
    }
}
__device__ __forceinline__ void p0_prologue(Frame& F) {
    LAS float* scr = (LAS float*)(F.lds + F.wave * 16384);
    float* pcs = WSP(float, WS_PCS); float* pbw = WSP(float, WS_PBW);
    {
        tr_run(F, F.gw, F.NGW, TR_I1, scr, pcs, pbw);
    }
    bf16_t* h0b = WSP(bf16_t, WS_H0B); bf16_t* z1b = WSP(bf16_t, WS_Z1B); bf16_t* wint = WSP(bf16_t, WS_WIN);
    for (int m = F.gw; m < MPAD + (PW - NPROJ); m += F.NGW) {
        if (m >= MPAD) { u32x2* o = (u32x2*)(wint + (size_t)(NPROJ + m - MPAD) * DM) + F.lane;
#pragma unroll
            for (int j = 0; j < 8; ++j) o[64 * j] = (u32x2){0u, 0u};
            continue; }
        const float* src = m < MR ? F.ka->in[0] + (size_t)m * DM : (m < MR + NMETA ? F.ka->in[1] + (size_t)(m - MR) * DM : nullptr);
        u32x2* o = (u32x2*)(h0b + (size_t)m * DM) + F.lane;
        f32x4 xv[8];
#pragma unroll
        for (int j = 0; j < 8; ++j) xv[j] = src ? ((const f32x4*)src)[F.lane + 64 * j] : (f32x4){0.f, 0.f, 0.f, 0.f};
#pragma unroll
        for (int j = 0; j < 8; ++j) { u32x2 w; w.x = pk2(xv[j][0], xv[j][1]); w.y = pk2(xv[j][2], xv[j][3]); o[64 * j] = w; }
        if (m >= MR + NMETA) { u32x2* oz = (u32x2*)(z1b + (size_t)m * DM) + F.lane;
#pragma unroll
            for (int j = 0; j < 8; ++j) oz[64 * j] = (u32x2){0u, 0u}; }
    }
}
__device__ __forceinline__ void p1_colsums(Frame& F, int c0, int c1) {
    const float* pcs = WSP(float, WS_PCS); const float* pbw = WSP(float, WS_PBW); float* csv = WSP(float, WS_CSV); float* bwv = WSP(float, WS_BWV);
    for (int i = c0 + blockIdx.x * 512 + F.tid; i < c1; i += F.G * 512) {
        float cs = 0.f, bw = 0.f;
        if (!(i >= NPROJ && i < PW)) {
#pragma unroll 8
            for (int kb = 0; kb < 32; ++kb) { cs += pcs[(size_t)kb * NCS + i]; bw += pbw[(size_t)kb * NCS + i]; } }
        csv[i] = cs; bwv[i] = bw;
    }
}
__device__ __forceinline__ void p2_meta_down(Frame& F) {
    const bf16_t* G = WSP(bf16_t, WS_G); const bf16_t* wd = WSP(bf16_t, WS_WD1); float* z1m = WSP(float, WS_Z1M); bf16_t* z1b = WSP(bf16_t, WS_Z1B);
    const int lane = F.lane;
    for (int c = F.gw; c < DM; c += F.NGW) {
        const bf16_t* wrow = wd + (size_t)c * DFF;
        float acc[16];
#pragma unroll
        for (int r = 0; r < 16; ++r) acc[r] = 0.f;
        for (int i = 0; i < 11; ++i) {
            const int k = 8 * lane + 512 * i;
            const v4u wv = *(const v4u*)(wrow + k);
            const float w0 = bflo(wv.x), w1 = bfhi(wv.x), w2 = bflo(wv.y), w3 = bfhi(wv.y), w4 = bflo(wv.z), w5 = bfhi(wv.z), w6 = bflo(wv.w), w7 = bfhi(wv.w);
#pragma unroll
            for (int r = 0; r < 16; ++r) { const v4u gv = *(const v4u*)(G + (size_t)(METAROW + r) * DFF + k);
                acc[r] += (bflo(gv.x) * w0 + bfhi(gv.x) * w1) + (bflo(gv.y) * w2 + bfhi(gv.y) * w3) + (bflo(gv.z) * w4 + bfhi(gv.z) * w5) + (bflo(gv.w) * w6 + bfhi(gv.w) * w7); }
        }
        float v8[8], v4[4], v2[2], v1;
#pragma unroll
        for (int i = 0; i < 8; ++i) { const bool hi = (lane & 32) != 0; const float send = hi ? acc[i] : acc[8 + i], keep = hi ? acc[8 + i] : acc[i]; v8[i] = keep + __shfl_xor(send, 32); }
#pragma unroll
        for (int i = 0; i < 4; ++i) { const bool hi = (lane & 16) != 0; const float send = hi ? v8[i] : v8[4 + i], keep = hi ? v8[4 + i] : v8[i]; v4[i] = keep + __shfl_xor(send, 16); }
#pragma unroll
        for (int i = 0; i < 2; ++i) { const bool hi = (lane & 8) != 0; const float send = hi ? v4[i] : v4[2 + i], keep = hi ? v4[2 + i] : v4[i]; v2[i] = keep + __shfl_xor(send, 8); }
        { const bool hi = (lane & 4) != 0; const float send = hi ? v2[0] : v2[1], keep = hi ? v2[1] : v2[0]; v1 = keep + __shfl_xor(send, 4); }
        v1 += __shfl_xor(v1, 1); v1 += __shfl_xor(v1, 2);
        const int r = ((lane >> 5) & 1) * 8 + ((lane >> 4) & 1) * 4 + ((lane >> 3) & 1) * 2 + ((lane >> 2) & 1);
        if ((lane & 3) == 0) { const float z = 1.18920711500272f * F.ka->in[1][(size_t)r * DM + c] + 0.5f * v1; z1m[(size_t)r * DM + c] = z; z1b[(size_t)(METAROW + r) * DM + c] = (bf16_t)f2bf(z); }
    }
}
__device__ __forceinline__ StatTbl fill_stats(Frame& F, const StaticOrder& S, const float* slab, const float* z1m) {
    LAS int* slot = (LAS int*)(F.lds + STT_OFF); LAS float* tbl = (LAS float*)(F.lds + STT_TBL);
    if (F.tid < 64) slot[F.tid] = -1;
    __syncthreads();
    int ns = 0; Unit u;
    for (int i = 0; S.next(i, u); ++i) {
        const int have = slot[u.pm];
        __syncthreads();
        if (have < 0) {
            if (F.tid == 0) slot[u.pm] = ns;
            if (u.pm == 32) {
                if (F.tid < 256) { tbl[(ns * 256 + F.tid) * 2] = 0.f; tbl[(ns * 256 + F.tid) * 2 + 1] = 0.f; }
                __syncthreads();
#pragma unroll
                for (int q = 0; q < 2; ++q) { const int r = 2 * F.wave + q; float s1 = 0.f, s2 = 0.f;
#pragma unroll
                    for (int j = 0; j < 8; ++j) { const f32x4 v = ((const f32x4*)(z1m + (size_t)r * DM))[F.lane + 64 * j]; s1 += (v[0] + v[1]) + (v[2] + v[3]); s2 += (v[0] * v[0] + v[1] * v[1]) + (v[2] * v[2] + v[3] * v[3]); }
                    s1 = wave_sum(s1); s2 = wave_sum(s2);
                    const float mu = s1 * (1.f / DM), var = fmaxf(s2 * (1.f / DM) - mu * mu, 0.f);
                    if (F.lane == 0) { tbl[(ns * 256 + r) * 2] = mu; tbl[(ns * 256 + r) * 2 + 1] = __builtin_amdgcn_rsqf(var + 1e-5f); } }
            } else if (F.tid < 256) { float mu, rs; row_stats(slab, u.pm * 256 + F.tid, mu, rs); tbl[(ns * 256 + F.tid) * 2] = mu; tbl[(ns * 256 + F.tid) * 2 + 1] = rs; }
            ++ns;
            __syncthreads();
        }
    }
    StatTbl t; t.slot = slot; t.tbl = tbl; return t;
}
__device__ __forceinline__ void p4_ikn(Frame& F) {
    const bf16_t* proj = WSP(bf16_t, WS_PROJ); bf16_t* ikn = WSP(bf16_t, WS_IKN);
    const float g = F.ka->in[8][F.lane], b = F.ka->in[9][F.lane];
    for (int row = F.gw; row < MR; row += F.NGW) {
        const float v = bf2f(proj[(size_t)row * PW + PC_IK + F.lane]);
        const float mu = wave_sum(v) * (1.f / 64.f); const float d = v - mu; const float var = wave_sum(d * d) * (1.f / 64.f);
        ikn[(size_t)row * 64 + F.lane] = (bf16_t)f2bf(d * __builtin_amdgcn_rsqf(var + 1e-5f) * g + b);
    }
}
constexpr int QP = 136, TP = 72;
__device__ __forceinline__ void h1_item(Frame& F, int bh, int c) {
    const int b = bh >> 3, h = bh & 7, tid = F.tid, lane = F.lane, w = F.wave;
    const bf16_t* proj = WSP(bf16_t, WS_PROJ);
    LAS bf16_t* Qs = (LAS bf16_t*)F.lds; LAS bf16_t* Ks = Qs + 64 * QP; LAS bf16_t* KhT = Ks + 64 * QP; LAS bf16_t* VT = KhT + 128 * TP; LAS float* tot = (LAS float*)(VT + 128 * TP);
    const int ch = tid & 127, part = tid >> 7;
    const float l0 = F.ka->in[10][h * 128 + ch], l1 = F.ka->in[10][1024 + h * 128 + ch];
    const float lb = 1.f / (1.f + __expf(l1 - l0));
    float fgv[16], cum[16]; float run = 0.f;
    const size_t prow0 = c == 0 ? (size_t)METAROW : (size_t)(b * SEQ + (c - 1) * 64 + 16 * part);
    const bf16_t* pf = proj + prow0 * PW + PC_HF + h * 128 + ch; const bf16_t* pq = proj + prow0 * PW + PC_HQ + h * 128 + ch; const bf16_t* pv = proj + prow0 * PW + PC_HI + h * 128 + ch;
    unsigned short fraw[16], qraw[16], vraw[16];
#pragma unroll
    for (int i = 0; i < 16; ++i) fraw[i] = pf[(size_t)i * PW];
#pragma unroll
    for (int i = 0; i < 16; ++i) { qraw[i] = pq[(size_t)i * PW]; vraw[i] = pv[(size_t)i * PW]; }
#pragma unroll
    for (int i = 0; i < 16; ++i) { const int tt = 16 * part + i; const bool valid = (c > 0) || (tt < NMETA);
        const float f = bf2f(fraw[i]);
        const float fg = valid ? lb + (1.f - lb) * sigm(f) : 1.f; run += __logf(fg); fgv[i] = fg; cum[i] = run; }
    tot[part * 128 + ch] = run;
    __syncthreads();
    float off = 0.f, blast = 0.f;
#pragma unroll
    for (int p = 0; p < 4; ++p) { const float t = tot[p * 128 + ch]; if (p < part) off += t; blast += t; }
    if (part == 0) WSP(float, WS_GCH)[(size_t)(bh * 65 + c) * 128 + ch] = __expf(blast);
    bf16_t* qtg = WSP(bf16_t, WS_QT);
#pragma unroll
    for (int i = 0; i < 16; ++i) { const int tt = 16 * part + i; const bool valid = (c > 0) || (tt < NMETA);
        const float bq = off + cum[i], fg = fgv[i];
        const float q = valid ? bf2f(qraw[i]) : 0.f, v = valid ? bf2f(vraw[i]) : 0.f;
        const float qt = silu(q) * __expf(bq), kk = 1.f - fg, kt = kk * __expf(-bq), kh = kk * __expf(blast - bq);
        const bf16_t qb = (bf16_t)f2bf(qt);
        Qs[tt * QP + ch] = qb; Ks[tt * QP + ch] = (bf16_t)f2bf(kt); KhT[ch * TP + tt] = (bf16_t)f2bf(kh); VT[ch * TP + tt] = (bf16_t)f2bf(v);
        if (c > 0) qtg[((size_t)(bh * 64 + (c - 1)) * 64 + tt) * 128 + ch] = qb; }
    __syncthreads();
    const int tb = w >> 2, dvb = w & 3, r = lane & 31, hh = lane >> 5;
    if (c > 0) {
        f32x16 o;
#pragma unroll
        for (int i = 0; i < 16; ++i) o[i] = 0.f;
        for (int sb = 0; sb <= tb; ++sb) {
            f32x16 x;
#pragma unroll
            for (int i = 0; i < 16; ++i) x[i] = 0.f;
#pragma unroll
            for (int ks = 0; ks < 8; ++ks) { const bf16x8 a = *(const LAS bf16x8*)(Ks + (32 * sb + r) * QP + 16 * ks + 8 * hh); const bf16x8 bq = *(const LAS bf16x8*)(Qs + (32 * tb + r) * QP + 16 * ks + 8 * hh); x = MFMA32(a, bq, x); }
            if (sb == tb) {
#pragma unroll
                for (int i = 0; i < 16; ++i) if (crow(i, hh) > r) x[i] = 0.f; }
#pragma unroll
            for (int s2 = 0; s2 < 2; ++s2) {
                bf16x8 xb;
#pragma unroll
                for (int j = 0; j < 8; ++j) xb[j] = (short)f2bf(x[8 * s2 + j]);
                const LAS bf16_t* vp = VT + (32 * dvb + r) * TP + 32 * sb + 16 * s2 + 4 * hh;
                const s16x4 lo = *(const LAS s16x4*)vp, hi = *(const LAS s16x4*)(vp + 8);
                const bf16x8 a2 = __builtin_shufflevector(lo, hi, 0, 1, 2, 3, 4, 5, 6, 7);
                o = MFMA32(a2, xb, o);
            }
        }
        float* oi = WSP(float, WS_OI) + ((size_t)(bh * 64 + (c - 1)) * 8 + w) * 1024 + lane;
#pragma unroll
        for (int i = 0; i < 16; ++i) oi[i * 64] = o[i];
    }
    if (c < 64) {
        bf16_t* lst = WSP(bf16_t, WS_LST) + (size_t)(bh * 65 + c) * 16384;
#pragma unroll
        for (int q2 = 0; q2 < 2; ++q2) { const int db = (w >> 2) * 2 + q2;
            f32x16 l;
#pragma unroll
            for (int i = 0; i < 16; ++i) l[i] = 0.f;
#pragma unroll
            for (int ks = 0; ks < 4; ++ks) { const bf16x8 a = *(const LAS bf16x8*)(VT + (32 * dvb + r) * TP + 16 * ks + 8 * hh); const bf16x8 bb = *(const LAS bf16x8*)(KhT + (32 * db + r) * TP + 16 * ks + 8 * hh); l = MFMA32(a, bb, l); }
#pragma unroll
            for (int i = 0; i < 16; ++i) lst[(size_t)(32 * dvb + crow(i, hh)) * 128 + 32 * db + r] = (bf16_t)f2bf(l[i]); }
    }
    __syncthreads();
}
__device__ __forceinline__ void h2_item(Frame& F, int it) {
    const int bh = it >> 4, part = it & 15, dv = 8 * part + (F.tid >> 6), d0 = 2 * (F.tid & 63);
    bf16_t* p = WSP(bf16_t, WS_LST) + ((size_t)bh * 65 * 128 + dv) * 128 + d0; const float* g = WSP(float, WS_GCH) + (size_t)bh * 65 * 128 + d0;
    float s0 = 0.f, s1 = 0.f;
#pragma unroll 8
    for (int c = 0; c < 64; ++c) { const unsigned l = *(const unsigned*)(p + (size_t)c * 16384); const f32x2 gg = *(const f32x2*)(g + c * 128);
        s0 = gg.x * s0 + bflo(l); s1 = gg.y * s1 + bfhi(l); *(unsigned*)(p + (size_t)c * 16384) = pk2(s0, s1); }
}
__device__ __forceinline__ void h3_wave(Frame& F, int bh, int c, int tb) {
    const int b = bh >> 3, h = bh & 7, lane = F.lane, r = lane & 31, hh = lane >> 5;
    const bf16_t* st = WSP(bf16_t, WS_LST) + (size_t)(bh * 65 + (c - 1)) * 16384; const bf16_t* qg = WSP(bf16_t, WS_QT) + (size_t)(bh * 64 + (c - 1)) * 8192 + (size_t)(32 * tb + r) * 128 + 8 * hh;
    const float* oi = WSP(float, WS_OI) + ((size_t)(bh * 64 + (c - 1)) * 8 + tb * 4) * 1024 + lane;
    const size_t row = (size_t)(b * SEQ + (c - 1) * 64 + 32 * tb + r);
    const bf16_t* gp = WSP(bf16_t, WS_PROJ) + row * PW + PC_HG + h * 128 + 4 * hh; const float* ng = F.ka->in[11] + h * 128 + 4 * hh;
    bf16x8 bq[8];
#pragma unroll
    for (int ks = 0; ks < 8; ++ks) bq[ks] = *(const bf16x8*)(qg + 16 * ks);
    f32x16 o[4];
#pragma unroll
    for (int d = 0; d < 4; ++d)
#pragma unroll
        for (int i = 0; i < 16; ++i) o[d][i] = oi[d * 1024 + i * 64];
    u32x2 gz[16];
#pragma unroll
    for (int d = 0; d < 4; ++d)
#pragma unroll
        for (int g4 = 0; g4 < 4; ++g4) gz[d * 4 + g4] = *(const u32x2*)(gp + 32 * d + 8 * g4);
#pragma unroll
    for (int d = 0; d < 4; ++d) {
        bf16x8 a[8];
#pragma unroll
        for (int ks = 0; ks < 8; ++ks) a[ks] = *(const bf16x8*)(st + (size_t)(32 * d + r) * 128 + 16 * ks + 8 * hh);
#pragma unroll
        for (int ks = 0; ks < 8; ++ks) o[d] = MFMA32(a[ks], bq[ks], o[d]);
    }
    float ss = 0.f;
#pragma unroll
    for (int d = 0; d < 4; ++d)
#pragma unroll
        for (int i = 0; i < 16; ++i) ss += o[d][i] * o[d][i];
    { const auto sw = __builtin_amdgcn_permlane32_swap(__float_as_uint(ss), __float_as_uint(ss), false, false); ss = __uint_as_float(sw[0]) + __uint_as_float(sw[1]); }
    const float rstd = __builtin_amdgcn_rsqf(ss * (1.f / 128.f) + 1e-6f);
    bf16_t* yp = WSP(bf16_t, WS_YHG) + row * 1024 + h * 128 + 4 * hh;
#pragma unroll
    for (int d = 0; d < 4; ++d)
#pragma unroll
        for (int g4 = 0; g4 < 4; ++g4) { const f32x4 n4 = *(const f32x4*)(ng + 32 * d + 8 * g4); const u32x2 g2 = gz[d * 4 + g4];
            u32x2 wv; wv.x = pk2(o[d][4 * g4] * rstd * n4[0] * silu(bflo(g2.x)), o[d][4 * g4 + 1] * rstd * n4[1] * silu(bfhi(g2.x)));
            wv.y = pk2(o[d][4 * g4 + 2] * rstd * n4[2] * silu(bflo(g2.y)), o[d][4 * g4 + 3] * rstd * n4[3] * silu(bfhi(g2.y)));
            *(u32x2*)(yp + 32 * d + 8 * g4) = wv; }
}
__device__ __forceinline__ int wave_total(int v) {
    v += __builtin_amdgcn_update_dpp(0, v, 0xB1, 0xF, 0xF, true);
    v += __builtin_amdgcn_update_dpp(0, v, 0x4E, 0xF, 0xF, true);
    v += __builtin_amdgcn_update_dpp(0, v, 0x141, 0xF, 0xF, true);
    v += __builtin_amdgcn_update_dpp(0, v, 0x140, 0xF, 0xF, true);
    v += __builtin_amdgcn_update_dpp(0, v, 0x142, 0xA, 0xF, true);
    v += __builtin_amdgcn_update_dpp(0, v, 0x143, 0xC, 0xF, true);
    return __builtin_amdgcn_readlane(v, 63);
}
__device__ __forceinline__ void cnt4_ge(int& cnt, unsigned mid, unsigned a, unsigned b, unsigned c, unsigned d) {
    unsigned long long m0, m1, m2, m3; int t0, t1, t2, t3;
    asm volatile("v_cmp_le_u32_e64 %1, %9, %10\n\tv_cmp_le_u32_e64 %2, %9, %11\n\tv_cmp_le_u32_e64 %3, %9, %12\n\tv_cmp_le_u32_e64 %4, %9, %13\n\t"
                 "s_bcnt1_i32_b64 %5, %1\n\ts_bcnt1_i32_b64 %6, %2\n\ts_bcnt1_i32_b64 %7, %3\n\ts_bcnt1_i32_b64 %8, %4\n\t"
                 "s_add_i32 %0, %0, %5\n\ts_add_i32 %0, %0, %6\n\ts_add_i32 %0, %0, %7\n\ts_add_i32 %0, %0, %8"
                 : "+s"(cnt), "=&s"(m0), "=&s"(m1), "=&s"(m2), "=&s"(m3), "=&s"(t0), "=&s"(t1), "=&s"(t2), "=&s"(t3)
                 : "s"(mid), "v"(a), "v"(b), "v"(c), "v"(d) : "scc");
}
__device__ __forceinline__ void cnt4_gt(int& cnt, unsigned mid, unsigned a, unsigned b, unsigned c, unsigned d) {
    unsigned long long m0, m1, m2, m3; int t0, t1, t2, t3;
    asm volatile("v_cmp_lt_u32_e64 %1, %9, %10\n\tv_cmp_lt_u32_e64 %2, %9, %11\n\tv_cmp_lt_u32_e64 %3, %9, %12\n\tv_cmp_lt_u32_e64 %4, %9, %13\n\t"
                 "s_bcnt1_i32_b64 %5, %1\n\ts_bcnt1_i32_b64 %6, %2\n\ts_bcnt1_i32_b64 %7, %3\n\ts_bcnt1_i32_b64 %8, %4\n\t"
                 "s_add_i32 %0, %0, %5\n\ts_add_i32 %0, %0, %6\n\ts_add_i32 %0, %0, %7\n\ts_add_i32 %0, %0, %8"
                 : "+s"(cnt), "=&s"(m0), "=&s"(m1), "=&s"(m2), "=&s"(m3), "=&s"(t0), "=&s"(t1), "=&s"(t2), "=&s"(t3)
                 : "s"(mid), "v"(a), "v"(b), "v"(c), "v"(d) : "scc");
}
__device__ __forceinline__ void cnt4_gef(int& cnt, float mid, float a, float b, float c, float d) {
    unsigned long long m0, m1, m2, m3; int t0, t1, t2, t3;
    asm volatile("v_cmp_le_f32_e64 %1, %9, %10\n\tv_cmp_le_f32_e64 %2, %9, %11\n\tv_cmp_le_f32_e64 %3, %9, %12\n\tv_cmp_le_f32_e64 %4, %9, %13\n\t"
                 "s_bcnt1_i32_b64 %5, %1\n\ts_bcnt1_i32_b64 %6, %2\n\ts_bcnt1_i32_b64 %7, %3\n\ts_bcnt1_i32_b64 %8, %4\n\t"
                 "s_add_i32 %0, %0, %5\n\ts_add_i32 %0, %0, %6\n\ts_add_i32 %0, %0, %7\n\ts_add_i32 %0, %0, %8"
                 : "+s"(cnt), "=&s"(m0), "=&s"(m1), "=&s"(m2), "=&s"(m3), "=&s"(t0), "=&s"(t1), "=&s"(t2), "=&s"(t3)
                 : "s"(mid), "v"(a), "v"(b), "v"(c), "v"(d) : "scc");
}
__device__ __forceinline__ void cnt4_gtf(int& cnt, float mid, float a, float b, float c, float d) {
    unsigned long long m0, m1, m2, m3; int t0, t1, t2, t3;
    asm volatile("v_cmp_lt_f32_e64 %1, %9, %10\n\tv_cmp_lt_f32_e64 %2, %9, %11\n\tv_cmp_lt_f32_e64 %3, %9, %12\n\tv_cmp_lt_f32_e64 %4, %9, %13\n\t"
                 "s_bcnt1_i32_b64 %5, %1\n\ts_bcnt1_i32_b64 %6, %2\n\ts_bcnt1_i32_b64 %7, %3\n\ts_bcnt1_i32_b64 %8, %4\n\t"
                 "s_add_i32 %0, %0, %5\n\ts_add_i32 %0, %0, %6\n\ts_add_i32 %0, %0, %7\n\ts_add_i32 %0, %0, %8"
                 : "+s"(cnt), "=&s"(m0), "=&s"(m1), "=&s"(m2), "=&s"(m3), "=&s"(t0), "=&s"(t1), "=&s"(t2), "=&s"(t3)
                 : "s"(mid), "v"(a), "v"(b), "v"(c), "v"(d) : "scc");
}
__device__ __forceinline__ float wave_maxf(float v) {
#pragma unroll
    for (int o = 1; o < 64; o <<= 1) v = fmaxf(v, __shfl_xor(v, o));
    return v;
}
__device__ __forceinline__ void idx_item(Frame& F, int b, int qblk) {
    const int lane = F.lane, w = F.wave;
#ifdef TS_A0
    unsigned long long* tsx = (unsigned long long*)(F.ws + WS_CTL + 65536); const bool tsl = blockIdx.x == 0 && F.tid == 0;
    const unsigned long long t0_ = __builtin_amdgcn_s_memrealtime();
#endif
    const bf16_t* proj = WSP(bf16_t, WS_PROJ); const bf16_t* ikn = WSP(bf16_t, WS_IKN);
    LAS unsigned* sc = (LAS unsigned*)F.lds;
    const int r0 = 8 * qblk, ntile = (r0 + 8 + 31) >> 5;
    const int r = lane & 31, hh = lane >> 5;
    {
        LAS float* wl = (LAS float*)(F.lds + WL_OFF);
        LAS bf16_t* iql = (LAS bf16_t*)(wl + 128);
        if (F.tid < 128) wl[F.tid] = bf2f(proj[(size_t)(b * SEQ + r0 + (F.tid >> 4)) * PW + PC_IW + (F.tid & 15)]) * (1.f / 32.f);
        {
            const int q = F.tid >> 6, d = F.tid & 63; const bf16_t* pw = proj + (size_t)(b * SEQ + r0 + q) * PW;
            unsigned short wr_[16], qr_[16];
#pragma unroll
            for (int hd = 0; hd < 16; ++hd) { wr_[hd] = pw[PC_IW + hd]; qr_[hd] = pw[PC_IQ + hd * 64 + d]; }
            float acc_ = 0.f;
#pragma unroll
            for (int hd = 0; hd < 16; ++hd) acc_ += bf2f(wr_[hd]) * bf2f(qr_[hd]);
            iql[q * 64 + d] = (bf16_t)f2bf(acc_ * (1.f / 32.f));
        }
        bf16x8 a[4][4];
#pragma unroll
        for (int p = 0; p < 4; ++p) {
            const size_t rowq = (size_t)(b * SEQ + r0 + 2 * p + (r >> 4));
#pragma unroll
            for (int ks = 0; ks < 4; ++ks) a[p][ks] = *(const bf16x8*)(proj + rowq * PW + PC_IQ + (r & 15) * 64 + 16 * ks + 8 * hh);
        }
        __syncthreads();
        bf16x8 al[4];
#pragma unroll
        for (int ks = 0; ks < 4; ++ks) { bf16x8 z = {0, 0, 0, 0, 0, 0, 0, 0}; if (r < 8) z = *(const LAS bf16x8*)(iql + (2 * (r & 3) + (r >> 2)) * 64 + 16 * ks + 8 * hh); al[ks] = z; }
        bf16x8 bc[4], bn[4];
#define IDX_LOAD(dst, kt) do { int kt_ = (kt); if (kt_ >= ntile) kt_ = w < ntile ? w : 0; const bf16_t* kp_ = ikn + (size_t)(b * SEQ + 32 * kt_ + r) * 64 + 8 * hh; \
    _Pragma("unroll") for (int ks = 0; ks < 4; ++ks) dst[ks] = *(const bf16x8*)(kp_ + 16 * ks); } while (0)
        IDX_LOAD(bc, w);
        for (int kt = w; kt < ntile; kt += 8) {
            IDX_LOAD(bn, kt + 8);
            const int key = 32 * kt + r;
            f32x16 xl;
#pragma unroll
            for (int i = 0; i < 16; ++i) xl[i] = 0.f;
#pragma unroll
            for (int ks = 0; ks < 4; ++ks) xl = MFMA32(al[ks], bc[ks], xl);
#pragma unroll
            for (int p = 0; p < 4; ++p) {
                f32x16 x;
#pragma unroll
                for (int i = 0; i < 16; ++i) x[i] = 0.f;
#pragma unroll
                for (int ks = 0; ks < 4; ++ks) x = MFMA32(a[p][ks], bc[ks], x);
                const LAS f32x4* wq = (const LAS f32x4*)(wl + (2 * p) * 16 + 4 * hh);
                const f32x4 w0 = wq[0], w1 = wq[2], w2 = wq[4], w3 = wq[6];
                float p0 = 0.f, p1 = 0.f;
#pragma unroll
                for (int i = 0; i < 4; ++i) { p0 += w0[i] * fabsf(x[i]); p0 += w1[i] * fabsf(x[4 + i]); p1 += w2[i] * fabsf(x[8 + i]); p1 += w3[i] * fabsf(x[12 + i]); }
                const auto sw = __builtin_amdgcn_permlane32_swap(__float_as_uint(p0), __float_as_uint(p1), false, false);
                const float tot = 0.5f * ((__uint_as_float(sw[0]) + __uint_as_float(sw[1])) + xl[p]);
                sc[(2 * p + hh) * 4096 + key] = key > r0 + 2 * p + hh ? 0xff800000u : __float_as_uint(tot);
            }
#pragma unroll
            for (int ks = 0; ks < 4; ++ks) bc[ks] = bn[ks];
        }
#undef IDX_LOAD
    }
    __syncthreads();
#ifdef TS_A0
    const unsigned long long t1_ = __builtin_amdgcn_s_memrealtime(); if (tsl) tsx[21] += t1_ - t0_;
#endif
    {
        const int rq = r0 + w, nvalid = rq + 1, nk = ntile * 32;
        float k[64];
#pragma unroll
        for (int i = 0; i < 64; ++i) { const int idx = lane + 64 * i; k[i] = idx < nk ? __uint_as_float(sc[w * 4096 + idx]) : -INFINITY; }
        float thr = -INFINITY; bool exact = false, search = nvalid > 256;
        if (search) {
            float mx = -INFINITY, mn = INFINITY;
#pragma unroll
            for (int i = 0; i < 64; ++i) { mx = fmaxf(mx, k[i]); mn = fminf(mn, k[i] == -INFINITY ? INFINITY : k[i]); }
            mx = wave_maxf(mx); mn = -wave_maxf(-mn);
            float lo = mn, hi = mx;
            lo = __uint_as_float(__builtin_amdgcn_readfirstlane(__float_as_uint(lo))); hi = __uint_as_float(__builtin_amdgcn_readfirstlane(__float_as_uint(hi)));
            { int c = 0;
#pragma unroll
              for (int i = 0; i < 64; i += 4) cnt4_gef(c, hi, k[i], k[i + 1], k[i + 2], k[i + 3]);
              if (c >= 256) lo = hi; }
            for (int it = 0; it < 64 && lo < hi; ++it) {
                const float mid = 0.5f * lo + 0.5f * hi;
                if (!(mid > lo) || !(mid < hi)) break;
                int cnt = 0;
#pragma unroll
                for (int i = 0; i < 64; i += 4) cnt4_gef(cnt, mid, k[i], k[i + 1], k[i + 2], k[i + 3]);
                if (cnt == 256) { lo = mid; exact = true; break; }
                if (cnt > 256) lo = mid; else hi = mid;
            }
            thr = lo;
        }
        int quota = 0;
        if (search && !exact) { int ngt = 0;
#pragma unroll
            for (int i = 0; i < 64; i += 4) cnt4_gtf(ngt, thr, k[i], k[i + 1], k[i + 2], k[i + 3]);
            quota = 256 - ngt; }
        int eqrun = 0; unsigned long long myword = 0ull;
        if (!search || exact) {
#pragma unroll
            for (int i = 0; i < 64; ++i) { const unsigned long long m = __ballot(search ? (k[i] >= thr) : (k[i] > -INFINITY)); if (lane == i) myword = m; }
        } else {
#pragma unroll
            for (int i = 0; i < 64; ++i) { const bool gt = k[i] > thr, eq = k[i] == thr;
                const unsigned long long meq = __ballot(eq); const int eqb = eqrun + (int)__builtin_amdgcn_mbcnt_hi((unsigned)(meq >> 32), __builtin_amdgcn_mbcnt_lo((unsigned)meq, 0u));
                const bool take = gt || (eq && eqb < quota);
                const unsigned long long m = __ballot(take);
                if (lane == i) myword = m;
                eqrun += __popcll(meq); }
        }
        WSP(unsigned long long, WS_SEL)[(size_t)(b * SEQ + rq) * 64 + lane] = myword;
    }
    __syncthreads();
#ifdef TS_A0
    if (tsl) tsx[23] += __builtin_amdgcn_s_memrealtime() - t1_;
#endif
}
__device__ __forceinline__ bf16x8 pack8_bf16(float a0, float a1, float a2, float a3, float a4, float a5, float a6, float a7) {
    u32x4 p;
    asm volatile("v_cvt_pk_bf16_f32 %0, %4, %5\n\tv_cvt_pk_bf16_f32 %1, %6, %7\n\tv_cvt_pk_bf16_f32 %2, %8, %9\n\tv_cvt_pk_bf16_f32 %3, %10, %11\n\ts_nop 1"
                 : "=&v"(p[0]), "=&v"(p[1]), "=&v"(p[2]), "=&v"(p[3]) : "v"(a0), "v"(a1), "v"(a2), "v"(a3), "v"(a4), "v"(a5), "v"(a6), "v"(a7));
    return __builtin_bit_cast(bf16x8, p);
}
constexpr int AKP = 136, AVP = 72;
constexpr int AK_BYTES = 64 * AKP * 2, AV_BYTES = 128 * AVP * 2;
__device__ __forceinline__ void att_unit(Frame& F, int b, int kv, int qb, int t_lo, int t_hi, int mode, int uidx) {
    const int lane = F.lane, w = F.wave, tid = F.tid;
    const bf16_t* proj = WSP(bf16_t, WS_PROJ); const unsigned long long* mask = WSP(unsigned long long, WS_SEL);
    LAS bf16_t* Kl0 = (LAS bf16_t*)F.lds; LAS bf16_t* Vl0 = (LAS bf16_t*)(F.lds + 2 * AK_BYTES); LAS bf16_t* Ql = (LAS bf16_t*)(F.lds + 2 * AK_BYTES + 2 * AV_BYTES) + w * 4096 + lane * 8;
    const int col = lane & 31, hh = lane >> 5, ql = col >> 2, h = col & 3;
    const int q = 64 * qb + 8 * w + ql; const size_t rowq = (size_t)(b * SEQ + q);
    __syncthreads();
#pragma unroll
    for (int ks = 0; ks < 8; ++ks) { const v4u raw = *(const v4u*)(proj + rowq * PW + PC_AQ + (kv * 4 + h) * 128 + 16 * ks + 8 * hh); const float sc = 0.08838834764831845f;
        v4u o; o.x = pk2(bflo(raw.x) * sc, bfhi(raw.x) * sc); o.y = pk2(bflo(raw.y) * sc, bfhi(raw.y) * sc); o.z = pk2(bflo(raw.z) * sc, bfhi(raw.z) * sc); o.w = pk2(bflo(raw.w) * sc, bfhi(raw.w) * sc);
        *(LAS v4u*)(Ql + ks * 512) = o; }
    const unsigned qebits = hh == 0 ? ((unsigned)(127 + 6 - (kv * 4 + h + 1)) << 7) | ((unsigned)(127 - (kv * 4 + h + 1)) << 23) : 0u;
    const int pi_ = (col & 16) | ((col & 4) << 1) | ((col & 8) >> 1) | (col & 3);
    f32x16 o0, o1, o2, o3;
#pragma unroll
    for (int i = 0; i < 16; ++i) { o0[i] = 0.f; o1[i] = 0.f; o2[i] = 0.f; o3[i] = 0.f; }
    float m_run = -1e30f, l_run = 0.f;
    const int skey = tid & 63, sch = tid >> 6;
    v4u sk0, sk1, sv0, sv1; unsigned long long mw = 0ull;
#define ATT_ROW(t_) ((t_) == 0 ? proj + (size_t)(METAROW + (skey & 15)) * PW + kv * 128 : proj + (size_t)(b * SEQ + 64 * (qb + 1 - (t_)) + skey) * PW + kv * 128)
#define ATT_LOADK(t) do { const int t_ = (t); const bool ok_ = t_ != 0 || skey < NMETA; const bf16_t* p_ = ATT_ROW(t_); const v4u z_ = (v4u){0u, 0u, 0u, 0u}; \
        sk0 = ok_ ? *(const v4u*)(p_ + PC_AK + 8 * sch) : z_; sk1 = ok_ ? *(const v4u*)(p_ + PC_AK + 8 * (sch + 8)) : z_; } while (0)
#define ATT_LOADV(t) do { const int t_ = (t); const bool ok_ = t_ != 0 || skey < NMETA; const bf16_t* p_ = ATT_ROW(t_); const v4u z_ = (v4u){0u, 0u, 0u, 0u}; \
        sv0 = ok_ ? *(const v4u*)(p_ + PC_AV + 8 * sch) : z_; sv1 = ok_ ? *(const v4u*)(p_ + PC_AV + 8 * (sch + 8)) : z_; mw = t_ == 0 ? 0ull : mask[rowq * 64 + (qb + 1 - t_)]; } while (0)
#define ATT_VT(dst, v, c) do { LAS bf16_t* d_ = (dst) + (8 * (c)) * AVP + skey; \
        d_[0 * AVP] = (bf16_t)(v.x & 0xffffu); d_[1 * AVP] = (bf16_t)(v.x >> 16); d_[2 * AVP] = (bf16_t)(v.y & 0xffffu); d_[3 * AVP] = (bf16_t)(v.y >> 16); \
        d_[4 * AVP] = (bf16_t)(v.z & 0xffffu); d_[5 * AVP] = (bf16_t)(v.z >> 16); d_[6 * AVP] = (bf16_t)(v.w & 0xffffu); d_[7 * AVP] = (bf16_t)(v.w >> 16); } while (0)
#define ATT_STOREK(buf) do { LAS bf16_t* kd_ = Kl0 + (buf) * (64 * AKP) + skey * AKP; *(LAS v4u*)(kd_ + 8 * sch) = sk0; *(LAS v4u*)(kd_ + 8 * (sch + 8)) = sk1; } while (0)
#define ATT_STOREV(buf) do { LAS bf16_t* vd_ = Vl0 + (buf) * (128 * AVP); ATT_VT(vd_, sv0, sch); ATT_VT(vd_, sv1, sch + 8); } while (0)
#define ATT_S(xa, xb, t) do { const int t_ = (t); const LAS bf16_t* Kb_ = Kl0 + (t_ & 1) * (64 * AKP); const int pos0_ = t_ == 0 ? 0 : NMETA + 64 * (qb + 1 - t_); \
        _Pragma("unroll") for (int i = 0; i < 16; ++i) { xa[i] = 0.f; xb[i] = 0.f; } \
        _Pragma("unroll") for (int ks = 0; ks < 8; ++ks) { const bf16x8 a0 = *(const LAS bf16x8*)(Kb_ + pi_ * AKP + 16 * ks + 8 * hh); const bf16x8 a1 = *(const LAS bf16x8*)(Kb_ + (32 + pi_) * AKP + 16 * ks + 8 * hh); \
            const bf16x8 qf_ = *(const LAS bf16x8*)(Ql + ks * 512); xa = MFMA32(a0, qf_, xa); xb = MFMA32(a1, qf_, xb); } \
        { const int p0_ = pos0_ + pi_, p1_ = pos0_ + 32 + pi_; v4u e0 = (v4u){0u, 0u, 0u, 0u}, e1 = e0; \
          e0.x = hh == 0 ? pk2((float)(p0_ >> 6), (float)(p0_ & 63)) : 0u; e1.x = hh == 0 ? pk2((float)(p1_ >> 6), (float)(p1_ & 63)) : 0u; \
          const bf16x8 qe_ = __builtin_bit_cast(bf16x8, ((v4u){qebits, 0u, 0u, 0u})); \
          xa = MFMA32(__builtin_bit_cast(bf16x8, e0), qe_, xa); xb = MFMA32(__builtin_bit_cast(bf16x8, e1), qe_, xb); } } while (0)
    const int ntiles = t_hi;
    ATT_LOADK(t_lo); ATT_LOADV(t_lo); ATT_STOREK(t_lo & 1); ATT_STOREV(t_lo & 1);
    ATT_LOADK(t_lo + 1); ATT_STOREK((t_lo + 1) & 1);
    unsigned long long mcur = mw;
    __syncthreads();
    f32x16 x0, x1, y0, y1;
    ATT_S(x0, x1, t_lo);
    __syncthreads();
#define ATT_BODY(XA, XB, YA, YB, T, FULL) do { const int T_ = (T); \
        if (FULL || T_ + 2 < ntiles) ATT_LOADK(T_ + 2); \
        if (FULL || T_ + 1 < ntiles) ATT_S(YA, YB, T_ + 1); \
        const LAS bf16_t* Vb = Vl0 + (T_ & 1) * (128 * AVP); \
        const unsigned mk0 = T_ == 0 ? 0x000000ffu : (unsigned)(mcur >> (8 * hh)), mk1 = T_ == 0 ? 0u : (unsigned)(mcur >> (32 + 8 * hh)); \
        float mt = -INFINITY; \
        _Pragma("unroll") for (int i = 0; i < 16; ++i) { const int bit = (i & 7) + 16 * (i >> 3); \
            const unsigned s0 = (unsigned)(((int)(mk0 << (31 - bit))) >> 31), s1 = (unsigned)(((int)(mk1 << (31 - bit))) >> 31); \
            XA[i] = __uint_as_float((__float_as_uint(XA[i]) & s0) | (~s0 & 0xff800000u)); XB[i] = __uint_as_float((__float_as_uint(XB[i]) & s1) | (~s1 & 0xff800000u)); \
            mt = fmaxf(mt, fmaxf(XA[i], XB[i])); } \
        { const auto sw = __builtin_amdgcn_permlane32_swap(__float_as_uint(mt), __float_as_uint(mt), false, false); mt = fmaxf(__uint_as_float(sw[0]), __uint_as_float(sw[1])); } \
        const float m_new = (mt > m_run + 8.f) ? mt : m_run;        \
        const float LOG2E = 1.4426950408889634f; \
        const float alpha = __builtin_amdgcn_exp2f((m_run - m_new) * LOG2E); \
        m_run = m_new; \
        const float mneg = -m_new * LOG2E; \
        float ls = 0.f; \
        _Pragma("unroll") for (int i = 0; i < 16; ++i) { XA[i] = __builtin_amdgcn_exp2f(fmaf(XA[i], LOG2E, mneg)); XB[i] = __builtin_amdgcn_exp2f(fmaf(XB[i], LOG2E, mneg)); ls += XA[i] + XB[i]; } \
        l_run = l_run * alpha + ls; \
        if (FULL) { _Pragma("unroll") for (int g_ = 0; g_ < 18; ++g_) { __builtin_amdgcn_sched_group_barrier(0x100, 2, 0); __builtin_amdgcn_sched_group_barrier(0x8, 1, 0); __builtin_amdgcn_sched_group_barrier(0x2, 9, 0); } } \
        if (FULL || T_ + 2 < ntiles) ATT_STOREK(T_ & 1);        \
        if (FULL || T_ + 1 < ntiles) ATT_LOADV(T_ + 1); \
        _Pragma("unroll") for (int i = 0; i < 16; ++i) { o0[i] *= alpha; o1[i] *= alpha; o2[i] *= alpha; o3[i] *= alpha; } \
        _Pragma("unroll") for (int cb = 0; cb < 2; ++cb) \
        _Pragma("unroll") for (int s2 = 0; s2 < 2; ++s2) { \
                const bf16x8 pb = cb == 0 ? pack8_bf16(XA[8 * s2], XA[8 * s2 + 1], XA[8 * s2 + 2], XA[8 * s2 + 3], XA[8 * s2 + 4], XA[8 * s2 + 5], XA[8 * s2 + 6], XA[8 * s2 + 7]) \
                                          : pack8_bf16(XB[8 * s2], XB[8 * s2 + 1], XB[8 * s2 + 2], XB[8 * s2 + 3], XB[8 * s2 + 4], XB[8 * s2 + 5], XB[8 * s2 + 6], XB[8 * s2 + 7]); \
                const LAS bf16_t* vp = Vb + col * AVP + 32 * cb + 16 * s2 + 8 * hh; \
                o0 = MFMA32(*(const LAS bf16x8*)(vp), pb, o0); o1 = MFMA32(*(const LAS bf16x8*)(vp + 32 * AVP), pb, o1); \
                o2 = MFMA32(*(const LAS bf16x8*)(vp + 64 * AVP), pb, o2); o3 = MFMA32(*(const LAS bf16x8*)(vp + 96 * AVP), pb, o3); } \
        if (FULL || T_ + 1 < ntiles) { ATT_STOREV((T_ + 1) & 1); mcur = mw; } \
        __syncthreads(); } while (0)
    int t = t_lo;
    for (; t + 3 < ntiles; t += 2) { ATT_BODY(x0, x1, y0, y1, t, 1); ATT_BODY(y0, y1, x0, x1, t + 1, 1); }
    for (; t < ntiles; ++t) { ATT_BODY(x0, x1, y0, y1, t, 0);
#pragma unroll
        for (int i = 0; i < 16; ++i) { x0[i] = y0[i]; x1[i] = y1[i]; } }
#undef ATT_BODY
#undef ATT_S
#undef ATT_ROW
#undef ATT_LOADK
#undef ATT_LOADV
#undef ATT_VT
#undef ATT_STOREK
#undef ATT_STOREV
    { const auto sw = __builtin_amdgcn_permlane32_swap(__float_as_uint(l_run), __float_as_uint(l_run), false, false); l_run = __uint_as_float(sw[0]) + __uint_as_float(sw[1]); }
    int colx, hhx; { int l2 = (int)__builtin_amdgcn_mbcnt_hi(~0u, __builtin_amdgcn_mbcnt_lo(~0u, 0u)); asm volatile("" : "+v"(l2)); colx = l2 & 31; hhx = l2 >> 5; }
    bf16_t* pO = WSP(bf16_t, WS_APART) + (size_t)uidx * (256 * 128) + (size_t)(32 * w + colx) * 128 + 4 * hhx; float* pML = WSP(float, WS_APML) + (size_t)uidx * 512 + (32 * w + colx) * 2;
    unsigned* flag = (unsigned*)(F.ws + WS_CTL) + CW_AFLAG + 64 * uidx;
    if (mode == 1) {
#pragma unroll
        for (int g4 = 0; g4 < 4; ++g4) {
            u32x2 w0, w1, w2, w3;
            w0.x = pk2(o0[4 * g4], o0[4 * g4 + 1]); w0.y = pk2(o0[4 * g4 + 2], o0[4 * g4 + 3]); w1.x = pk2(o1[4 * g4], o1[4 * g4 + 1]); w1.y = pk2(o1[4 * g4 + 2], o1[4 * g4 + 3]);
            w2.x = pk2(o2[4 * g4], o2[4 * g4 + 1]); w2.y = pk2(o2[4 * g4 + 2], o2[4 * g4 + 3]); w3.x = pk2(o3[4 * g4], o3[4 * g4 + 1]); w3.y = pk2(o3[4 * g4 + 2], o3[4 * g4 + 3]);
            *(u32x2*)(pO + 8 * g4) = w0; *(u32x2*)(pO + 32 + 8 * g4) = w1; *(u32x2*)(pO + 64 + 8 * g4) = w2; *(u32x2*)(pO + 96 + 8 * g4) = w3; }
        if (hhx == 0) { pML[0] = m_run; pML[1] = l_run; }
        asm volatile("s_waitcnt vmcnt(0)" ::: "memory");
        __syncthreads();
        if (tid == 0) { __builtin_amdgcn_fence(__ATOMIC_RELEASE, "agent"); asm volatile("s_waitcnt vmcnt(0)" ::: "memory"); __hip_atomic_store(flag, 1u, __ATOMIC_RELAXED, __HIP_MEMORY_SCOPE_AGENT); }
        return;
    }
    float sc_own = 1.f, sc_oth = 0.f, l_tot = l_run;
    if (mode == 2) {
        if (tid == 0) { unsigned spins = 0; while (__hip_atomic_load(flag, __ATOMIC_RELAXED, __HIP_MEMORY_SCOPE_AGENT) == 0u && ++spins < (1u << 22)) __builtin_amdgcn_s_sleep(8);
            __builtin_amdgcn_fence(__ATOMIC_ACQUIRE, "agent"); asm volatile("s_waitcnt vmcnt(0)" ::: "memory"); }
        __syncthreads();
        const float m2 = pML[0], l2 = pML[1]; const float mm = fmaxf(m_run, m2);
        sc_own = __expf(m_run - mm); sc_oth = __expf(m2 - mm); l_tot = l_run * sc_own + l2 * sc_oth;
    }
    const float inv = 1.f / l_tot; const float ko = sc_own * inv, kp = sc_oth * inv;
    bf16_t* yp = WSP(bf16_t, WS_YATT) + (size_t)(b * SEQ + 64 * qb + 8 * w + (colx >> 2)) * 1024 + (kv * 4 + (colx & 3)) * 128 + 4 * hhx;
#pragma unroll
    for (int g4 = 0; g4 < 4; ++g4) {
        u32x2 q0 = (u32x2){0u, 0u}, q1 = q0, q2 = q0, q3 = q0;
        if (mode == 2) { q0 = *(const u32x2*)(pO + 8 * g4); q1 = *(const u32x2*)(pO + 32 + 8 * g4); q2 = *(const u32x2*)(pO + 64 + 8 * g4); q3 = *(const u32x2*)(pO + 96 + 8 * g4); }
        u32x2 w0, w1, w2, w3;
        w0.x = pk2(o0[4 * g4] * ko + bflo(q0.x) * kp, o0[4 * g4 + 1] * ko + bfhi(q0.x) * kp); w0.y = pk2(o0[4 * g4 + 2] * ko + bflo(q0.y) * kp, o0[4 * g4 + 3] * ko + bfhi(q0.y) * kp);
        w1.x = pk2(o1[4 * g4] * ko + bflo(q1.x) * kp, o1[4 * g4 + 1] * ko + bfhi(q1.x) * kp); w1.y = pk2(o1[4 * g4 + 2] * ko + bflo(q1.y) * kp, o1[4 * g4 + 3] * ko + bfhi(q1.y) * kp);
        w2.x = pk2(o2[4 * g4] * ko + bflo(q2.x) * kp, o2[4 * g4 + 1] * ko + bfhi(q2.x) * kp); w2.y = pk2(o2[4 * g4 + 2] * ko + bflo(q2.y) * kp, o2[4 * g4 + 3] * ko + bfhi(q2.y) * kp);
        w3.x = pk2(o3[4 * g4] * ko + bflo(q3.x) * kp, o3[4 * g4 + 1] * ko + bfhi(q3.x) * kp); w3.y = pk2(o3[4 * g4 + 2] * ko + bflo(q3.y) * kp, o3[4 * g4 + 3] * ko + bfhi(q3.y) * kp);
        *(u32x2*)(yp + 8 * g4) = w0; *(u32x2*)(yp + 32 + 8 * g4) = w1; *(u32x2*)(yp + 64 + 8 * g4) = w2; *(u32x2*)(yp + 96 + 8 * g4) = w3;
    }
}
__device__ __forceinline__ void p11_final_ln(Frame& F) {
    const float* st = WSP(float, WS_ST3); const float* g = F.ka->in[20]; const float* b = F.ka->in[21];
    for (int row = F.gw; row < MR; row += F.NGW) { float mu, rs; row_stats(st, row, mu, rs);
        f32x4* o = (f32x4*)(F.out + (size_t)row * DM);
#pragma unroll
        for (int j = 0; j < 8; ++j) { const int i = F.lane + 64 * j; const f32x4 z = o[i]; o[i] = (z - mu) * rs * ((const f32x4*)g)[i] + ((const f32x4*)b)[i]; } }
}
constexpr int NPH = 12;
__global__ void __launch_bounds__(512, 2) mk_fwd(Args args) {
    extern __shared__ __attribute__((aligned(16))) unsigned char lds_raw[];
    Frame F;
    F.lds = (LAS unsigned char*)lds_raw;
    F.tid = threadIdx.x; F.lane = F.tid & 63; F.wave = __builtin_amdgcn_readfirstlane(F.tid >> 6);
    F.G = gridDim.x; F.gw = blockIdx.x * 8 + F.wave; F.NGW = F.G * 8;
    F.ka = (KArgs)__builtin_amdgcn_kernarg_segment_ptr();
    F.out = args.out; F.ws = args.ws;
    volatile LAS unsigned* MISC = (volatile LAS unsigned*)(F.lds + MISC_OFF);
    if (F.tid < 64) MISC[F.tid] = 0u;
    __syncthreads();
    XcdBarrier bar = xcd_barrier_post((unsigned*)(F.ws + WS_CTL) + CW_BAR + args.li * XCD_BAR_WORDS, MISC + 8);
    const int lo = args.ph_lo, hi = args.ph_hi;
#define IN(k) (lo <= (k) && (k) < hi)
#ifdef TS_A0
    unsigned long long* ts = (unsigned long long*)(F.ws + WS_CTL + 65536);
#define MARK(i) do { if (blockIdx.x == 0 && F.tid == 0) ts[i] = __builtin_amdgcn_s_memrealtime(); } while (0)
#else
#define MARK(i) do { } while (0)
#endif
    MARK(0);
#define SEAM(k) do { if (IN(k) && IN((k) + 1)) xcd_barrier(bar); MARK((k) + 1); } while (0)
    const int bid = blockIdx.x;
#ifndef REP_MASK
#define REP_MASK 0
#endif
#define PBEG(k) if (IN(k)) { const int nrep_ = ((REP_MASK >> (k)) & 1) ? 2 : 1; for (int rep = 0; rep < nrep_; ++rep) { if (rep) xcd_barrier(bar);
#define PEND(k) } } SEAM(k);

    PBEG(0) p0_prologue(F); PEND(0)
    PBEG(1)
        p1_colsums(F, 0, PW);
        Gemm g{WSP(bf16_t, WS_H0B), WSP(bf16_t, WS_WGU1), MPAD, NGU, DM}; StaticOrder S; S.init(MPAD, NGU, F.G, bid);
        EpiSwiGLU<false> E{WSP(bf16_t, WS_G), DFF, StatTbl{nullptr, nullptr}, nullptr, nullptr};
        gemm_phase<EpiSwiGLU<false>, StaticOrder, true, true>(F.lds, g, S, E);
        MARK(16);
        tr_queue(F, (unsigned*)(F.ws + WS_CTL) + CW_Q1 + 64 * rep, TR_I1, TR_I2);
    PEND(1)
    PBEG(2)
        p2_meta_down(F); MARK(17);
        Gemm g{WSP(bf16_t, WS_G), WSP(bf16_t, WS_WD1), MR, DM, DFF}; StaticOrder S; S.init(MR, DM, F.G, bid);
        EpiResid<0> E{F.ka->in[0], nullptr, StatTbl{nullptr, nullptr}, nullptr, nullptr, WSP(bf16_t, WS_Z1B), nullptr, WSP(float, WS_ST1), 0.5f};
        gemm_phase<EpiResid<0>, StaticOrder, false, true>(F.lds, g, S, E);
    PEND(2)
    PBEG(3)
        Gemm g{WSP(bf16_t, WS_Z1B), WSP(bf16_t, WS_WIN), MPAD, PW, DM}; StaticOrder S; S.init(MPAD, PW, F.G, bid);
        const StatTbl st = fill_stats(F, S, WSP(float, WS_ST1), WSP(float, WS_Z1M)); MARK(18);
        EpiProj E{WSP(bf16_t, WS_PROJ), PW, st, WSP(float, WS_CSV), WSP(float, WS_BWV)};
        gemm_phase<EpiProj, StaticOrder, true, true>(F.lds, g, S, E);
        tr_queue(F, (unsigned*)(F.ws + WS_CTL) + CW_Q3 + 64 * rep, TR_I2, TR_I3);
    PEND(3)
    PBEG(4)
        p1_colsums(F, PW, NCS);
        p4_ikn(F); MARK(13);
        for (int it = bid; it < 16 * 65; it += F.G) h1_item(F, it / 65, it % 65);
    PEND(4)
    PBEG(5)
        if (rep == 0) for (int it = bid; it < 256; it += F.G) h2_item(F, it);
        MARK(14);
        for (int it = bid; it < 1024; it += F.G) { const int j = it >> 8, x = it & 255; idx_item(F, j >> 1, (j & 1) ? 511 - x : x); }
    PEND(5)
    PBEG(6)
#ifndef REP_H3
#define REP_H3 1
#endif
#ifndef REP_ATT
#define REP_ATT 1
#endif
        {
            const int pr = bid >> 1, ab = pr >> 6, akv = (pr >> 5) & 1, j = pr & 31, qbl = 32 + j, split = j + 2;
            const bool paired = F.G == 256; const int np = paired ? ((bid & 1) ? 1 : 2) : (256 + F.G - 1 - bid) / F.G;
            for (int ps = 0; ps < np; ++ps) {
                int ub, ukv, uq, lo_, hi_, md;
                if (paired) { ub = ab; ukv = akv;
                    if (bid & 1) { uq = qbl; lo_ = split; hi_ = qbl + 2; md = 1; }
                    else if (ps == 0) { uq = 31 - j; lo_ = 0; hi_ = 33 - j; md = 0; }
                    else { uq = qbl; lo_ = 0; hi_ = split; md = 2; } }
                else { const int it = bid + ps * F.G; ub = it >> 7; ukv = (it >> 6) & 1; uq = it & 63; lo_ = 0; hi_ = uq + 2; md = 0; }
                att_unit(F, ub, ukv, uq, lo_, hi_, md, pr);
            }
        }
        MARK(15);
        {
            unsigned* qctr = (unsigned*)(F.ws + WS_CTL) + CW_Q6 + 64 * rep; volatile LAS int* qslot = (volatile LAS int*)(F.lds + MISC_OFF + 128);
            for (;;) {
                __syncthreads();
                if (F.tid == 0) qslot[0] = (int)__hip_atomic_fetch_add(qctr, 1u, __ATOMIC_RELAXED, __HIP_MEMORY_SCOPE_AGENT);
                __syncthreads();
                const int it = qslot[0];
                if (it >= 16 * 16) break;
                h3_wave(F, it >> 4, 4 * (it & 15) + (F.wave >> 1) + 1, F.wave & 1);
            }
        }
    PEND(6)
    PBEG(7)
        { Gemm g{WSP(bf16_t, WS_YATT), WSP(bf16_t, WS_WBA), MR, DM, 1024}; StaticOrder S; S.init(MR, DM, F.G, bid);
          EpiBranch<0> E{WSP(bf16_t, WS_PROJ), PW, PC_GA, WSP(bf16_t, WS_T1), nullptr};
          gemm_phase<EpiBranch<0>, StaticOrder, false, true>(F.lds, g, S, E); }
        __syncthreads(); MARK(19);
        { Gemm g{WSP(bf16_t, WS_YHG), WSP(bf16_t, WS_WBH), MR, DM, 1024}; StaticOrder S; S.init(MR, DM, F.G, bid);
          EpiBranch<1> E{WSP(bf16_t, WS_PROJ), PW, PC_GH, WSP(bf16_t, WS_T1), WSP(bf16_t, WS_MRG)};
          gemm_phase<EpiBranch<1>, StaticOrder, false, true>(F.lds, g, S, E); }
    PEND(7)
    PBEG(8)
        Gemm g{WSP(bf16_t, WS_MRG), WSP(bf16_t, WS_WOUT), MR, DM, DM}; StaticOrder S; S.init(MR, DM, F.G, bid);
        const StatTbl st = fill_stats(F, S, WSP(float, WS_ST1), nullptr);
        EpiResid<1> E{nullptr, WSP(bf16_t, WS_Z1B), st, F.ka->in[5], F.ka->in[6], WSP(bf16_t, WS_Z2B), nullptr, WSP(float, WS_ST2), 1.0f};
        gemm_phase<EpiResid<1>, StaticOrder, false, true>(F.lds, g, S, E);
    PEND(8)
    PBEG(9)
        Gemm g{WSP(bf16_t, WS_Z2B), WSP(bf16_t, WS_WGU2), MR, NGU, DM}; StaticOrder S; S.init(MR, NGU, F.G, bid);
        const StatTbl st = fill_stats(F, S, WSP(float, WS_ST2), nullptr);
        EpiSwiGLU<true> E{WSP(bf16_t, WS_G2), DFF, st, WSP(float, WS_CSV) + PW, WSP(float, WS_BWV) + PW};
        gemm_phase<EpiSwiGLU<true>, StaticOrder, true, true>(F.lds, g, S, E);
        tr_queue(F, (unsigned*)(F.ws + WS_CTL) + CW_Q9 + 64 * rep, TR_I3, TR_I4);
    PEND(9)
    PBEG(10)
        Gemm g{WSP(bf16_t, WS_G2), WSP(bf16_t, WS_WD2), MR, DM, DFF}; StaticOrder S; S.init(MR, DM, F.G, bid);
        const StatTbl st = fill_stats(F, S, WSP(float, WS_ST2), nullptr);
        EpiResid<2> E{nullptr, WSP(bf16_t, WS_Z2B), st, F.ka->in[15], F.ka->in[16], nullptr, F.out, WSP(float, WS_ST3), 0.5f};
        gemm_phase<EpiResid<2>, StaticOrder, false, true>(F.lds, g, S, E);
    PEND(10)
    if (IN(11)) { p11_final_ln(F); }
#ifdef TS_A0
    if (blockIdx.x == 0 && F.tid == 0) {
        const unsigned long long now = __builtin_amdgcn_s_memrealtime(); ts[12] = now;
        unsigned long long qa = (ts[TS_A1] - ts[TS_A0]) / TS_UNIT, qb = (ts[TS_B1] - ts[TS_B0]) / TS_UNIT; if (qa > 99) qa = 99; if (qb > 99) qb = 99;
        const unsigned long long target = now + 2000ull * (100ull * qa + qb);
        while (__builtin_amdgcn_s_memrealtime() < target) __builtin_amdgcn_s_sleep(32);
    }
#endif
#undef IN
#undef SEAM
}

#ifndef MK_CUTS
#define MK_CUTS {0, NPH}
#endif
extern "C" void kernel_launch(void* const* d_in, const int* in_sizes, int n_in, void* d_out, int out_size, void* d_ws, size_t ws_size, hipStream_t stream) {
    static int grid = 0;
    if (grid == 0) {
        if (n_in != 22 || out_size != MR * DM || ws_size < WS_END) { fprintf(stderr, "kernel_launch: unexpected shapes (n_in %d, out %d, ws %zu < %zu)\n", n_in, out_size, ws_size, (size_t)WS_END); grid = -1; return; }
        int dev = 0, cus = 0, per_cu = 0;
        if (hipGetDevice(&dev) != hipSuccess || hipDeviceGetAttribute(&cus, hipDeviceAttributeMultiprocessorCount, dev) != hipSuccess) { grid = -1; return; }
        if (hipFuncSetAttribute((const void*)mk_fwd, hipFuncAttributeMaxDynamicSharedMemorySize, LDS_BYTES) != hipSuccess) { fprintf(stderr, "kernel_launch: hipFuncSetAttribute failed\n"); grid = -1; return; }
        if (hipOccupancyMaxActiveBlocksPerMultiprocessor(&per_cu, (const void*)mk_fwd, 512, LDS_BYTES) != hipSuccess || per_cu < 1) { fprintf(stderr, "kernel_launch: occupancy query says %d blocks per CU\n", per_cu); grid = -1; (void)hipGetLastError(); return; }
        grid = cus;
        if (grid != 256) fprintf(stderr, "kernel_launch: %d CUs; the one-unit-per-workgroup GEMM phases assume 256\n", grid);
    }
    if (grid < 0) return;
    (void)hipMemsetAsync((char*)d_ws + WS_CTL, 0, CTL_BYTES, stream);
    Args a{};
    for (int i = 0; i < 22; ++i) a.in[i] = (const float*)d_in[i];
    a.out = (float*)d_out; a.ws = (unsigned char*)d_ws;
    const int cuts[] = MK_CUTS; const int nl = (int)(sizeof(cuts) / sizeof(int)) - 1;
    for (int li = 0; li < nl; ++li) {
        a.ph_lo = cuts[li]; a.ph_hi = cuts[li + 1]; a.li = li; a.pad = 0;
        void* kargs[] = {&a};
        const hipError_t e = hipLaunchCooperativeKernel((const void*)mk_fwd, dim3(grid), dim3(512), kargs, LDS_BYTES, stream);
        if (e != hipSuccess) { fprintf(stderr, "kernel_launch: cooperative launch %d failed: %s\n", li, hipGetErrorString(e)); break; }
    }
}
```
